# Optimizing an MI355X kernel written in HIP

```python
import jax, jax.numpy as jnp
from jax import lax
import numpy as np

D_MODEL = 2048
BATCH = 4
SEQ = 4096
DEPTH = 1

HEAD_DIM = 64
N_HEADS_SWA = 16
N_KV_SWA = 2
N_HEADS_FOX = 16
WINDOW = 128
BLOCK = 128
D_FF = 5632
CONV_WIDTH = 3
EPS = 1e-6
D_SWA = N_HEADS_SWA * HEAD_DIM
D_KV_SWA = N_KV_SWA * HEAD_DIM
D_FOX = N_HEADS_FOX * HEAD_DIM
D_MIX = D_SWA + D_FOX
D_IN = D_SWA + 2 * D_KV_SWA + 3 * D_FOX + N_HEADS_FOX

kernel_name = "hymba_swa_sink_fox_alibi_convffn"


def rmsnorm(x, g):
    xf = x.astype(jnp.float32)
    y = xf * lax.rsqrt(jnp.mean(xf * xf, axis=-1, keepdims=True) + EPS)
    return (y * g.astype(jnp.float32)).astype(x.dtype)


def alibi_slopes(n):
    return jnp.asarray(2.0 ** (-8.0 * np.arange(1, n + 1) / n), dtype=jnp.float32)


def swa_sink_attention(q, k, v, sinks):
    B, S, H, D = q.shape
    KV = k.shape[2]
    G = H // KV
    nB = S // BLOCK
    scale = 1.0 / np.sqrt(D)
    qb = q.reshape(B, nB, BLOCK, KV, G, D)

    def band(t):
        tp = jnp.pad(t, ((0, 0), (BLOCK, 0), (0, 0), (0, 0)))[:, :S]
        return jnp.concatenate([tp.reshape(B, nB, BLOCK, KV, D), t.reshape(B, nB, BLOCK, KV, D)], axis=2)

    kb, vb = band(k), band(v)
    s = jnp.einsum('bnqkgd,bnskd->bnkgqs', qb, kb).astype(jnp.float32) * scale
    q_loc = BLOCK + jnp.arange(BLOCK)
    k_loc = jnp.arange(2 * BLOCK)
    dist = (q_loc[:, None] - k_loc[None, :]).astype(jnp.float32)
    blk_start = jnp.arange(nB) * BLOCK - BLOCK
    k_abs = blk_start[:, None] + k_loc[None, :]
    mask = (dist >= 0)[None] & (dist < WINDOW)[None] & (k_abs >= 0)[:, None, :]
    slopes = alibi_slopes(H).reshape(KV, G)
    s = s - slopes[:, :, None, None] * dist
    s = jnp.where(mask[None, :, None, None], s, -jnp.inf)
    sink = sinks.astype(jnp.float32).reshape(KV, G)[None, None, :, :, None, None]
    m = jnp.maximum(jnp.max(s, axis=-1, keepdims=True), sink)
    p = jnp.exp(s - m)
    p = p / (jnp.sum(p, axis=-1, keepdims=True) + jnp.exp(sink - m))
    o = jnp.einsum('bnkgqs,bnskd->bnqkgd', p.astype(v.dtype), vb)
    return o.reshape(B, S, H, D)


def forgetting_attention(q, k, v, log_f):
    B, S, H, D = q.shape
    nB = S // BLOCK
    scale = 1.0 / np.sqrt(D)
    c = lax.cumsum(log_f, axis=1)
    cT = jnp.transpose(c, (0, 2, 1))
    qb = jnp.moveaxis(q.reshape(B, nB, BLOCK, H, D), 1, 0)
    cb = jnp.moveaxis(cT.reshape(B, H, nB, BLOCK), 2, 0)
    k_pos = jnp.arange(S)

    def one_block(args):
        q_blk, c_blk, n = args
        s = jnp.einsum('bqhd,bshd->bhqs', q_blk, k).astype(jnp.float32) * scale
        s = s + c_blk[..., None] - cT[:, :, None, :]
        q_pos = n * BLOCK + jnp.arange(BLOCK)
        s = jnp.where((q_pos[:, None] >= k_pos[None, :])[None, None], s, -jnp.inf)
        p = jax.nn.softmax(s, axis=-1)
        return jnp.einsum('bhqs,bshd->bqhd', p.astype(v.dtype), v)

    o = lax.map(one_block, (qb, cb, jnp.arange(nB)))
    return jnp.moveaxis(o, 0, 1).reshape(B, S, H, D)


def causal_dwconv(u, w, b):
    S = u.shape[1]
    up = jnp.pad(u, ((0, 0), (CONV_WIDTH - 1, 0), (0, 0)))
    y = b
    for kk in range(CONV_WIDTH):
        y = y + up[:, kk:kk + S] * w[kk]
    return y


def setup_inputs(seed: int = 0) -> dict:
    key = jax.random.key(seed)
    ks = jax.random.split(key, 17)
    f32 = jnp.float32
    nrm = lambda k, shape, s: jax.random.normal(k, shape, f32) * s
    gain = lambda k, n: 1.0 + 0.05 * jax.random.normal(k, (DEPTH, n), f32)
    return {
        "x": jax.random.normal(ks[0], (BATCH, SEQ, D_MODEL), f32),
        "pre_mix_g": gain(ks[1], D_MODEL),
        "w_in": nrm(ks[2], (DEPTH, D_MODEL, D_IN), D_MODEL ** -0.5),
        "b_forget": 2.0 + 0.5 * jax.random.normal(ks[3], (DEPTH, N_HEADS_FOX), f32),
        "sinks": nrm(ks[4], (DEPTH, N_HEADS_SWA), 1.0),
        "grp_swa_g": gain(ks[5], D_SWA),
        "grp_fox_g": gain(ks[6], D_FOX),
        "w_out": nrm(ks[7], (DEPTH, D_MIX, D_MODEL), D_MIX ** -0.5),
        "post_mix_g": gain(ks[8], D_MODEL),
        "pre_ffn_g": gain(ks[9], D_MODEL),
        "w_up": nrm(ks[10], (DEPTH, D_MODEL, 2 * D_FF), D_MODEL ** -0.5),
        "conv_w": nrm(ks[11], (DEPTH, CONV_WIDTH, 2 * D_FF), CONV_WIDTH ** -0.5),
        "conv_b": nrm(ks[12], (DEPTH, 2 * D_FF), 0.02),
        "w_down": nrm(ks[13], (DEPTH, D_FF, D_MODEL), D_FF ** -0.5),
        "post_ffn_g": gain(ks[14], D_MODEL),
    }


def reference(x, pre_mix_g, w_in, b_forget, sinks, grp_swa_g, grp_fox_g, w_out, post_mix_g,
              pre_ffn_g, w_up, conv_w, conv_b, w_down, post_ffn_g):
    B, S, _ = x.shape
    cuts = np.cumsum([D_SWA, D_KV_SWA, D_KV_SWA, D_FOX, D_FOX, D_FOX])
    for l in range(DEPTH):
        h = rmsnorm(x, pre_mix_g[l])
        proj = h @ w_in[l]
        q_a, k_a, v_a, q_b, k_b, v_b, f_b = jnp.split(proj, cuts, axis=-1)
        o_a = swa_sink_attention(q_a.reshape(B, S, N_HEADS_SWA, HEAD_DIM),
                                 k_a.reshape(B, S, N_KV_SWA, HEAD_DIM),
                                 v_a.reshape(B, S, N_KV_SWA, HEAD_DIM), sinks[l])
        log_f = jax.nn.log_sigmoid(f_b.astype(jnp.float32) + b_forget[l].astype(jnp.float32))
        o_b = forgetting_attention(q_b.reshape(B, S, N_HEADS_FOX, HEAD_DIM),
                                   k_b.reshape(B, S, N_HEADS_FOX, HEAD_DIM),
                                   v_b.reshape(B, S, N_HEADS_FOX, HEAD_DIM), log_f)
        o_a = rmsnorm(o_a.reshape(B, S, D_SWA), grp_swa_g[l])
        o_b = rmsnorm(o_b.reshape(B, S, D_FOX), grp_fox_g[l])
        mix = jnp.concatenate([o_a, o_b], axis=-1) @ w_out[l]
        x = x + rmsnorm(mix, post_mix_g[l])
        h = rmsnorm(x, pre_ffn_g[l])
        u = causal_dwconv(h @ w_up[l], conv_w[l], conv_b[l])
        gate, val = jnp.split(u, 2, axis=-1)
        y = (jax.nn.gelu(gate, approximate=True) * val) @ w_down[l]
        x = x + rmsnorm(y, post_ffn_g[l])
    return x
```

```cpp
#include <hip/hip_runtime.h>
#include <cstdio>
#include <cstdint>

constexpr int NB = 4, SEQ = 4096, DM = 2048, M = NB * SEQ;
constexpr int HD = 64, NHA = 16, NKVA = 2, NHB = 16, WIN = 128, DFF = 5632, NUP = 2 * DFF;
constexpr int DIN = 4368, DINP = 4608;
constexpr float EPS = 1e-6f;
constexpr float LOG2E = 1.4426950408889634f;
constexpr float C2 = 0.125f * LOG2E;

constexpr size_t MiB = 1u << 20;
constexpr size_t WS_WIN = 0, WS_WOUT = 18 * MiB, WS_WUP = 26 * MiB, WS_WDN = 70 * MiB;
constexpr size_t WS_XN = 92 * MiB;
constexpr size_t WS_CS = 156 * MiB, WS_F = 157 * MiB, WS_SIDE = 158 * MiB;
constexpr size_t WS_QA = 170 * MiB, WS_KA = 202 * MiB, WS_VA = 206 * MiB, WS_QB = 210 * MiB, WS_KB = 242 * MiB, WS_VB = 274 * MiB, WS_O = 306 * MiB;
constexpr size_t WS_ACT = 170 * MiB;
constexpr size_t WS_MIX = 370 * MiB;
constexpr size_t WS_END = 498 * MiB;

typedef unsigned short bf16_t;
typedef unsigned v4u __attribute__((ext_vector_type(4)));
typedef float f32x4 __attribute__((ext_vector_type(4)));

__device__ __forceinline__ unsigned f2bf(float f) { unsigned u = __builtin_bit_cast(unsigned, f); return (u + 0x7fffu + ((u >> 16) & 1u)) >> 16; }
__device__ __forceinline__ unsigned pk2(float lo, float hi) { return f2bf(lo) | (f2bf(hi) << 16); }
__device__ __forceinline__ float bf2f(unsigned h) { return __builtin_bit_cast(float, h << 16); }
__device__ __forceinline__ float wave_sum(float v) {
#pragma unroll
    for (int o = 1; o < 64; o <<= 1) v += __shfl_xor(v, o);
    return v;
}
__device__ __forceinline__ float wave_max(float v) {
#pragma unroll
    for (int o = 1; o < 64; o <<= 1) v = fmaxf(v, __shfl_xor(v, o));
    return v;
}

__device__ __forceinline__ int rowmap(int n, int map) {
    if (map == 0) return n;
    if (n < DFF) return ((n >> 7) << 8) + (n & 127);
    const int g = n - DFF; return ((g >> 7) << 8) + 128 + (g & 127);
}
__device__ __forceinline__ void transpose_item(const float* W, int K, int N, int Npad, bf16_t* WT, int map, float* scr, int item, int lane) {
    const int nblk = Npad / 32, kb = item / nblk, nb = item % nblk, k0 = 64 * kb, n0 = 32 * nb;
#pragma unroll 8
    for (int i = 0; i < 32; ++i) { const int kk = 2 * i + (lane >> 5); const int n = n0 + (lane & 31); scr[kk * 33 + (lane & 31)] = (n < N) ? W[(size_t)(k0 + kk) * N + n] : 0.f; }
    __builtin_amdgcn_s_waitcnt(0); asm volatile("" ::: "memory");
    const int c = lane & 7;
#pragma unroll
    for (int j = 0; j < 4; ++j) { const int n = (lane >> 3) + 8 * j; const float* s = scr + (8 * c) * 33 + n;
        v4u o; o.x = pk2(s[0 * 33], s[1 * 33]); o.y = pk2(s[2 * 33], s[3 * 33]); o.z = pk2(s[4 * 33], s[5 * 33]); o.w = pk2(s[6 * 33], s[7 * 33]);
        *(v4u*)(WT + (size_t)rowmap(n0 + n, map) * K + k0 + 8 * c) = o; }
    __builtin_amdgcn_s_waitcnt(0); asm volatile("" ::: "memory");
}
struct Ptrs {
    const float *x, *pre_mix_g, *w_in, *b_forget, *sinks, *grp_swa_g, *grp_fox_g, *w_out, *post_mix_g, *pre_ffn_g, *w_up, *conv_w, *conv_b, *w_down, *post_ffn_g;
    float* out; unsigned char* ws;
};
__global__ void __launch_bounds__(256) k_prologue(Ptrs P) {
    __shared__ float scr_all[4 * 64 * 33];
    const int tid = threadIdx.x, lane = tid & 63, wave = tid >> 6;
    float* scr = scr_all + wave * 64 * 33;
    const int gw = blockIdx.x * 4 + wave, NGW = gridDim.x * 4;
    constexpr int I_IN = (DM / 64) * (DINP / 32), I_OUT = (DM / 64) * (DM / 32), I_UP = (DM / 64) * (NUP / 32), I_DN = (DFF / 64) * (DM / 32);
    for (int it = gw; it < I_IN + I_OUT + I_UP + I_DN; it += NGW) {
        int r = it;
        if (r < I_IN) { transpose_item(P.w_in, DM, DIN, DINP, (bf16_t*)(P.ws + WS_WIN), 0, scr, r, lane); continue; } r -= I_IN;
        if (r < I_OUT) { transpose_item(P.w_out, DM, DM, DM, (bf16_t*)(P.ws + WS_WOUT), 0, scr, r, lane); continue; } r -= I_OUT;
        if (r < I_UP) { transpose_item(P.w_up, DM, NUP, NUP, (bf16_t*)(P.ws + WS_WUP), 1, scr, r, lane); continue; } r -= I_UP;
        transpose_item(P.w_down, DFF, DM, DM, (bf16_t*)(P.ws + WS_WDN), 0, scr, r, lane);
    }
}

__device__ __forceinline__ void row_load(const float* row, int lane, f32x4 (&v)[8]) {
#pragma unroll
    for (int j = 0; j < 8; ++j) v[j] = ((const f32x4*)row)[lane + 64 * j];
}
__device__ __forceinline__ float row_sumsq(const f32x4 (&v)[8]) {
    float s = 0.f;
#pragma unroll
    for (int j = 0; j < 8; ++j) s += (v[j].x * v[j].x + v[j].y * v[j].y) + (v[j].z * v[j].z + v[j].w * v[j].w);
    return wave_sum(s);
}
__device__ __forceinline__ void row_store_bf16(bf16_t* orow, int lane, const f32x4 (&v)[8]) {
#pragma unroll
    for (int j = 0; j < 8; ++j) ((unsigned long long*)orow)[lane + 64 * j] = (unsigned long long)pk2(v[j].x, v[j].y) | ((unsigned long long)pk2(v[j].z, v[j].w) << 32);
}
__device__ __forceinline__ void pass_prenorm(const float* x, const float* g, bf16_t* xn, int gw, int NGW, int lane) {
    f32x4 gv[8]; row_load(g, lane, gv);
    for (int m = gw; m < M; m += NGW) {
        f32x4 v[8]; row_load(x + (size_t)m * DM, lane, v);
        const float r = 1.0f / sqrtf(row_sumsq(v) * (1.0f / DM) + EPS);
#pragma unroll
        for (int j = 0; j < 8; ++j) v[j] = v[j] * r * gv[j];
        row_store_bf16(xn + (size_t)m * DM, lane, v);
    }
}
__device__ __forceinline__ void pass_postmix(const float* x, const float* mix, const float* gpost, const float* gpre, float* out, bf16_t* xn, int gw, int NGW, int lane) {
    for (int m = gw; m < M; m += NGW) {
        f32x4 v[8], xv[8], gv[8]; row_load(mix + (size_t)m * DM, lane, v); row_load(x + (size_t)m * DM, lane, xv); row_load(gpost, lane, gv);
        const float r = 1.0f / sqrtf(row_sumsq(v) * (1.0f / DM) + EPS);
#pragma unroll
        for (int j = 0; j < 8; ++j) { v[j] = xv[j] + v[j] * r * gv[j]; ((f32x4*)(out + (size_t)m * DM))[lane + 64 * j] = v[j]; }
        const float r2 = 1.0f / sqrtf(row_sumsq(v) * (1.0f / DM) + EPS);
        row_load(gpre, lane, gv);
#pragma unroll
        for (int j = 0; j < 8; ++j) v[j] = v[j] * r2 * gv[j];
        row_store_bf16(xn + (size_t)m * DM, lane, v);
    }
}
__device__ __forceinline__ void pass_final(const float* y, const float* g, float* out, int gw, int NGW, int lane) {
    f32x4 gv[8]; row_load(g, lane, gv);
    for (int m = gw; m < M; m += NGW) {
        f32x4 v[8], xv[8]; row_load(y + (size_t)m * DM, lane, v); row_load(out + (size_t)m * DM, lane, xv);
        const float r = 1.0f / sqrtf(row_sumsq(v) * (1.0f / DM) + EPS);
#pragma unroll
        for (int j = 0; j < 8; ++j) ((f32x4*)(out + (size_t)m * DM))[lane + 64 * j] = xv[j] + v[j] * r * gv[j];
    }
}
__device__ __forceinline__ void pass_groupnorm(bf16_t* O, const float* ga, const float* gb, int gw, int NGW, int lane) {
    for (int m = gw; m < M; m += NGW) {
        v4u w[4]; float f[4][8];
#pragma unroll
        for (int i = 0; i < 4; ++i) { w[i] = ((const v4u*)(O + (size_t)m * DM))[lane + 64 * i];
#pragma unroll
            for (int e = 0; e < 4; ++e) { f[i][2 * e] = bf2f(w[i][e] & 0xffffu); f[i][2 * e + 1] = bf2f(w[i][e] >> 16); } }
        float sa = 0.f, sb = 0.f;
#pragma unroll
        for (int e = 0; e < 8; ++e) { sa += f[0][e] * f[0][e] + f[1][e] * f[1][e]; sb += f[2][e] * f[2][e] + f[3][e] * f[3][e]; }
        sa = wave_sum(sa); sb = wave_sum(sb);
        const float ra = 1.0f / sqrtf(sa * (1.0f / 1024.f) + EPS), rb = 1.0f / sqrtf(sb * (1.0f / 1024.f) + EPS);
#pragma unroll
        for (int i = 0; i < 4; ++i) { const int c0 = 8 * (lane + 64 * i); const float* g = (i < 2) ? (ga + c0) : (gb + c0 - 1024); const float r = (i < 2) ? ra : rb;
            v4u o;
#pragma unroll
            for (int e = 0; e < 4; ++e) o[e] = pk2(f[i][2 * e] * r * g[2 * e], f[i][2 * e + 1] * r * g[2 * e + 1]);
            ((v4u*)(O + (size_t)m * DM))[lane + 64 * i] = o; }
    }
}
__global__ void __launch_bounds__(512) k_prenorm(Ptrs P) { pass_prenorm(P.x, P.pre_mix_g, (bf16_t*)(P.ws + WS_XN), blockIdx.x * 8 + (threadIdx.x >> 6), gridDim.x * 8, threadIdx.x & 63); }
__global__ void __launch_bounds__(512) k_postmix(Ptrs P) { pass_postmix(P.x, (const float*)(P.ws + WS_MIX), P.post_mix_g, P.pre_ffn_g, P.out, (bf16_t*)(P.ws + WS_XN), blockIdx.x * 8 + (threadIdx.x >> 6), gridDim.x * 8, threadIdx.x & 63); }
__global__ void __launch_bounds__(512) k_final(Ptrs P) { pass_final((const float*)(P.ws + WS_MIX), P.post_ffn_g, P.out, blockIdx.x * 8 + (threadIdx.x >> 6), gridDim.x * 8, threadIdx.x & 63); }
__global__ void __launch_bounds__(512) k_groupnorm(Ptrs P) { pass_groupnorm((bf16_t*)(P.ws + WS_O), P.grp_swa_g, P.grp_fox_g, blockIdx.x * 8 + (threadIdx.x >> 6), gridDim.x * 8, threadIdx.x & 63); }

__device__ __forceinline__ float log_sigmoid(float z) { return z >= 0.f ? -log1pf(expf(-z)) : z - log1pf(expf(z)); }
__device__ __forceinline__ void pass_cscan(const float* F, const float* bfg, float* cs, int gw, int NGW, int lane) {
    for (int bh = gw; bh < NB * NHB; bh += NGW) {
        const int b = bh / NHB, h = bh % NHB; const float bias = bfg[h];
        const float* f = F + ((size_t)b * SEQ + 64 * lane) * 16 + h;
        float s = 0.f;
        for (int i = 0; i < 64; ++i) s += log_sigmoid(f[i * 16] + bias);
        float inc = s;
#pragma unroll
        for (int o = 1; o < 64; o <<= 1) { const float t = __shfl_up(inc, o); if (lane >= o) inc += t; }
        float run = inc - s;
        float* c = cs + (size_t)bh * SEQ + 64 * lane;
        for (int i = 0; i < 64; ++i) { run += log_sigmoid(f[i * 16] + bias); c[i] = run * LOG2E; }
    }
}
__global__ void __launch_bounds__(512) k_cscan(Ptrs P) { pass_cscan((const float*)(P.ws + WS_F), P.b_forget, (float*)(P.ws + WS_CS), blockIdx.x * 8 + (threadIdx.x >> 6), gridDim.x * 8, threadIdx.x & 63); }

struct EpiInProj {
    unsigned char* ws;
    __device__ __forceinline__ void put(int r, int c, float v) const {
        if (c < 1024) { ((bf16_t*)(ws + WS_QA))[(size_t)r * 1024 + c] = (bf16_t)f2bf(v * C2); return; }
        if (c < 1152) { ((bf16_t*)(ws + WS_KA))[(size_t)r * 128 + c - 1024] = (bf16_t)f2bf(v); return; }
        if (c < 1280) { ((bf16_t*)(ws + WS_VA))[(size_t)r * 128 + c - 1152] = (bf16_t)f2bf(v); return; }
        if (c < 2304) { ((bf16_t*)(ws + WS_QB))[(size_t)r * 1024 + c - 1280] = (bf16_t)f2bf(v * C2); return; }
        if (c < 3328) { ((bf16_t*)(ws + WS_KB))[(size_t)r * 1024 + c - 2304] = (bf16_t)f2bf(v); return; }
        if (c < 4352) { ((bf16_t*)(ws + WS_VB))[(size_t)r * 1024 + c - 3328] = (bf16_t)f2bf(v); return; }
        if (c < 4368) { ((float*)(ws + WS_F))[(size_t)r * 16 + c - 4352] = v; }
    }
};
struct EpiF32 { float* C; int ldc; int pad; __device__ __forceinline__ void put(int r, int c, float v) const { C[(size_t)r * ldc + c] = v; } };

template <class Epi> __global__ void __launch_bounds__(512) k_naive_gemm(const bf16_t* A, const bf16_t* Bt, long Kl, Epi E) {
    const int K = (int)Kl;
    __shared__ float As[16][132], Bs[16][132];
    const int tid = threadIdx.x, ty = tid >> 5, tx = tid & 31;
    const int m0 = blockIdx.y * 128, n0 = blockIdx.x * 128;
    float acc[8][4];
#pragma unroll
    for (int i = 0; i < 8; ++i)
#pragma unroll
        for (int j = 0; j < 4; ++j) acc[i][j] = 0.f;
    const int lt = tid & 255, lrow = lt >> 1, lhalf = lt & 1;
    const bf16_t* src = (tid < 256) ? (A + (size_t)(m0 + lrow) * K + 8 * lhalf) : (Bt + (size_t)(n0 + lrow) * K + 8 * lhalf);
    float (*dst)[132] = (tid < 256) ? As : Bs;
    for (int k0 = 0; k0 < K; k0 += 16) {
        const v4u w = *(const v4u*)(src + k0);
        __syncthreads();
#pragma unroll
        for (int e = 0; e < 4; ++e) { dst[8 * lhalf + 2 * e][lrow] = bf2f(w[e] & 0xffffu); dst[8 * lhalf + 2 * e + 1][lrow] = bf2f(w[e] >> 16); }
        __syncthreads();
#pragma unroll
        for (int kk = 0; kk < 16; ++kk) {
            const f32x4 a0 = *(const f32x4*)&As[kk][ty * 8], a1 = *(const f32x4*)&As[kk][ty * 8 + 4], b = *(const f32x4*)&Bs[kk][tx * 4];
#pragma unroll
            for (int j = 0; j < 4; ++j) { acc[0][j] += a0[0] * b[j]; acc[1][j] += a0[1] * b[j]; acc[2][j] += a0[2] * b[j]; acc[3][j] += a0[3] * b[j];
                acc[4][j] += a1[0] * b[j]; acc[5][j] += a1[1] * b[j]; acc[6][j] += a1[2] * b[j]; acc[7][j] += a1[3] * b[j]; }
        }
    }
#pragma unroll
    for (int i = 0; i < 8; ++i)
#pragma unroll
        for (int j = 0; j < 4; ++j) E.put(m0 + ty * 8 + i, n0 + tx * 4 + j, acc[i][j]);
}

struct AttnP { const bf16_t *Q, *K, *V; bf16_t* O; const float* cs; const float* sinks; int qpitch, kvpitch, gq, ocol0, mode, pad; };
__global__ void __launch_bounds__(512) k_naive_attn(AttnP A) {
    const int lane = threadIdx.x & 63; const int gw = blockIdx.x * 8 + (threadIdx.x >> 6), NGW = gridDim.x * 8;
    for (int idx = gw; idx < NB * 16 * SEQ; idx += NGW) {
        const int t = idx % SEQ, h = (idx / SEQ) % 16, b = idx / (SEQ * 16);
        const size_t rb = (size_t)b * SEQ;
        float q[64];
        { const bf16_t* qp = A.Q + (rb + t) * A.qpitch + h * 64;
#pragma unroll
          for (int i = 0; i < 8; ++i) { const v4u w = ((const v4u*)qp)[i];
#pragma unroll
              for (int e = 0; e < 4; ++e) { q[8 * i + 2 * e] = bf2f(w[e] & 0xffffu); q[8 * i + 2 * e + 1] = bf2f(w[e] >> 16); } } }
        const int kvh = h / A.gq;
        const float slope = exp2f(-0.5f * (float)(h + 1)) * LOG2E;
        const float* cs = A.cs ? A.cs + ((size_t)b * 16 + h) * SEQ : nullptr;
        const float ct = (A.mode == 1) ? cs[t] : 0.f;
        const int slo = (A.mode == 0) ? (t - (WIN - 1) > 0 ? t - (WIN - 1) : 0) : 0;
        float m = -INFINITY, l = 0.f, acc = 0.f;
        for (int s0 = slo & ~63; s0 <= t; s0 += 64) {
            const int s = s0 + lane;
            const bf16_t* kp = A.K + (rb + s) * A.kvpitch + kvh * 64;
            float d = 0.f;
#pragma unroll
            for (int i = 0; i < 8; ++i) { const v4u w = ((const v4u*)kp)[i];
#pragma unroll
                for (int e = 0; e < 4; ++e) { d += q[8 * i + 2 * e] * bf2f(w[e] & 0xffffu); d += q[8 * i + 2 * e + 1] * bf2f(w[e] >> 16); } }
            float x;
            if (s > t || s < slo) x = -INFINITY;
            else x = d + ((A.mode == 1) ? (ct - cs[s]) : (-slope * (float)(t - s)));
            const float cm = wave_max(x);
            const float mn = fmaxf(m, cm);
            const float f = exp2f(m - mn), p = exp2f(x - mn);
            l = l * f + wave_sum(p); acc *= f; m = mn;
            const bf16_t* vp = A.V + (rb + s0) * A.kvpitch + kvh * 64 + lane;
            for (int j = 0; j < 64; ++j) { const float pj = __shfl(p, j); acc += pj * bf2f(vp[(size_t)j * A.kvpitch]); }
        }
        if (A.mode == 0) l += exp2f(A.sinks[h] * LOG2E - m);
        A.O[(rb + t) * DM + A.ocol0 + h * 64 + lane] = (bf16_t)f2bf(acc / l);
    }
}

__device__ __forceinline__ float gelu_tanh(float x) {
    const float z = 0.7978845608028654f * (x + 0.044715f * x * x * x);
    return x / (1.0f + exp2f(-2.0f * LOG2E * z));
}
__global__ void __launch_bounds__(512) k_naive_conv(const float* U, const float* cw, const float* cb, bf16_t* act, long chunkl) {
    const int chunk = (int)chunkl;
    for (size_t i = (size_t)blockIdx.x * 512 + threadIdx.x; i < (size_t)M * 512; i += (size_t)gridDim.x * 512) {
        const int r = (int)(i / 512), e = (int)(i % 512), j = e >> 7, ii = e & 127;
        const int n = 128 * (4 * chunk + j) + ii, t = r % SEQ;
        float gv = cb[n], vv = cb[DFF + n];
#pragma unroll
        for (int kk = 0; kk < 3; ++kk) { const int dt = 2 - kk; if (t - dt >= 0) {
            gv += cw[(size_t)kk * NUP + n] * U[(size_t)(r - dt) * 1024 + 256 * j + ii];
            vv += cw[(size_t)kk * NUP + DFF + n] * U[(size_t)(r - dt) * 1024 + 256 * j + 128 + ii]; } }
        act[(size_t)r * DFF + n] = (bf16_t)f2bf(gelu_tanh(gv) * vv);
    }
}

extern "C" void kernel_launch(void* const* d_in, const int* in_sizes, int n_in, void* d_out, int out_size, void* d_ws, size_t ws_size, hipStream_t stream) {
    if (n_in != 15 || ws_size < WS_END || out_size != M * DM) { fprintf(stderr, "kernel_launch: unexpected sizes n_in %d ws %zu out %d\n", n_in, ws_size, out_size); return; }
    Ptrs P{};
    const float** pp = (const float**)&P;
    for (int i = 0; i < 15; ++i) pp[i] = (const float*)d_in[i];
    P.out = (float*)d_out; P.ws = (unsigned char*)d_ws;
    unsigned char* ws = P.ws;
    const int G = 1024;
    k_prologue<<<2048, 256, 0, stream>>>(P);
    k_prenorm<<<G, 512, 0, stream>>>(P);
    k_naive_gemm<EpiInProj><<<dim3(DINP / 128, M / 128), 512, 0, stream>>>((const bf16_t*)(ws + WS_XN), (const bf16_t*)(ws + WS_WIN), (long)DM, EpiInProj{ws});
    k_cscan<<<8, 512, 0, stream>>>(P);
    AttnP a0{(const bf16_t*)(ws + WS_QA), (const bf16_t*)(ws + WS_KA), (const bf16_t*)(ws + WS_VA), (bf16_t*)(ws + WS_O), nullptr, P.sinks, 1024, 128, 8, 0, 0, 0};
    AttnP a1{(const bf16_t*)(ws + WS_QB), (const bf16_t*)(ws + WS_KB), (const bf16_t*)(ws + WS_VB), (bf16_t*)(ws + WS_O), (const float*)(ws + WS_CS), nullptr, 1024, 1024, 1, 1024, 1, 0};
    k_naive_attn<<<G, 512, 0, stream>>>(a0);
    k_naive_attn<<<G, 512, 0, stream>>>(a1);
    k_groupnorm<<<G, 512, 0, stream>>>(P);
    k_naive_gemm<EpiF32><<<dim3(DM / 128, M / 128), 512, 0, stream>>>((const bf16_t*)(ws + WS_O), (const bf16_t*)(ws + WS_WOUT), (long)DM, EpiF32{(float*)(ws + WS_MIX), DM, 0});
    k_postmix<<<G, 512, 0, stream>>>(P);
    for (int c = 0; c < 11; ++c) {
        k_naive_gemm<EpiF32><<<dim3(1024 / 128, M / 128), 512, 0, stream>>>((const bf16_t*)(ws + WS_XN), (const bf16_t*)(ws + WS_WUP) + (size_t)c * 1024 * DM, (long)DM, EpiF32{(float*)(ws + WS_MIX), 1024, 0});
        k_naive_conv<<<G, 512, 0, stream>>>((const float*)(ws + WS_MIX), P.conv_w, P.conv_b, (bf16_t*)(ws + WS_ACT), (long)c);
    }
    k_naive_gemm<EpiF32><<<dim3(DM / 128, M / 128), 512, 0, stream>>>((const bf16_t*)(ws + WS_ACT), (const bf16_t*)(ws + WS_WDN), (long)DFF, EpiF32{(float*)(ws + WS_MIX), DM, 0});
    k_final<<<G, 512, 0, stream>>>(P);
}
```

```cpp
#include <hip/hip_runtime.h>
#include <hip/hip_cooperative_groups.h>
namespace cg = cooperative_groups;
#include <cstdio>
#include <cstdint>

constexpr int NB = 4, SEQ = 4096, DM = 2048, M = NB * SEQ;
constexpr int HD = 64, NHA = 16, NKVA = 2, NHB = 16, WIN = 128, DFF = 5632, NUP = 2 * DFF;
constexpr int DIN = 4368, DINP = 4608;
constexpr float EPS = 1e-6f;
constexpr float LOG2E = 1.4426950408889634f;
constexpr float C2 = 0.125f * LOG2E;

constexpr size_t MiB = 1u << 20;
constexpr size_t WS_WIN = 0, WS_WOUT = 18 * MiB, WS_WUP = 26 * MiB, WS_WDN = 70 * MiB;
constexpr size_t WS_XN = 92 * MiB;
constexpr size_t WS_CS = 156 * MiB, WS_F = 157 * MiB, WS_SIDE = 158 * MiB;
constexpr size_t WS_QA = 170 * MiB, WS_KA = 202 * MiB, WS_VA = 206 * MiB, WS_QB = 210 * MiB, WS_KB = 242 * MiB, WS_VB = 274 * MiB, WS_O = 306 * MiB;
constexpr size_t WS_ACT = 170 * MiB;
constexpr size_t WS_MIX = 370 * MiB, WS_Y = 434 * MiB;
constexpr size_t WS_CTL = 169 * MiB + 768 * 1024, CTL_BYTES = 64 * 1024;
constexpr size_t WS_END = 498 * MiB;

typedef unsigned short bf16_t;
typedef unsigned v4u __attribute__((ext_vector_type(4)));
typedef float f32x4 __attribute__((ext_vector_type(4)));

__device__ __forceinline__ unsigned f2bf(float f) { unsigned u = __builtin_bit_cast(unsigned, f); return (u + 0x7fffu + ((u >> 16) & 1u)) >> 16; }
__device__ __forceinline__ unsigned pk2(float lo, float hi) { return f2bf(lo) | (f2bf(hi) << 16); }
__device__ __forceinline__ float bf2f(unsigned h) { return __builtin_bit_cast(float, h << 16); }
__device__ __forceinline__ float wave_sum(float v) {
#pragma unroll
    for (int o = 1; o < 64; o <<= 1) v += __shfl_xor(v, o);
    return v;
}
__device__ __forceinline__ float wave_max(float v) {
#pragma unroll
    for (int o = 1; o < 64; o <<= 1) v = fmaxf(v, __shfl_xor(v, o));
    return v;
}

__device__ __forceinline__ int rowmap(int n, int map) {
    if (map == 0) return n;
    if (n < DFF) return ((n >> 7) << 8) + (n & 127);
    const int g = n - DFF; return ((g >> 7) << 8) + 128 + (g & 127);
}
__device__ __forceinline__ void transpose_item(const float* W, int K, int N, int Npad, bf16_t* WT, int map, float* scr, int item, int lane, const float* ks0 = nullptr, const float* ks1 = nullptr) {
    const int nblk = Npad / 32, kb = item / nblk, nb = item % nblk, k0 = 128 * kb, n0 = 32 * nb;
    { const int n4 = lane & 7, n = n0 + 4 * n4;
      f32x4 w[16];
#pragma unroll
      for (int i = 0; i < 16; ++i) { const int kk = (lane >> 3) + 8 * i; w[i] = (n < N) ? *(const f32x4*)(W + (size_t)(k0 + kk) * N + n) : (f32x4){0.f, 0.f, 0.f, 0.f}; }
#pragma unroll
      for (int i = 0; i < 16; ++i) { const int kk = (lane >> 3) + 8 * i;
          if (ks0) w[i] = w[i] * ((k0 < 1024) ? ks0[k0 + kk] : ks1[k0 + kk - 1024]);
#pragma unroll
          for (int j = 0; j < 4; ++j) scr[kk * 33 + 4 * n4 + j] = w[i][j]; } }
    __builtin_amdgcn_s_waitcnt(0); asm volatile("" ::: "memory");
    const int c = lane & 15;
#pragma unroll
    for (int j = 0; j < 8; ++j) { const int n = (lane >> 4) + 4 * j; const float* s = scr + (8 * c) * 33 + n;
        v4u o; o.x = pk2(s[0 * 33], s[1 * 33]); o.y = pk2(s[2 * 33], s[3 * 33]); o.z = pk2(s[4 * 33], s[5 * 33]); o.w = pk2(s[6 * 33], s[7 * 33]);
        *(v4u*)(WT + (size_t)rowmap(n0 + n, map) * K + k0 + 8 * c) = o; }
    __builtin_amdgcn_s_waitcnt(0); asm volatile("" ::: "memory");
}
struct Ptrs {
    const float *x, *pre_mix_g, *w_in, *b_forget, *sinks, *grp_swa_g, *grp_fox_g, *w_out, *post_mix_g, *pre_ffn_g, *w_up, *conv_w, *conv_b, *w_down, *post_ffn_g;
    float* out; unsigned char* ws;
    int use_cg, pad;
};
constexpr int I_IN = (DM / 128) * (DINP / 32), I_OUT = (DM / 128) * (DM / 32), I_UP = (DM / 128) * (NUP / 32), I_DN = (DFF / 128) * (DM / 32);
constexpr int I_CUT = I_IN + I_OUT, I_ALL = I_IN + I_OUT + I_UP + I_DN;
__device__ __forceinline__ void convert_items(const Ptrs& P, float* scr_all, int lo, int hi, int gw, int NGW) {
    const int tid = threadIdx.x, lane = tid & 63, wave = tid >> 6;
    float* scr = scr_all + wave * 128 * 33;
    for (int it = lo + gw; it < hi; it += NGW) {
        int r = it;
        if (r < I_IN) { transpose_item(P.w_in, DM, DIN, DINP, (bf16_t*)(P.ws + WS_WIN), 0, scr, r, lane); continue; } r -= I_IN;
        if (r < I_OUT) { transpose_item(P.w_out, DM, DM, DM, (bf16_t*)(P.ws + WS_WOUT), 0, scr, r, lane, P.grp_swa_g, P.grp_fox_g); continue; } r -= I_OUT;
        if (r < I_UP) { transpose_item(P.w_up, DM, NUP, NUP, (bf16_t*)(P.ws + WS_WUP), 1, scr, r, lane); continue; } r -= I_UP;
        transpose_item(P.w_down, DFF, DM, DM, (bf16_t*)(P.ws + WS_WDN), 0, scr, r, lane);
    }
}
__device__ __forceinline__ void ph_prologue(const Ptrs& P, float* scr_all) {
    const int tid = threadIdx.x;
    const bool defer = (gridDim.x == 256);
    convert_items(P, scr_all, 0, defer ? I_CUT : I_ALL, blockIdx.x * 8 + (tid >> 6), gridDim.x * 8);
    for (int i = blockIdx.x * 512 + tid; i < M * 2; i += gridDim.x * 512) ((float*)(P.ws + WS_CS))[i] = 0.f;
}

__device__ __forceinline__ void row_load(const float* row, int lane, f32x4 (&v)[8]) {
#pragma unroll
    for (int j = 0; j < 8; ++j) v[j] = ((const f32x4*)row)[lane + 64 * j];
}
__device__ __forceinline__ void row_load_bf16(const bf16_t* row, int lane, f32x4 (&v)[8]) {
#pragma unroll
    for (int j = 0; j < 8; ++j) { const unsigned long long w = ((const unsigned long long*)row)[lane + 64 * j];
        v[j] = (f32x4){bf2f((unsigned)w & 0xffffu), bf2f(((unsigned)w >> 16)), bf2f((unsigned)(w >> 32) & 0xffffu), bf2f((unsigned)(w >> 48))}; }
}
__device__ __forceinline__ float row_sumsq(const f32x4 (&v)[8]) {
    float s = 0.f;
#pragma unroll
    for (int j = 0; j < 8; ++j) s += (v[j].x * v[j].x + v[j].y * v[j].y) + (v[j].z * v[j].z + v[j].w * v[j].w);
    return wave_sum(s);
}
__device__ __forceinline__ void row_store_bf16(bf16_t* orow, int lane, const f32x4 (&v)[8]) {
#pragma unroll
    for (int j = 0; j < 8; ++j) ((unsigned long long*)orow)[lane + 64 * j] = (unsigned long long)pk2(v[j].x, v[j].y) | ((unsigned long long)pk2(v[j].z, v[j].w) << 32);
}
__device__ __forceinline__ void pass_prenorm(const float* x, const float* g, bf16_t* xn, float* r0s, int gw, int NGW, int lane) {
    f32x4 gv[8]; row_load(g, lane, gv);
    for (int m = gw; m < M; m += NGW) {
        f32x4 v[8]; row_load(x + (size_t)m * DM, lane, v);
        const float r = 1.0f / sqrtf(row_sumsq(v) * (1.0f / DM) + EPS);
#pragma unroll
        for (int j = 0; j < 8; ++j) v[j] = v[j] * r * gv[j];
        row_store_bf16(xn + (size_t)m * DM, lane, v);
        if (lane == 0) r0s[m] = r;
    }
}
__device__ __forceinline__ void pass_postmix(bf16_t* xn, const float* r0s, const float* gpm, const bf16_t* mix, const float* gpost, const float* gpre, float* r2s, int gw, int NGW, int lane) {
    f32x4 ig[8]; row_load(gpm, lane, ig);
#pragma unroll
    for (int j = 0; j < 8; ++j) { ig[j][0] = __builtin_amdgcn_rcpf(ig[j][0]); ig[j][1] = __builtin_amdgcn_rcpf(ig[j][1]); ig[j][2] = __builtin_amdgcn_rcpf(ig[j][2]); ig[j][3] = __builtin_amdgcn_rcpf(ig[j][3]); }
    for (int m = gw; m < M; m += NGW) {
        f32x4 v[8], xv[8], gv[8]; row_load_bf16(mix + (size_t)m * DM, lane, v); row_load_bf16(xn + (size_t)m * DM, lane, xv); row_load(gpost, lane, gv);
        const float ir0 = __builtin_amdgcn_rcpf(r0s[m]);
        const float r = 1.0f / sqrtf(row_sumsq(v) * (1.0f / DM) + EPS);
#pragma unroll
        for (int j = 0; j < 8; ++j) v[j] = xv[j] * ig[j] * ir0 + v[j] * r * gv[j];
        const float r2 = 1.0f / sqrtf(row_sumsq(v) * (1.0f / DM) + EPS);
        row_load(gpre, lane, gv);
#pragma unroll
        for (int j = 0; j < 8; ++j) v[j] = v[j] * r2 * gv[j];
        row_store_bf16(xn + (size_t)m * DM, lane, v);
        if (lane == 0) r2s[m] = r2;
    }
}
__device__ __forceinline__ void pass_final(const bf16_t* xn, const float* r2s, const float* gpre, const bf16_t* y, const float* g, float* out, int gw, int NGW, int lane) {
    f32x4 ig[8]; row_load(gpre, lane, ig);
#pragma unroll
    for (int j = 0; j < 8; ++j) { ig[j][0] = __builtin_amdgcn_rcpf(ig[j][0]); ig[j][1] = __builtin_amdgcn_rcpf(ig[j][1]); ig[j][2] = __builtin_amdgcn_rcpf(ig[j][2]); ig[j][3] = __builtin_amdgcn_rcpf(ig[j][3]); }
    f32x4 gv[8]; row_load(g, lane, gv);
    for (int m = gw; m < M; m += NGW) {
        f32x4 v[8], xv[8]; row_load_bf16(xn + (size_t)m * DM, lane, xv); row_load_bf16(y + (size_t)m * DM, lane, v);
        const float ir2 = __builtin_amdgcn_rcpf(r2s[m]);
        const float r = 1.0f / sqrtf(row_sumsq(v) * (1.0f / DM) + EPS);
#pragma unroll
        for (int j = 0; j < 8; ++j) ((f32x4*)(out + (size_t)m * DM))[lane + 64 * j] = xv[j] * ig[j] * ir2 + v[j] * r * gv[j];
    }
}
__device__ __forceinline__ float log_sigmoid(float z) { return z >= 0.f ? -log1pf(expf(-z)) : z - log1pf(expf(z)); }
__device__ __forceinline__ float gelu_tanh(float x) {
    const float z = 0.7978845608028654f * (x + 0.044715f * x * x * x);
    return x / (1.0f + exp2f(-2.0f * LOG2E * z));
}
namespace pg8 {
#define PG8_LAS __attribute__((address_space(3)))
typedef unsigned short bf16_t;
typedef short bf16x8 __attribute__((ext_vector_type(8)));
typedef float f32x4 __attribute__((ext_vector_type(4)));
typedef unsigned u32x4 __attribute__((ext_vector_type(4)));
constexpr int BM = 256, BK = 64, HALF = 128, HTB = HALF * BK * 2  , STAGE_BYTES = 8 * HTB, NXCD = 8, WGM = 8;

__host__ __device__ __forceinline__ int lds_byte(int r, int c) { const int st = (r >> 4) * 2 + (c >> 5), rr = r & 15, cc = c & 31, ob = rr * 64 + cc * 2; return st * 1024 + (ob ^ (((ob >> 9) & 1) << 5)); }
__host__ __device__ __forceinline__ void stage_rc(int b, int& R, int& C) { const int st = b / 1024, sb = b % 1024, swz = sb ^ (((sb >> 9) & 1) << 5); R = (st >> 1) * 16 + swz / 64; C = (st & 1) * 32 + (swz % 64) / 2; }
__host__ __device__ __forceinline__ int perm32(int rho) { const int n = rho >> 4, i = rho & 15; return 8 * (i >> 2) + 4 * n + (i & 3); }

struct Unit { int pm, pn; };
struct Gemm { const bf16_t* A; const bf16_t* Bt; int M, N, K; };

struct StaticOrder {
    int nM, nN, nwg, G, c;
    __host__ __device__ void init(int M, int N, int G_, int c_) { nM = M / BM; nN = N / BM; nwg = nM * nN; G = G_; c = c_; }
    __host__ __device__ bool next(int i, Unit& u) const {
        const long L = (long)i * G + c; if (L >= nwg) return false;
        int wgid = (int)L; { const int q = nwg / NXCD, r = nwg % NXCD, xcd = wgid % NXCD, off = wgid / NXCD; wgid = (xcd < r ? xcd * (q + 1) : r * (q + 1) + (xcd - r) * q) + off; }
        const int nig = WGM * nN, gid = wgid / nig, fm = gid * WGM, gsz = (nM - fm) < WGM ? (nM - fm) : WGM;
        u.pm = fm + ((wgid % nig) % gsz); u.pn = (wgid % nig) / gsz; return true;
    }
    __device__ __forceinline__ void a_ready(const Unit&) const {}
    __device__ __forceinline__ void done(const Unit&) const {}
};

__device__ __forceinline__ unsigned cvt_pk_bf16(float lo, float hi) { unsigned r; asm volatile("v_cvt_pk_bf16_f32 %0, %1, %2" : "=v"(r) : "v"(lo), "v"(hi)); return r; }
typedef float f32x2 __attribute__((ext_vector_type(2)));
template <class Epi, class Sched, bool ALIGN_EPI = false, bool SP2 = false>
__device__ __forceinline__ void gemm_phase(PG8_LAS unsigned char* lds, const Gemm g, const Sched& S, const Epi& E) {
    int tid = threadIdx.x; asm volatile("" : "+v"(tid));
    const int wid = __builtin_amdgcn_readfirstlane(tid >> 6), lane = tid & 63, wr = wid >> 2, wc = wid & 3, fr = lane & 15, fq = lane >> 4;
    const int K = g.K, nt = K / BK;
    unsigned voffA[2], voffB[2];
#pragma unroll
    for (int i = 0; i < 2; ++i) { int R, C; stage_rc(tid * 16 + i * 8192, R, C); const int Rb = Epi::PERM ? ((R & ~31) + perm32(R & 31)) : R;
        voffA[i] = (unsigned)(R * K + C) * 2u; voffB[i] = (unsigned)(Rb * K + C) * 2u; }
    const size_t kstep = (size_t)(BK * 2);
    const size_t hstep = (size_t)HALF * K * 2;
    const size_t tstep = 2 * hstep;
    const unsigned ldsw = (unsigned)wid * 1024u;
    const int aoff = lds_byte(wr * 64 + fr, fq * 8), boff = lds_byte(wc * 32 + fr, fq * 8);
#define PG8_SA(b, h) (((b) * 2 + (h)) * HTB)
#define PG8_SB(b, h) ((4 + (b) * 2 + (h)) * HTB)
#define PG8_STAGE(bufoff, gbase, voff) do { _Pragma("unroll") for (int _i = 0; _i < 2; ++_i) \
        __builtin_amdgcn_global_load_lds((const unsigned*)((const char*)(gbase) + (voff)[_i]), (PG8_LAS unsigned*)(lds + (bufoff) + ldsw + _i * 8192), 16, 0, 0); } while (0)
#define PG8_LDA(dst, b, h) do { _Pragma("unroll") for (int m = 0; m < 4; ++m) _Pragma("unroll") for (int k = 0; k < 2; ++k) dst[m][k] = *(const PG8_LAS bf16x8*)(lds + PG8_SA(b, h) + aoff + m * 2048 + k * 1024); } while (0)
#define PG8_LDB(dst, b, h) do { _Pragma("unroll") for (int n = 0; n < 2; ++n) _Pragma("unroll") for (int k = 0; k < 2; ++k) dst[n][k] = *(const PG8_LAS bf16x8*)(lds + PG8_SB(b, h) + boff + n * 2048 + k * 1024); } while (0)
#define PG8_MMA(ai, bj, At, Bt) do { __builtin_amdgcn_s_setprio(1); _Pragma("unroll") for (int m = 0; m < 4; ++m) _Pragma("unroll") for (int n = 0; n < 2; ++n) _Pragma("unroll") for (int k = 0; k < 2; ++k) \
        acc[ai][bj][m][n] = __builtin_amdgcn_mfma_f32_16x16x32_bf16(Bt[n][k], At[m][k], acc[ai][bj][m][n], 0, 0, 0); __builtin_amdgcn_s_setprio(0); } while (0)
#define PG8_WAIT_V(n) asm volatile("s_waitcnt vmcnt(" #n ")" ::: "memory")
#define PG8_WAIT_L(n) asm volatile("s_waitcnt lgkmcnt(" #n ")" ::: "memory")
#define PG8_BAR __builtin_amdgcn_s_barrier()
#define PG8_SCHED __builtin_amdgcn_sched_barrier(0)
    Unit cur, nxt; int ui = 0;
    if (!S.next(0, cur)) return;
    f32x4 acc[2][2][4][2];
#pragma unroll
    for (int a = 0; a < 2; ++a)
#pragma unroll
        for (int b = 0; b < 2; ++b)
#pragma unroll
            for (int m = 0; m < 4; ++m)
#pragma unroll
                for (int n = 0; n < 2; ++n) acc[a][b][m][n] = (f32x4){0.f, 0.f, 0.f, 0.f};
    bf16x8 At[4][2], B0[2][2], B1[2][2];
    const char* cA = (const char*)g.A + (size_t)cur.pm * tstep; const char* cB = (const char*)g.Bt + (size_t)cur.pn * tstep;
    S.a_ready(cur);
    if constexpr (SP2) {
        PG8_STAGE(PG8_SB(0, 0), cB, voffB); PG8_STAGE(PG8_SB(0, 1), cB + hstep, voffB); PG8_STAGE(PG8_SA(0, 0), cA, voffA); PG8_STAGE(PG8_SA(0, 1), cA + hstep, voffA);
        if (wr == 1) PG8_BAR;
        PG8_WAIT_V(2); PG8_BAR;
        PG8_STAGE(PG8_SB(1, 0), cB + kstep, voffB); PG8_STAGE(PG8_SA(1, 0), cA + kstep, voffA); PG8_STAGE(PG8_SB(1, 1), cB + hstep + kstep, voffB);
        PG8_WAIT_V(6); PG8_BAR;
    } else {
        PG8_STAGE(PG8_SB(0, 0), cB, voffB); PG8_STAGE(PG8_SA(0, 0), cA, voffA); PG8_STAGE(PG8_SB(0, 1), cB + hstep, voffB); PG8_STAGE(PG8_SA(0, 1), cA + hstep, voffA);
        if (wr == 1) PG8_BAR;
        PG8_WAIT_V(4); PG8_BAR;
        PG8_STAGE(PG8_SB(1, 0), cB + kstep, voffB); PG8_STAGE(PG8_SA(1, 0), cA + kstep, voffA); PG8_STAGE(PG8_SB(1, 1), cB + hstep + kstep, voffB);
        PG8_WAIT_V(6); PG8_BAR;
    }
    for (;;) {
        const bool has_next = S.next(ui + 1, nxt);
        const char* nA = has_next ? (const char*)g.A + (size_t)nxt.pm * tstep : cA; const char* nB = has_next ? (const char*)g.Bt + (size_t)nxt.pn * tstep : cB;
        for (int t = 0; t < nt; t += 2) {
            if constexpr (Epi::MIDK) { if (t == nt / 2) E.midk(acc, ui, wr, fr); }
            const bool last = (t == nt - 2);
            const char* a1 = cA + (size_t)(t + 1) * kstep;
            const char* a2 = last ? nA : cA + (size_t)(t + 2) * kstep; const char* b2 = last ? nB : cB + (size_t)(t + 2) * kstep;
            const char* a3 = a2 + kstep; const char* b3 = b2 + kstep;
            if (last && has_next) S.a_ready(nxt);
            if constexpr (SP2) {
            PG8_LDB(B0, 0, 0); PG8_LDB(B1, 0, 1); PG8_SCHED; PG8_LDA(At, 0, 0); PG8_STAGE(PG8_SA(1, 1), a1 + hstep, voffA);
            PG8_WAIT_V(8); PG8_WAIT_L(0); PG8_BAR; PG8_MMA(0, 0, At, B0); PG8_MMA(0, 1, At, B1); PG8_BAR; PG8_SCHED;
            PG8_LDA(At, 0, 1); PG8_STAGE(PG8_SB(0, 0), b2, voffB); PG8_STAGE(PG8_SB(0, 1), b2 + hstep, voffB); PG8_STAGE(PG8_SA(0, 0), a2, voffA);
            PG8_WAIT_V(8); PG8_WAIT_L(0); PG8_BAR; PG8_MMA(1, 0, At, B0); PG8_MMA(1, 1, At, B1); PG8_BAR; PG8_SCHED;
            PG8_LDB(B0, 1, 0); PG8_LDB(B1, 1, 1); PG8_SCHED; PG8_LDA(At, 1, 0); PG8_STAGE(PG8_SA(0, 1), a2 + hstep, voffA);
            PG8_WAIT_V(8); PG8_WAIT_L(0); PG8_BAR; PG8_MMA(0, 0, At, B0); PG8_MMA(0, 1, At, B1); PG8_BAR; PG8_SCHED;
            PG8_LDA(At, 1, 1); PG8_STAGE(PG8_SB(1, 0), b3, voffB); PG8_STAGE(PG8_SB(1, 1), b3 + hstep, voffB); PG8_STAGE(PG8_SA(1, 0), a3, voffA);
            PG8_WAIT_V(8); PG8_WAIT_L(0); PG8_BAR; PG8_MMA(1, 0, At, B0); PG8_MMA(1, 1, At, B1); PG8_BAR; PG8_SCHED;
            } else {
            PG8_LDB(B0, 0, 0); PG8_SCHED; PG8_LDA(At, 0, 0); PG8_STAGE(PG8_SA(1, 1), a1 + hstep, voffA);
            PG8_WAIT_L(8); PG8_BAR; PG8_WAIT_L(0); PG8_MMA(0, 0, At, B0); PG8_BAR; PG8_SCHED;
            PG8_LDB(B1, 0, 1); PG8_STAGE(PG8_SB(0, 0), b2, voffB);
            PG8_BAR; PG8_WAIT_L(0); PG8_MMA(0, 1, At, B1); PG8_BAR;
            PG8_LDA(At, 0, 1); PG8_STAGE(PG8_SA(0, 0), a2, voffA);
            PG8_BAR; PG8_WAIT_L(0); PG8_MMA(1, 0, At, B0); PG8_BAR; PG8_SCHED;
            PG8_STAGE(PG8_SB(0, 1), b2 + hstep, voffB);
            PG8_WAIT_V(6); PG8_BAR; PG8_MMA(1, 1, At, B1); PG8_BAR;
            PG8_LDB(B0, 1, 0); PG8_SCHED; PG8_LDA(At, 1, 0); PG8_STAGE(PG8_SA(0, 1), a2 + hstep, voffA);
            PG8_WAIT_L(8); PG8_BAR; PG8_WAIT_L(0); PG8_MMA(0, 0, At, B0); PG8_BAR; PG8_SCHED;
            PG8_LDB(B1, 1, 1); PG8_STAGE(PG8_SB(1, 0), b3, voffB);
            PG8_BAR; PG8_WAIT_L(0); PG8_MMA(0, 1, At, B1); PG8_BAR;
            PG8_LDA(At, 1, 1); PG8_STAGE(PG8_SA(1, 0), a3, voffA);
            PG8_BAR; PG8_WAIT_L(0); PG8_MMA(1, 0, At, B0); PG8_BAR; PG8_SCHED;
            PG8_STAGE(PG8_SB(1, 1), b3 + hstep, voffB);
            PG8_WAIT_V(6); PG8_BAR; PG8_MMA(1, 1, At, B1); PG8_BAR;
            }
        }
        if constexpr (ALIGN_EPI) { if (wr == 0) PG8_BAR; }
        if constexpr (Epi::MIDK) { E.epi(acc, cur, ui, wr, wc, fr, fq); S.done(cur); }
        else if constexpr (!Epi::AFTER_DRAIN) { E(acc, cur, wr, wc, fr, fq); S.done(cur); }
        if (!has_next) break;
#pragma unroll
        for (int a = 0; a < 2; ++a)
#pragma unroll
            for (int b = 0; b < 2; ++b)
#pragma unroll
                for (int m = 0; m < 4; ++m)
#pragma unroll
                    for (int n = 0; n < 2; ++n) acc[a][b][m][n] = (f32x4){0.f, 0.f, 0.f, 0.f};
        cur = nxt; cA = nA; cB = nB; ++ui;
        if constexpr (ALIGN_EPI) { if (wr == 1) PG8_BAR; }
    }
    PG8_WAIT_V(0);
    if constexpr (!ALIGN_EPI) { if (wr == 0) PG8_BAR; }
    PG8_BAR;
    if constexpr (Epi::AFTER_DRAIN) { E.fused(acc, cur, wr, wc, fr, fq, lds, wid, lane); S.done(cur); }
#undef PG8_SA
#undef PG8_SB
#undef PG8_STAGE
#undef PG8_LDA
#undef PG8_LDB
#undef PG8_MMA
#undef PG8_WAIT_V
#undef PG8_WAIT_L
#undef PG8_BAR
#undef PG8_SCHED
}
}

namespace pg8 {
struct EpiInProjT {
    static constexpr bool PERM = true, AFTER_DRAIN = false, MIDK = false;
    unsigned char* ws;
    __device__ __forceinline__ void operator()(const f32x4 (&acc)[2][2][4][2], const Unit& u, int wr, int wc, int fr, int fq) const {
        const int row0 = u.pm * BM + wr * 64 + fr, pn = u.pn, cin = wc * 32 + 8 * fq;
        if (pn == 17) {
            if (wc == 0 && fq < 2) { float* F = (float*)(ws + WS_F);
#pragma unroll
                for (int ai = 0; ai < 2; ++ai)
#pragma unroll
                    for (int m = 0; m < 4; ++m)
#pragma unroll
                        for (int n = 0; n < 2; ++n)
#pragma unroll
                            for (int j = 0; j < 4; ++j) F[(size_t)(8 * fq + 4 * n + j) * M + row0 + ai * HALF + m * 16] = acc[ai][0][m][n][j]; }
            return;
        }
        bf16_t *b0, *b1; int ldc; float sc = 1.f;
        if (pn < 4) { b0 = (bf16_t*)(ws + WS_QA) + pn * 256 + cin; b1 = b0 + HALF; ldc = 1024; sc = C2; }
        else if (pn == 4) { b0 = (bf16_t*)(ws + WS_KA) + cin; b1 = (bf16_t*)(ws + WS_VA) + cin; ldc = 128; }
        else if (pn < 9) { b0 = (bf16_t*)(ws + WS_QB) + (pn - 5) * 256 + cin; b1 = b0 + HALF; ldc = 1024; sc = C2; }
        else if (pn < 13) { b0 = (bf16_t*)(ws + WS_KB) + (pn - 9) * 256 + cin; b1 = b0 + HALF; ldc = 1024; }
        else { b0 = (bf16_t*)(ws + WS_VB) + (pn - 13) * 256 + cin; b1 = b0 + HALF; ldc = 1024; }
#pragma unroll
        for (int ai = 0; ai < 2; ++ai)
#pragma unroll
            for (int m = 0; m < 4; ++m) { const size_t ro = (size_t)(row0 + ai * HALF + m * 16) * ldc;
#pragma unroll
                for (int bj = 0; bj < 2; ++bj) { const f32x4 v0 = acc[ai][bj][m][0] * sc, v1 = acc[ai][bj][m][1] * sc;
                    u32x4 w; w.x = cvt_pk_bf16(v0[0], v0[1]); w.y = cvt_pk_bf16(v0[2], v0[3]); w.z = cvt_pk_bf16(v1[0], v1[1]); w.w = cvt_pk_bf16(v1[2], v1[3]);
                    *(u32x4*)((bj ? b1 : b0) + ro) = w; } }
    }
};
struct EpiBf16T {
    static constexpr bool PERM = true, AFTER_DRAIN = false, MIDK = false;
    bf16_t* C; int ldc;
    __device__ __forceinline__ void operator()(const f32x4 (&acc)[2][2][4][2], const Unit& u, int wr, int wc, int fr, int fq) const {
        const int row0 = u.pm * BM + wr * 64 + fr, col0 = u.pn * BM + wc * 32 + 8 * fq;
#pragma unroll
        for (int ai = 0; ai < 2; ++ai)
#pragma unroll
            for (int m = 0; m < 4; ++m) { bf16_t* rp = C + (size_t)(row0 + ai * HALF + m * 16) * ldc + col0;
#pragma unroll
                for (int bj = 0; bj < 2; ++bj) { const f32x4 v0 = acc[ai][bj][m][0], v1 = acc[ai][bj][m][1];
                    u32x4 w; w.x = cvt_pk_bf16(v0[0], v0[1]); w.y = cvt_pk_bf16(v0[2], v0[3]); w.z = cvt_pk_bf16(v1[0], v1[1]); w.w = cvt_pk_bf16(v1[2], v1[3]);
                    *(u32x4*)(rp + bj * HALF) = w; } }
    }
};
struct EpiOutT {
    static constexpr bool PERM = true, AFTER_DRAIN = false, MIDK = true;
    bf16_t* C; int ldc; const PG8_LAS float* T;
    __device__ __forceinline__ void midk(f32x4 (&acc)[2][2][4][2], int ui, int wr, int fr) const {
#pragma unroll
        for (int ai = 0; ai < 2; ++ai)
#pragma unroll
            for (int m = 0; m < 4; ++m) { const float r = T[((ui & 1) * 256 + ai * HALF + wr * 64 + m * 16 + fr) * 2];
#pragma unroll
                for (int bj = 0; bj < 2; ++bj)
#pragma unroll
                    for (int n = 0; n < 2; ++n) acc[ai][bj][m][n] *= r; }
    }
    __device__ __forceinline__ void epi(const f32x4 (&acc)[2][2][4][2], const Unit& u, int ui, int wr, int wc, int fr, int fq) const {
        const int row0 = u.pm * BM + wr * 64 + fr, col0 = u.pn * BM + wc * 32 + 8 * fq;
#pragma unroll
        for (int ai = 0; ai < 2; ++ai)
#pragma unroll
            for (int m = 0; m < 4; ++m) { bf16_t* rp = C + (size_t)(row0 + ai * HALF + m * 16) * ldc + col0; const float r = T[((ui & 1) * 256 + ai * HALF + wr * 64 + m * 16 + fr) * 2 + 1];
#pragma unroll
                for (int bj = 0; bj < 2; ++bj) { const f32x4 v0 = acc[ai][bj][m][0] * r, v1 = acc[ai][bj][m][1] * r;
                    u32x4 w; w.x = cvt_pk_bf16(v0[0], v0[1]); w.y = cvt_pk_bf16(v0[2], v0[3]); w.z = cvt_pk_bf16(v1[0], v1[1]); w.w = cvt_pk_bf16(v1[2], v1[3]);
                    *(u32x4*)(rp + bj * HALF) = w; } }
    }
};
}

namespace pg8 {
__device__ __forceinline__ float dpp_ror1(float x) { return __builtin_bit_cast(float, __builtin_amdgcn_mov_dpp(__builtin_bit_cast(int, x), 0x121, 0xf, 0xf, true)); }
__device__ __forceinline__ float dpp_ror2(float x) { return __builtin_bit_cast(float, __builtin_amdgcn_mov_dpp(__builtin_bit_cast(int, x), 0x122, 0xf, 0xf, true)); }
__device__ __forceinline__ float gelu_tanh_fast(float x) {
    const float e = __builtin_amdgcn_exp2f(-2.3022082f * x * (1.0f + 0.044715f * x * x));
    return x * __builtin_amdgcn_rcpf(1.0f + e);
}
__device__ __forceinline__ f32x4 geglu4(f32x4 g, f32x4 v) {
    const f32x4 t = (g * g) * 0.044715f + 1.0f, a = (g * -2.3022082f) * t;
    f32x4 e; e[0] = __builtin_amdgcn_exp2f(a[0]); e[1] = __builtin_amdgcn_exp2f(a[1]); e[2] = __builtin_amdgcn_exp2f(a[2]); e[3] = __builtin_amdgcn_exp2f(a[3]);
    e = e + 1.0f;
    f32x4 r; r[0] = __builtin_amdgcn_rcpf(e[0]); r[1] = __builtin_amdgcn_rcpf(e[1]); r[2] = __builtin_amdgcn_rcpf(e[2]); r[3] = __builtin_amdgcn_rcpf(e[3]);
    return (g * v) * r;
}
constexpr size_t SIDE_HEAD = 0, SIDE_TAIL = 6 * MiB;
struct EpiUpT {
    static constexpr bool PERM = true, AFTER_DRAIN = false, MIDK = false;
    bf16_t* act; const float* cw; const float* cb; float* side; PG8_LAS float* X;
    __device__ __forceinline__ void operator()(const f32x4 (&acc)[2][2][4][2], const Unit& u, int wr, int wc, int fr, int fq) const {
        const int cin = wc * 32 + 8 * fq;
        f32x4 Wt[2][2][4];
#define EPIUP_LOADW(n_) do { _Pragma("unroll") for (int bj_ = 0; bj_ < 2; ++bj_) { const int col_ = bj_ * DFF + HALF * u.pn + cin + 4 * (n_); \
            Wt[n_][bj_][1] = *(const f32x4*)(cw + NUP + col_); Wt[n_][bj_][2] = *(const f32x4*)(cw + 2 * NUP + col_); } } while (0)
#define EPIUP_LOADB(n_) do { _Pragma("unroll") for (int bj_ = 0; bj_ < 2; ++bj_) { Wt[n_][bj_][3] = *(const f32x4*)(cb + bj_ * DFF + HALF * u.pn + cin + 4 * (n_)); Wt[n_][bj_][0] = *(const f32x4*)(cw + bj_ * DFF + HALF * u.pn + cin + 4 * (n_)); } } while (0)
        EPIUP_LOADW(0); EPIUP_LOADB(0);
        if (fr >= 14) {
#pragma unroll
            for (int ai = 0; ai < 2; ++ai)
#pragma unroll
                for (int bj = 0; bj < 2; ++bj)
#pragma unroll
                    for (int n = 0; n < 2; ++n) *(PG8_LAS f32x4*)(X + ((2 * ai + wr) * 2 + (fr - 14)) * 256 + bj * HALF + cin + 4 * n) = acc[ai][bj][3][n];
            if (wr == 1) {
#pragma unroll
                for (int bj = 0; bj < 2; ++bj)
#pragma unroll
                    for (int n = 0; n < 2; ++n) *(f32x4*)(side + SIDE_TAIL / 4 + ((size_t)u.pm * 2 + (fr - 14)) * NUP + u.pn * BM + bj * HALF + cin + 4 * n) = acc[1][bj][3][n];
            }
        }
        if (fr < 2 && wr == 0) {
#pragma unroll
            for (int bj = 0; bj < 2; ++bj)
#pragma unroll
                for (int n = 0; n < 2; ++n) *(f32x4*)(side + SIDE_HEAD / 4 + ((size_t)u.pm * 2 + fr) * NUP + u.pn * BM + bj * HALF + cin + 4 * n) = acc[0][bj][0][n];
        }
        asm volatile("s_waitcnt lgkmcnt(0)" ::: "memory"); __builtin_amdgcn_s_barrier(); asm volatile("" ::: "memory");
#pragma unroll
        for (int n = 0; n < 2; ++n) {
            if (n == 0) { EPIUP_LOADW(1); __builtin_amdgcn_sched_barrier(0); } else { EPIUP_LOADB(1); __builtin_amdgcn_sched_barrier(0); }
#pragma unroll
            for (int ai = 0; ai < 2; ++ai) {
                const int b4 = 2 * ai + wr;
                f32x4 p1[2], p2[2];
#pragma unroll
                for (int bj = 0; bj < 2; ++bj) {
                    f32x4 h62 = (f32x4){0.f, 0.f, 0.f, 0.f}, h63 = h62;
                    if (b4 > 0) { h62 = *(const PG8_LAS f32x4*)(X + ((b4 - 1) * 2 + 0) * 256 + bj * HALF + cin + 4 * n); h63 = *(const PG8_LAS f32x4*)(X + ((b4 - 1) * 2 + 1) * 256 + bj * HALF + cin + 4 * n); }
                    p1[bj] = h63; p2[bj] = (fr == 1) ? h63 : h62;
                }
#pragma unroll
                for (int m = 0; m < 4; ++m) {
                    f32x4 y[2];
#pragma unroll
                    for (int bj = 0; bj < 2; ++bj) {
                        const f32x4 v = acc[ai][bj][m][n];
                        f32x4 r1, r2;
#pragma unroll
                        for (int j = 0; j < 4; ++j) { r1[j] = dpp_ror1(v[j]); r2[j] = dpp_ror2(v[j]); }
                        const f32x4 q1 = (fr >= 1) ? r1 : p1[bj], q2 = (fr >= 2) ? r2 : p2[bj];
                        y[bj] = (Wt[n][bj][2] * v + Wt[n][bj][1] * q1) + (Wt[n][bj][0] * q2 + Wt[n][bj][3]);
                        p1[bj] = r1; p2[bj] = r2;
                    }
                    typedef unsigned u32x2v __attribute__((ext_vector_type(2)));
                    const f32x4 o4 = geglu4(y[0], y[1]); u32x2v w; w.x = cvt_pk_bf16(o4[0], o4[1]); w.y = cvt_pk_bf16(o4[2], o4[3]);
                    *(u32x2v*)(act + (size_t)(u.pm * BM + ai * HALF + wr * 64 + m * 16 + fr) * DFF + HALF * u.pn + cin + 4 * n) = w;
                    __builtin_amdgcn_sched_barrier(0);
                }
            }
            asm volatile("" ::: "memory"); __builtin_amdgcn_sched_barrier(0);
        }
#undef EPIUP_LOADW
#undef EPIUP_LOADB
    }
};
}
__device__ __forceinline__ void ph_convfix(const float* side, const float* cw, const float* cb, bf16_t* act) {
    const float* head = side + pg8::SIDE_HEAD / 4; const float* tail = side + pg8::SIDE_TAIL / 4;
    for (int idx = blockIdx.x * 512 + threadIdx.x; idx < 64 * 2 * DFF; idx += gridDim.x * 512) {
        const int pm = idx / (2 * DFF), r = (idx / DFF) & 1, n = idx % DFF;
        if ((pm & 15) == 0) continue;
        const int pg = ((n >> 7) << 8) + (n & 127);
        float y[2];
#pragma unroll
        for (int h = 0; h < 2; ++h) { const int pc = pg + 128 * h, col = h * DFF + n;
            const float H0 = head[((size_t)pm * 2 + 0) * NUP + pc], H1 = head[((size_t)pm * 2 + 1) * NUP + pc];
            const float T0 = tail[((size_t)(pm - 1) * 2 + 0) * NUP + pc], T1 = tail[((size_t)(pm - 1) * 2 + 1) * NUP + pc];
            const float w0 = cw[col], w1 = cw[NUP + col], w2 = cw[2 * NUP + col];
            y[h] = cb[col] + (r == 0 ? (w2 * H0 + w1 * T1 + w0 * T0) : (w2 * H1 + w1 * H0 + w0 * T1)); }
        act[(size_t)(256 * pm + r) * DFF + n] = (bf16_t)f2bf(gelu_tanh(y[0]) * y[1]);
    }
}
#include <hip/hip_bf16.h>
#include <cmath>
namespace attn_body {
using bf16=__hip_bfloat16;
using bf16x8=__attribute__((ext_vector_type(8)))short;
using s16x4=__attribute__((ext_vector_type(4)))short;
using f32x16=__attribute__((ext_vector_type(16)))float;
using u32x4=__attribute__((ext_vector_type(4)))unsigned;
using f32x4v=__attribute__((ext_vector_type(4)))float;
constexpr int BATCH=4,NHEAD=16,SEQ=4096,D=64,QP=1024,OP=2048;
constexpr int NW=8,QBLK=32,QB=QBLK*NW,KVBLK=64,NQB=SEQ/QB;
constexpr int ATTN_UNIT_ROWS=QB;
__device__ __forceinline__ int crow(int r,int hi){return (r&3)+8*(r>>2)+4*hi;}
#define SBAR() __builtin_amdgcn_sched_barrier(0)
template<bool WIN> __device__ __forceinline__ void amask(f32x16&p0,f32x16&p1,int koff,int qrel,int hi){
  const float NEG=-INFINITY; int d=qrel-(koff+4*hi); asm volatile("":"+v"(d));
  #pragma unroll
  for(int r=0;r<16;++r){const int kc=(r&3)+8*(r>>2);
    if(kc>d||(WIN&&kc<=d-128))p0[r]=NEG; if(kc+32>d||(WIN&&kc+32<=d-128))p1[r]=NEG;}
}

constexpr int NSLOT=3, SLOTB=8192;
constexpr int LDS_K=0, LDS_V=NSLOT*SLOTB, LDS_WS=2*NSLOT*SLOTB, LDS_OST=LDS_WS+NW*64*4, LDS_CL=LDS_OST+NW*4096+2048, LDS_CL2=LDS_CL+SEQ*4, LDS_WT=LDS_CL2+384*4, LDS_BYTES=LDS_WT+64;
constexpr float C2=0.125f*1.4426950408889634f;
__device__ __forceinline__ void glds16(const void*gsrc,unsigned lds_dst){unsigned keep;
  asm volatile("s_mov_b32 %0, m0\n\ts_mov_b32 m0, %2\n\ts_nop 0\n\tglobal_load_lds_dwordx4 %1, off\n\ts_mov_b32 m0, %0":"=&s"(keep):"v"(gsrc),"s"(lds_dst):"memory");}
__device__ __forceinline__ float max3f(float a,float b,float c){float r;asm("v_max3_f32 %0, %1, %2, %3":"=v"(r):"v"(a),"v"(b),"v"(c));return r;}
__device__ __forceinline__ float max2f(float a,float b){float r;asm("v_max_f32_e32 %0, %1, %2":"=v"(r):"v"(a),"v"(b));return r;}
__device__ __forceinline__ float fadd_s(float a,float b){float r;asm("v_add_f32_e32 %0, %1, %2":"=v"(r):"v"(a),"v"(b));return r;}
__device__ __forceinline__ float fsub_s(float a,float b){float r;asm("v_sub_f32_e32 %0, %1, %2":"=v"(r):"v"(a),"v"(b));return r;}
typedef float f32x2_t __attribute__((ext_vector_type(2))); typedef __bf16 bf16x2_t __attribute__((ext_vector_type(2)));
__device__ __forceinline__ unsigned cvtpk_s(float lo,float hi){f32x2_t v={lo,hi};bf16x2_t b=__builtin_convertvector(v,bf16x2_t);return __builtin_bit_cast(unsigned,b);}
#define WAIT_BAR(N) asm volatile("s_waitcnt vmcnt(" #N ") lgkmcnt(0)\n\ts_barrier":::"memory")

__device__ __forceinline__ void qkt(f32x16&p0,f32x16&p1,const char*Kslot,const bf16x8*qr,int r32,int hi){
  const char*kb=Kslot+hi*1024+r32*16;
  #pragma unroll
  for(int d0=0;d0<4;++d0){
    const bf16x8 b0=*reinterpret_cast<const bf16x8*>(kb+d0*2048);
    const bf16x8 b1=*reinterpret_cast<const bf16x8*>(kb+d0*2048+512);
    if(d0==0){p0=__builtin_amdgcn_mfma_f32_32x32x16_bf16(b0,qr[0],p0,0,0,0);p1=__builtin_amdgcn_mfma_f32_32x32x16_bf16(b1,qr[0],p1,0,0,0);}
    else{p0=__builtin_amdgcn_mfma_f32_32x32x16_bf16(b0,qr[d0],p0,0,0,0);p1=__builtin_amdgcn_mfma_f32_32x32x16_bf16(b1,qr[d0],p1,0,0,0);}}
}
typedef __attribute__((address_space(3))) const char* lds_cptr;
typedef short v4i16_t __attribute__((ext_vector_type(4)));
__device__ __forceinline__ void kload8(bf16x8*kf,lds_cptr kp){
  kf[0]=*(const __attribute__((address_space(3))) bf16x8*)(kp);      kf[1]=*(const __attribute__((address_space(3))) bf16x8*)(kp+512);
  kf[2]=*(const __attribute__((address_space(3))) bf16x8*)(kp+2048); kf[3]=*(const __attribute__((address_space(3))) bf16x8*)(kp+2560);
  kf[4]=*(const __attribute__((address_space(3))) bf16x8*)(kp+4096); kf[5]=*(const __attribute__((address_space(3))) bf16x8*)(kp+4608);
  kf[6]=*(const __attribute__((address_space(3))) bf16x8*)(kp+6144); kf[7]=*(const __attribute__((address_space(3))) bf16x8*)(kp+6656);
}
__device__ __forceinline__ void kload2(bf16x8*kf,lds_cptr kp,int j){ kf[2*j]=*(const __attribute__((address_space(3))) bf16x8*)(kp+j*2048); kf[2*j+1]=*(const __attribute__((address_space(3))) bf16x8*)(kp+j*2048+512); }
__device__ __forceinline__ s16x4 vtr(lds_cptr p){ return __builtin_bit_cast(s16x4,__builtin_amdgcn_ds_read_tr16_b64_v4i16((__attribute__((address_space(3))) v4i16_t*)p)); }
__device__ __forceinline__ float rowmax(const f32x16&p0,const f32x16&p1){
  float a=max3f(p0[0],p0[1],p1[0]),b=max3f(p0[2],p0[3],p1[1]);a=max3f(a,p1[2],p1[3]);
  #pragma unroll
  for(int r=4;r<16;r+=4){a=max3f(a,p0[r],p0[r+1]);b=max3f(b,p0[r+2],p0[r+3]);a=max3f(a,p1[r],p1[r+1]);b=max3f(b,p1[r+2],p1[r+3]);}
  const float m=max2f(a,b);
  auto rr=__builtin_amdgcn_permlane32_swap(__float_as_uint(m),__float_as_uint(m),false,false);
  return max2f(__uint_as_float(rr[0]),__uint_as_float(rr[1]));
}
__device__ __forceinline__ void pv(f32x16*o,int vb,bf16x8 pa0,bf16x8 pa1,bf16x8 pa2,bf16x8 pa3){
  #pragma unroll
  for(int d0=0;d0<2;++d0){s16x4 lo[4],hi[4];
    #pragma unroll
    for(int ks=0;ks<4;++ks){
      asm volatile("ds_read_b64_tr_b16 %0,%1 offset:%c2":"=&v"(lo[ks]):"v"(vb),"i"(d0*4096+ks*1024):"memory");
      asm volatile("ds_read_b64_tr_b16 %0,%1 offset:%c2":"=&v"(hi[ks]):"v"(vb),"i"(d0*4096+ks*1024+512):"memory");}
    asm volatile("s_waitcnt lgkmcnt(0)":::"memory");SBAR();
    #define PK(k) (bf16x8){lo[k][0],lo[k][1],lo[k][2],lo[k][3],hi[k][0],hi[k][1],hi[k][2],hi[k][3]}
    o[d0]=__builtin_amdgcn_mfma_f32_32x32x16_bf16(pa0,PK(0),o[d0],0,0,0);
    o[d0]=__builtin_amdgcn_mfma_f32_32x32x16_bf16(pa1,PK(1),o[d0],0,0,0);
    o[d0]=__builtin_amdgcn_mfma_f32_32x32x16_bf16(pa2,PK(2),o[d0],0,0,0);
    o[d0]=__builtin_amdgcn_mfma_f32_32x32x16_bf16(pa3,PK(3),o[d0],0,0,0);
    #undef PK
  }
}

#ifndef ATTN_STORE16
#define ATTN_STORE16(p,v) (*(u32x4*)(p)=(v))
#endif
template<int THRL,int MODE> __device__ __forceinline__ void attn_unit(int b,int h,int qb,const bf16*Q,const bf16*__restrict__ K,const bf16*__restrict__ V,int KP,int kvcol,bf16*O,int ocol,float*ssq,float slope_l2,float sink_l2,char*shm){
  int tid=threadIdx.x; asm volatile("":"+v"(tid));
  const int lane=tid&63,r32=lane&31,hi=lane>>5; const int wid=__builtin_amdgcn_readfirstlane(tid>>6);
  const long rowbase=(long)b*SEQ; const int q0=qb*QB;
  const int t0=(MODE==0)?((qb>0)?4*qb-2:0):0;
  const bf16*Qw=Q+(rowbase+q0+wid*QBLK)*QP+h*D;
  const bf16*Kh=K+(rowbase+(long)t0*KVBLK)*KP+kvcol,*Vh=V+(rowbase+(long)t0*KVBLK)*KP+kvcol;
  const unsigned lds0=(unsigned)(uintptr_t)shm;
  float*wsf=(float*)(shm+LDS_WS)+wid*64;
  const bf16*ksrc=Kh+(long)lane*KP+wid*8;
  const bf16*vsrc=Vh+(long)(16*(wid&3)+(lane>>2))*KP+(wid>>2)*32+(lane&3)*8;
  const unsigned kdst=lds0+LDS_K+wid*1024, vdst=lds0+LDS_V+wid*1024;
  #define DMA_K(t,slot) glds16(ksrc+(long)(t)*KVBLK*KP,(unsigned)__builtin_amdgcn_readfirstlane(kdst+(slot)))
  #define DMA_V(t,slot) glds16(vsrc+(long)(t)*KVBLK*KP,(unsigned)__builtin_amdgcn_readfirstlane(vdst+(slot)))
  const int vb0=(int)(lds0+LDS_V)+((lane>>4)&1)*32+(lane&3)*8+(4*hi+((lane&15)>>2))*64;
  const char*Kbase=shm+LDS_K; bf16x8 kf[8];
  const lds_cptr shm3=(lds_cptr)shm; const lds_cptr kp0=shm3+LDS_K+hi*1024+r32*16; const lds_cptr vp0=shm3+LDS_V+((lane>>4)&1)*32+(lane&3)*8+(4*hi+((lane&15)>>2))*64;
  const int NT=(MODE==0)?((qb>0)?6:4):(q0+QB)/KVBLK;
  typedef __attribute__((address_space(3))) float* lds_fptr;
  const lds_fptr cl=(lds_fptr)((lds_cptr)shm+((MODE==1)?LDS_CL:LDS_CL2));
  if(MODE==0){ if(tid<384)cl[tid]=-slope_l2*(float)tid; }
  DMA_K(0,0);DMA_V(0,0);DMA_K(1,SLOTB);
  bf16x8 qr[4];
  #pragma unroll
  for(int d0=0;d0<4;++d0)qr[d0]=*reinterpret_cast<const bf16x8*>(&Qw[(long)r32*QP+d0*16+hi*8]);
  float mhat=0.f,l_reg=0.f;f32x16 o[2];o[0]=f32x16{};o[1]=f32x16{};
  const int qrel=wid*QBLK+r32;
  asm volatile("s_waitcnt lgkmcnt(0)\n\ts_barrier":::"memory");
  const float ct=cl[q0-t0*KVBLK+qrel];
  float nm=ct;
  #define CINIT(I0,I1,t) do{ const lds_fptr cp_=cl+64*(t)+4*hi; _Pragma("unroll") for(int g_=0;g_<4;++g_){ \
      const f32x4v a_=*(const __attribute__((address_space(3))) f32x4v*)(cp_+8*g_), b_=*(const __attribute__((address_space(3))) f32x4v*)(cp_+8*g_+32); \
      _Pragma("unroll") for(int j_=0;j_<4;++j_){ I0[4*g_+j_]=nm-a_[j_]; I1[4*g_+j_]=nm-b_[j_]; } SBAR(); } }while(0)
  #define CMASK(P0,P1,t) do{int ko_=64*((t)-(NT-4)); if(MODE==0||ko_>=0)amask<MODE==0>(P0,P1,ko_,qrel,hi);}while(0)
  bool resc=false;
  #define START(P0,P1) do{ const float rm=rowmax(P0,P1); resc=false; \
    { const float dl=__builtin_fmaxf(rm,-1000.f); mhat=fadd_s(mhat,dl); \
      _Pragma("unroll") for(int r=0;r<16;++r){P0[r]=fsub_s(P0[r],dl);P1[r]=fsub_s(P1[r],dl);} \
      nm=ct-mhat; } \
    _Pragma("unroll") for(int r=0;r<16;++r)P0[r]=__builtin_amdgcn_exp2f(P0[r]); }while(0)
  #define RESC() do{ if(resc){ asm volatile("s_waitcnt lgkmcnt(0)":::"memory"); \
      _Pragma("unroll") for(int d_=0;d_<2;++d_) _Pragma("unroll") for(int r=0;r<16;++r)o[d_][r]*=wsf[crow(r,hi)]; } }while(0)
  f32x16 pA0,pA1,pB0,pB1;
  int sl_prev=0,sl_cur=0,sl_next=SLOTB;
  #define ROT() do{sl_prev=sl_cur;sl_cur=sl_next;sl_next=(sl_next==(NSLOT-1)*SLOTB)?0:sl_next+SLOTB;}while(0)
  DMA_K(2,2*SLOTB);
  WAIT_BAR(3);
  CINIT(pA0,pA1,0); qkt(pA0,pA1,Kbase,qr,r32,hi);asm volatile("s_nop 15\n\ts_nop 7":"+v"(pA0),"+v"(pA1));CMASK(pA0,pA1,0);
  START(pA0,pA1);
  _Pragma("unroll") for(int r=0;r<16;++r)pA1[r]=__builtin_amdgcn_exp2f(pA1[r]);
  WAIT_BAR(0);
  DMA_K(3,0);DMA_V(1,SLOTB);
  ROT();
  kload8(kf,kp0+sl_cur);
  WAIT_BAR(2);
  s16x4 vlo[8],vhi[8]; u32x4 pw0,pw1,pw2,pw3;
  #define PKW(P,B) cvtpk_s(P[B],P[B+1])
  #define PAF(k) __builtin_bit_cast(bf16x8,pw##k)
  #define VFR(i) (bf16x8){vlo[i][0],vlo[i][1],vlo[i][2],vlo[i][3],vhi[i][0],vhi[i][1],vhi[i][2],vhi[i][3]}
  #define PIN(x) asm volatile("":"+v"(x))
  #define MX3(a,b,c) __builtin_fmaxf(__builtin_fmaxf((a),(b)),(c))
  #define GAPA(MF,A0,A1,A2,A3,W0,W1,PW) do{ MF; sacc+=A0; sacc+=A1; sacc+=A2; sacc+=A3; PIN(sacc); W0; W1; PIN(PW); SBAR(); }while(0)
  #define EX(v) __builtin_amdgcn_exp2f(v)
  #define GAPB(MF,X,B) do{ MF; X[B]=EX(X[B]); X[B+1]=EX(X[B+1]); X[B+2]=EX(X[B+2]); X[B+3]=EX(X[B+3]); PIN(X); SBAR(); }while(0)
  #define VRD(i) do{ vlo[i]=vtr(vp_+(((i)>>2)*4096+((i)&3)*1024)); vhi[i]=vtr(vp_+(((i)>>2)*4096+((i)&3)*1024+512)); }while(0)
  #define KRD(G,j) do{ if(G){ kload2(kf,kp0+sl_next,j); SBAR(); } }while(0)
  #define STEP(C0,C1,P0,P1,t,GK,GV,GL) do{ SBAR(); CINIT(C0,C1,t); SBAR(); \
    const lds_cptr vp_=vp0+sl_prev; \
    VRD(0); SBAR(); float sacc=(P0[0]+P0[1]); \
    GAPA(C0=__builtin_amdgcn_mfma_f32_32x32x16_bf16(kf[0],qr[0],C0,0,0,0), P0[2],P0[3],P0[4],P0[5],     pw0[0]=PKW(P0,0), pw0[1]=PKW(P0,2), pw0); \
    VRD(4); SBAR(); GAPA(C1=__builtin_amdgcn_mfma_f32_32x32x16_bf16(kf[1],qr[0],C1,0,0,0), P0[6],P0[7],P0[8],P0[9],     pw0[2]=PKW(P0,4), pw0[3]=PKW(P0,6), pw0); \
    VRD(1); SBAR(); GAPA(C0=__builtin_amdgcn_mfma_f32_32x32x16_bf16(kf[2],qr[1],C0,0,0,0),   P0[10],P0[11],P0[12],P0[13], pw1[0]=PKW(P0,8), pw1[1]=PKW(P0,10), pw1); \
    VRD(5); SBAR(); GAPA(C1=__builtin_amdgcn_mfma_f32_32x32x16_bf16(kf[3],qr[1],C1,0,0,0),   P0[14],P0[15],P1[0],P1[1],   pw1[2]=PKW(P0,12),pw1[3]=PKW(P0,14), pw1); \
    VRD(2); SBAR(); GAPA(C0=__builtin_amdgcn_mfma_f32_32x32x16_bf16(kf[4],qr[2],C0,0,0,0),   P1[2],P1[3],P1[4],P1[5],     pw2[0]=PKW(P1,0), pw2[1]=PKW(P1,2), pw2); \
    VRD(6); SBAR(); GAPA(C1=__builtin_amdgcn_mfma_f32_32x32x16_bf16(kf[5],qr[2],C1,0,0,0),   P1[6],P1[7],P1[8],P1[9],     pw2[2]=PKW(P1,4), pw2[3]=PKW(P1,6), pw2); \
    VRD(3); SBAR(); GAPA(C0=__builtin_amdgcn_mfma_f32_32x32x16_bf16(kf[6],qr[3],C0,0,0,0),   P1[10],P1[11],P1[12],P1[13], pw3[0]=PKW(P1,8), pw3[1]=PKW(P1,10), pw3); \
    VRD(7); SBAR(); GAPA(C1=__builtin_amdgcn_mfma_f32_32x32x16_bf16(kf[7],qr[3],C1,0,0,0),   P1[14],P1[15],0.f,0.f,       pw3[2]=PKW(P1,12),pw3[3]=PKW(P1,14), pw3); \
    l_reg+=sacc; \
    if(GK){DMA_K((t)+3,sl_cur);} if(GV){DMA_V((t)+1,sl_next);} \
    CMASK(C0,C1,t); \
    { float a=MX3(C0[0],C0[1],C1[0]),b=MX3(C0[2],C0[3],C1[1]); a=MX3(a,C1[2],C1[3]); \
      _Pragma("unroll") for(int r=4;r<16;r+=4){a=MX3(a,C0[r],C0[r+1]);b=MX3(b,C0[r+2],C0[r+3]);a=MX3(a,C1[r],C1[r+1]);b=MX3(b,C1[r+2],C1[r+3]);} \
      float rm=__builtin_fmaxf(a,b); { auto rr=__builtin_amdgcn_permlane32_swap(__float_as_uint(rm),__float_as_uint(rm),false,false); rm=__builtin_fmaxf(__uint_as_float(rr[0]),__uint_as_float(rr[1])); } \
      resc=false; \
      if(__builtin_expect(__any(rm>(float)THRL),0)){ const float dl=__builtin_fmaxf(rm,0.f); mhat+=dl; \
        _Pragma("unroll") for(int r=0;r<16;++r){C0[r]-=dl;C1[r]-=dl;} \
        nm=ct-mhat; \
        const float f=__builtin_amdgcn_exp2f(-dl); l_reg*=f; if(hi==0)wsf[r32]=f; resc=true; } } \
    SBAR(); \
    GAPB(o[0]=__builtin_amdgcn_mfma_f32_32x32x16_bf16(PAF(0),VFR(0),o[0],0,0,0), C0,0); \
    GAPB(o[1]=__builtin_amdgcn_mfma_f32_32x32x16_bf16(PAF(0),VFR(4),o[1],0,0,0), C0,4); \
    KRD(GL,0); GAPB(o[0]=__builtin_amdgcn_mfma_f32_32x32x16_bf16(PAF(1),VFR(1),o[0],0,0,0), C0,8); \
    KRD(GL,1); GAPB(o[1]=__builtin_amdgcn_mfma_f32_32x32x16_bf16(PAF(1),VFR(5),o[1],0,0,0), C0,12); \
    KRD(GL,2); GAPB(o[0]=__builtin_amdgcn_mfma_f32_32x32x16_bf16(PAF(2),VFR(2),o[0],0,0,0), C1,0); \
    KRD(GL,3); GAPB(o[1]=__builtin_amdgcn_mfma_f32_32x32x16_bf16(PAF(2),VFR(6),o[1],0,0,0), C1,4); \
    GAPB(o[0]=__builtin_amdgcn_mfma_f32_32x32x16_bf16(PAF(3),VFR(3),o[0],0,0,0), C1,8); \
    GAPB(o[1]=__builtin_amdgcn_mfma_f32_32x32x16_bf16(PAF(3),VFR(7),o[1],0,0,0), C1,12); \
    }while(0)
  int t=1;
  #undef CMASK
  #define CMASK(P0,P1,t) do{}while(0)
  for(;t+5<NT;t+=2){
    STEP(pB0,pB1,pA0,pA1,t,true,true,true);     WAIT_BAR(2); RESC(); ROT();
    STEP(pA0,pA1,pB0,pB1,t+1,true,true,true);   WAIT_BAR(2); RESC(); ROT();
  }
  #undef CMASK
  #define CMASK(P0,P1,t) do{int ko_=64*((t)-(NT-4)); if(MODE==0||ko_>=0)amask<MODE==0>(P0,P1,ko_,qrel,hi);}while(0)
  #define ENDW(tt) do{ if((tt)+3<NT){WAIT_BAR(2);} else if((tt)+2<NT){WAIT_BAR(1);} else {WAIT_BAR(0);} }while(0)
  for(;t+1<NT;t+=2){
    STEP(pB0,pB1,pA0,pA1,t,(t+3<NT),(t+1<NT),(t+1<NT));       ENDW(t);   RESC(); ROT();
    STEP(pA0,pA1,pB0,pB1,t+1,(t+4<NT),(t+2<NT),(t+2<NT));     ENDW(t+1); RESC(); ROT();
  }
  STEP(pB0,pB1,pA0,pA1,NT-1,false,false,false); RESC();
  { float sacc=pB0[0]+pB0[1]; _Pragma("unroll") for(int r=2;r<16;++r)sacc+=pB0[r]; _Pragma("unroll") for(int r=0;r<16;++r)sacc+=pB1[r]; l_reg+=sacc;
    pw0=(u32x4){PKW(pB0,0),PKW(pB0,2),PKW(pB0,4),PKW(pB0,6)};pw1=(u32x4){PKW(pB0,8),PKW(pB0,10),PKW(pB0,12),PKW(pB0,14)};pw2=(u32x4){PKW(pB1,0),PKW(pB1,2),PKW(pB1,4),PKW(pB1,6)};pw3=(u32x4){PKW(pB1,8),PKW(pB1,10),PKW(pB1,12),PKW(pB1,14)};
    SBAR(); pv(o,vb0+sl_cur,PAF(0),PAF(1),PAF(2),PAF(3)); }
  #undef PKW
  #undef PAF
  #undef VFR
  #undef PIN
  #undef MX3
  #undef GAPA
  #undef GAPB
  #undef EX
  #undef VRD
  #undef KRD
  #undef STEP
  #undef ENDW
  {auto rr=__builtin_amdgcn_permlane32_swap(__float_as_uint(l_reg),__float_as_uint(l_reg),false,false);l_reg=__uint_as_float(rr[0])+__uint_as_float(rr[1]);}
  if(MODE==0)l_reg+=__builtin_amdgcn_exp2f(sink_l2-mhat);
  if(hi==0)wsf[32+r32]=l_reg;asm volatile("s_waitcnt lgkmcnt(0)":::"memory");
  float rli[16];
  #pragma unroll
  for(int r=0;r<16;++r)rli[r]=__builtin_amdgcn_rcpf(wsf[32+crow(r,hi)]);
  bf16*Ow=O+(rowbase+q0+wid*QBLK)*OP+ocol;
  { bf16*stg=(bf16*)(shm+LDS_OST)+wid*2048;
    #pragma unroll
    for(int r=0;r<16;++r){const int orow=crow(r,hi);
      #pragma unroll
      for(int d0=0;d0<2;++d0)stg[orow*64+d0*32+r32]=__float2bfloat16(o[d0][r]*rli[r]);}
    asm volatile("s_waitcnt lgkmcnt(0)":::"memory");
    #pragma unroll
    for(int i=0;i<4;++i){const int row=i*8+(lane>>3),ch=lane&7; const u32x4 v=*(const u32x4*)(stg+row*64+ch*8); ATTN_STORE16(Ow+(long)row*OP+ch*8,v);
      float ss=0.f;
      #pragma unroll
      for(int e=0;e<4;++e){const float lo=__builtin_bit_cast(float,v[e]<<16),hh=__builtin_bit_cast(float,v[e]&0xffff0000u); ss+=lo*lo+hh*hh;}
      ss+=__shfl_xor(ss,1); ss+=__shfl_xor(ss,2); ss+=__shfl_xor(ss,4);
      if(ch==0)__hip_atomic_fetch_add(ssq+(rowbase+q0+wid*QBLK+row)*2+MODE,ss,__ATOMIC_RELAXED,__HIP_MEMORY_SCOPE_AGENT); } }
  asm volatile("s_waitcnt lgkmcnt(0)\n\ts_barrier":::"memory");
  #undef CINIT
  #undef DMA_K
  #undef DMA_V
  #undef CMASK
  #undef START
  #undef RESC
  #undef ROT
}
constexpr int ATTN_LDS_BYTES=LDS_BYTES;
#undef SBAR
#undef WAIT_BAR
}

__device__ __forceinline__ void fox_cumsum(const float* Ft, float bias, int b, int h, char* lds) {
    typedef __attribute__((address_space(3))) float* lds_fptr; typedef __attribute__((address_space(3))) const char* lds_cptr;
    const lds_fptr cl = (lds_fptr)((lds_cptr)lds + attn_body::LDS_CL), wt = (lds_fptr)((lds_cptr)lds + attn_body::LDS_WT);
    const int tid = threadIdx.x, lane = tid & 63, wave = tid >> 6;
    const f32x4* f = (const f32x4*)(Ft + (size_t)h * M + (size_t)b * SEQ + 8 * tid);
    const f32x4 a = f[0], c = f[1];
    float v[8] = {a[0], a[1], a[2], a[3], c[0], c[1], c[2], c[3]};
#pragma unroll
    for (int k = 0; k < 8; ++k) v[k] = log_sigmoid(v[k] + bias);
#pragma unroll
    for (int k = 1; k < 8; ++k) v[k] += v[k - 1];
    float inc = v[7];
#pragma unroll
    for (int o = 1; o < 64; o <<= 1) { const float t = __shfl_up(inc, o); if (lane >= o) inc += t; }
    if (lane == 63) wt[wave] = inc;
    __syncthreads();
    float base = inc - v[7];
#pragma unroll
    for (int w = 0; w < 8; ++w) if (w < wave) base += wt[w];
    *(__attribute__((address_space(3))) f32x4*)(cl + 8 * tid) = (f32x4){(v[0] + base) * LOG2E, (v[1] + base) * LOG2E, (v[2] + base) * LOG2E, (v[3] + base) * LOG2E};
    *(__attribute__((address_space(3))) f32x4*)(cl + 8 * tid + 4) = (f32x4){(v[4] + base) * LOG2E, (v[5] + base) * LOG2E, (v[6] + base) * LOG2E, (v[7] + base) * LOG2E};
    __syncthreads();
}
__device__ __forceinline__ void attn_phase(const Ptrs& P, char* lds) {
    unsigned char* ws = P.ws;
    const int G = gridDim.x, bx = blockIdx.x, vcu0 = (G % 8 == 0) ? (bx % 8) * (G / 8) + bx / 8 : bx;
    for (int v = vcu0; v < 256; v += G) {
        const int bh = v >> 2, s = v & 3, b = bh >> 4, h = bh & 15;
        fox_cumsum((const float*)(ws + WS_F), P.b_forget[h], b, h, lds);
        for (int i = 0; i < 4; ++i) {
            const int qb = (i == 0) ? s : (i == 1) ? 7 - s : (i == 2) ? 8 + s : 15 - s;
            attn_body::attn_unit<60, 1>(b, h, qb, (const attn_body::bf16*)(ws + WS_QB), (const attn_body::bf16*)(ws + WS_KB), (const attn_body::bf16*)(ws + WS_VB), 1024, h * 64,
                                        (attn_body::bf16*)(ws + WS_O), 1024 + h * 64, (float*)(ws + WS_CS), 0.f, 0.f, lds);
        }
        for (int i = 0; i < 4; ++i) {
            const int qb = (i == 0) ? s : (i == 1) ? 7 - s : (i == 2) ? 8 + s : 15 - s;
            attn_body::attn_unit<8, 0>(b, h, qb, (const attn_body::bf16*)(ws + WS_QA), (const attn_body::bf16*)(ws + WS_KA), (const attn_body::bf16*)(ws + WS_VA), 128, (h >> 3) * 64,
                                       (attn_body::bf16*)(ws + WS_O), h * 64, (float*)(ws + WS_CS), exp2f(-0.5f * (float)(h + 1)) * LOG2E, P.sinks[h] * LOG2E, lds);
        }
    }
}
#define LAS __attribute__((address_space(3)))
#define XB_TMO      128
#define XB_XCNT(j)  (256  + 64 * (j))
#define XB_XSUB(j)  (1280 + 64 * (j))
#define XB_XGEN(j)  (2304 + 64 * (j))
#define XB_TOP      3328
#define XB_TOPGEN   3392
#define XCD_BAR_WORDS 3456
#define XB_SPIN_CAP (1u << 18)

__device__ __forceinline__ unsigned xb_ld(unsigned* p)              { return __hip_atomic_load(p, __ATOMIC_RELAXED, __HIP_MEMORY_SCOPE_AGENT); }
__device__ __forceinline__ unsigned xb_add(unsigned* p, unsigned v) { return __hip_atomic_fetch_add(p, v, __ATOMIC_RELAXED, __HIP_MEMORY_SCOPE_AGENT); }
__device__ __forceinline__ unsigned xb_xcc_id() { return (unsigned)__builtin_amdgcn_s_getreg((3 << 11) | 20) & 0xFu; }
#define XB_SPIN(cond, bar) do { unsigned _sp = 0; while (cond) { __builtin_amdgcn_s_sleep(1); \
    if ((++_sp & 255u) == 0u) { if (xb_ld(&(bar)[XB_TMO])) break; if (_sp > XB_SPIN_CAP) { atomicAdd(&(bar)[XB_TMO], 1u); break; } } } } while (0)

struct XcdBarrier {
    unsigned* bar; unsigned x;
    volatile LAS unsigned* st;
};

__device__ __forceinline__ XcdBarrier xcd_barrier_post(unsigned* bar, volatile LAS unsigned* st) {
    XcdBarrier b; b.bar = bar; b.x = xb_xcc_id(); b.st = st;
    if (threadIdx.x == 0) (void)xb_add(&bar[XB_XCNT(b.x)], 1u);
    return b;
}
__device__ __forceinline__ void xcd_barrier_complete(unsigned* bar, unsigned x, unsigned& nloc, unsigned& nx) {
    const unsigned G = gridDim.x * gridDim.y * gridDim.z;
    unsigned sum, cnt, mine, sp = 0u;
    for (;;) {
        sum = 0u; cnt = 0u; mine = 0u;
#pragma unroll
        for (unsigned j = 0; j < 16; ++j) { const unsigned c = xb_ld(&bar[XB_XCNT(j)]); sum += c; cnt += (c > 0u) ? 1u : 0u; mine = (j == x) ? c : mine; }
        if (sum == G) break;
        __builtin_amdgcn_s_sleep(1);
        if ((++sp & 255u) == 0u) { if (xb_ld(&bar[XB_TMO])) break; if (sp > XB_SPIN_CAP) { atomicAdd(&bar[XB_TMO], 1u); break; } }
    }
    nloc = mine > 0u ? mine : 1u; nx = cnt > 0u ? cnt : 1u;
}

__device__ __forceinline__ void xcd_barrier(const XcdBarrier& b) {
    asm volatile("s_waitcnt vmcnt(0)" ::: "memory");
    __syncthreads();
    if (threadIdx.x == 0) {
        unsigned* bar = b.bar;
        __builtin_amdgcn_s_waitcnt(0);
        unsigned nloc = b.st[0], nx = b.st[1];
        if (nloc == 0u) { xcd_barrier_complete(bar, b.x, nloc, nx); b.st[0] = nloc; b.st[1] = nx; }
        const unsigned old = xb_add(&bar[XB_XSUB(b.x)], 1u);
        const unsigned gen = old / nloc;
        if (old + 1u == (gen + 1u) * nloc) {
            __builtin_amdgcn_fence(__ATOMIC_RELEASE, "agent");
            asm volatile("s_waitcnt vmcnt(0)" ::: "memory");
            const unsigned og = xb_add(&bar[XB_TOP], 1u);
            const unsigned tg = og / nx;
            if (og + 1u == (tg + 1u) * nx) xb_add(&bar[XB_TOPGEN], 1u);
            else XB_SPIN(xb_ld(&bar[XB_TOPGEN]) == tg, bar);
            __builtin_amdgcn_fence(__ATOMIC_ACQUIRE, "agent");
            xb_add(&bar[XB_XGEN(b.x)], 1u);
            asm volatile("s_waitcnt vmcnt(0)" ::: "memory");
        } else {
            XB_SPIN(xb_ld(&bar[XB_XGEN(b.x)]) == gen, bar);
            __builtin_amdgcn_fence(__ATOMIC_ACQUIRE, "agent");
            asm volatile("s_waitcnt vmcnt(0)" ::: "memory");
        }
    }
    __syncthreads();
}

constexpr int LDS_BYTES = 147456;
__global__ void __launch_bounds__(512, 2) mega_fwd(Ptrs P) {
    extern __shared__ __attribute__((aligned(16))) unsigned char lds[];
    cg::grid_group grid = cg::this_grid();
    if (P.use_cg) grid.sync();
    unsigned char* ws = P.ws;
    PG8_LAS unsigned char* ldsp = (PG8_LAS unsigned char*)lds;
    const int NGW = gridDim.x * 8;
    volatile LAS unsigned* bst = (volatile LAS unsigned*)(ldsp + 143360);
    if (threadIdx.x == 0) { bst[0] = 0u; bst[1] = 0u; }
    __syncthreads();
    const XcdBarrier bar = xcd_barrier_post((unsigned*)(ws + WS_CTL), bst);
#define GRID_SYNC() xcd_barrier(bar)
#define FRESH_IDS() int tid_; asm volatile("v_mov_b32 %0, %1" : "=v"(tid_) : "v"(threadIdx.x)); const int lane = tid_ & 63, gw = blockIdx.x * 8 + (tid_ >> 6)
    ph_prologue(P, (float*)lds);
    { FRESH_IDS(); pass_prenorm(P.x, P.pre_mix_g, (bf16_t*)(ws + WS_XN), (float*)(ws + WS_CS + 512 * 1024), gw, NGW, lane); }
    GRID_SYNC();
    { pg8::Gemm g{(const bf16_t*)(ws + WS_XN), (const bf16_t*)(ws + WS_WIN), M, DINP, DM}; pg8::StaticOrder S; S.init(M, DINP, (int)gridDim.x, (int)blockIdx.x);
      pg8::gemm_phase<pg8::EpiInProjT, pg8::StaticOrder, true, true>(ldsp, g, S, pg8::EpiInProjT{ws}); }
    if (gridDim.x == 256 && blockIdx.x >= 128) convert_items(P, (float*)lds, I_CUT, I_ALL, (blockIdx.x - 128) * 8 + (threadIdx.x >> 6), 128 * 8);
    GRID_SYNC();
    attn_phase(P, (char*)lds);
    GRID_SYNC();
    { pg8::Gemm g{(const bf16_t*)(ws + WS_O), (const bf16_t*)(ws + WS_WOUT), M, DM, DM}; pg8::StaticOrder S; S.init(M, DM, (int)gridDim.x, (int)blockIdx.x);
      PG8_LAS float* T = (PG8_LAS float*)(ldsp + 139264);
      { pg8::Unit u; const float* SS = (const float*)(ws + WS_CS);
        for (int i = 0; i < 2; ++i) if (S.next(i, u) && threadIdx.x < 256) { const int row = u.pm * 256 + (int)threadIdx.x;
            const float ra = 1.0f / sqrtf(SS[row * 2] * (1.0f / 1024.f) + EPS), rb = 1.0f / sqrtf(SS[row * 2 + 1] * (1.0f / 1024.f) + EPS);
            T[(i * 256 + (int)threadIdx.x) * 2] = ra / rb; T[(i * 256 + (int)threadIdx.x) * 2 + 1] = rb; } }
      __syncthreads();
      pg8::gemm_phase<pg8::EpiOutT, pg8::StaticOrder, true, true>(ldsp, g, S, pg8::EpiOutT{(bf16_t*)(ws + WS_MIX), DM, T}); }
    GRID_SYNC();
    { FRESH_IDS(); pass_postmix((bf16_t*)(ws + WS_XN), (const float*)(ws + WS_CS + 512 * 1024), P.pre_mix_g, (const bf16_t*)(ws + WS_MIX), P.post_mix_g, P.pre_ffn_g, (float*)(ws + WS_CS + 256 * 1024), gw, NGW, lane); }
    GRID_SYNC();
    { pg8::Gemm g{(const bf16_t*)(ws + WS_XN), (const bf16_t*)(ws + WS_WUP), M, NUP, DM}; pg8::StaticOrder S; S.init(M, NUP, (int)gridDim.x, (int)blockIdx.x);
      pg8::gemm_phase<pg8::EpiUpT, pg8::StaticOrder, true, true>(ldsp, g, S, pg8::EpiUpT{(bf16_t*)(ws + WS_ACT), P.conv_w, P.conv_b, (float*)(ws + WS_SIDE), (PG8_LAS float*)(ldsp + 131072)}); }
    GRID_SYNC();
    ph_convfix((const float*)(ws + WS_SIDE), P.conv_w, P.conv_b, (bf16_t*)(ws + WS_ACT));
    GRID_SYNC();
    { pg8::Gemm g{(const bf16_t*)(ws + WS_ACT), (const bf16_t*)(ws + WS_WDN), M, DM, DFF}; pg8::StaticOrder S; S.init(M, DM, (int)gridDim.x, (int)blockIdx.x);
      pg8::gemm_phase<pg8::EpiBf16T, pg8::StaticOrder, true, true>(ldsp, g, S, pg8::EpiBf16T{(bf16_t*)(ws + WS_Y), DM}); }
    GRID_SYNC();
    { FRESH_IDS(); pass_final((const bf16_t*)(ws + WS_XN), (const float*)(ws + WS_CS + 256 * 1024), P.pre_ffn_g, (const bf16_t*)(ws + WS_Y), P.post_ffn_g, P.out, gw, NGW, lane); }
}

extern "C" void kernel_launch(void* const* d_in, const int* in_sizes, int n_in, void* d_out, int out_size, void* d_ws, size_t ws_size, hipStream_t stream) {
    if (n_in != 15 || ws_size < WS_END || out_size != M * DM) { fprintf(stderr, "kernel_launch: unexpected sizes n_in %d ws %zu out %d\n", n_in, ws_size, out_size); return; }
    static int grid_blocks = 0;
    if (!grid_blocks) {
        int dev = 0, cus = 0, per_cu = 0;
        hipGetDevice(&dev);
        hipDeviceGetAttribute(&cus, hipDeviceAttributeMultiprocessorCount, dev);
        if (hipFuncSetAttribute((const void*)mega_fwd, hipFuncAttributeMaxDynamicSharedMemorySize, LDS_BYTES) != hipSuccess) fprintf(stderr, "kernel_launch: hipFuncSetAttribute failed\n");
        hipOccupancyMaxActiveBlocksPerMultiprocessor(&per_cu, (const void*)mega_fwd, 512, LDS_BYTES);
        if (per_cu < 1) { fprintf(stderr, "kernel_launch: occupancy query gave %d\n", per_cu); per_cu = 1; }
        grid_blocks = cus * per_cu;
        if (grid_blocks != 256) fprintf(stderr, "kernel_launch: expected 256 resident workgroups, got %d (the output projection assumes two units per workgroup)\n", grid_blocks);
        (void)hipGetLastError();
    }
    Ptrs P{};
    const float** pp = (const float**)&P;
    for (int i = 0; i < 15; ++i) pp[i] = (const float*)d_in[i];
    P.out = (float*)d_out; P.ws = (unsigned char*)d_ws;
    P.use_cg = 0; P.pad = 0;
    if (hipMemsetAsync((char*)d_ws + WS_CTL, 0, CTL_BYTES, stream) != hipSuccess) { fprintf(stderr, "kernel_launch: hipMemsetAsync failed\n"); return; }
    void* args[] = {&P};
    hipError_t e = hipLaunchCooperativeKernel((const void*)mega_fwd, dim3(grid_blocks), dim3(512), args, LDS_BYTES, stream);
    if (e != hipSuccess) fprintf(stderr, "cooperative launch failed: %s (grid %d)\n", hipGetErrorString(e), grid_blocks);
}
```

```cpp
#include <hip/hip_runtime.h>
#include <hip/hip_cooperative_groups.h>
namespace cg = cooperative_groups;
#include <cstdio>
#include <cstdint>

constexpr int NB = 4, SEQ = 4096, DM = 2048, M = NB * SEQ;
constexpr int HD = 64, NHA = 16, NKVA = 2, NHB = 16, WIN = 128, DFF = 5632, NUP = 2 * DFF;
constexpr int DIN = 4368, DINP = 4608;
constexpr float EPS = 1e-6f;
constexpr float LOG2E = 1.4426950408889634f;
constexpr float C2 = 0.125f * LOG2E;

constexpr size_t MiB = 1u << 20;
constexpr size_t WS_WIN = 0, WS_WOUT = 18 * MiB, WS_WUP = 26 * MiB, WS_WDN = 70 * MiB;
constexpr size_t WS_XN = 92 * MiB;
constexpr size_t WS_CS = 156 * MiB, WS_F = 157 * MiB, WS_SIDE = 158 * MiB;
constexpr size_t WS_QA = 170 * MiB, WS_KA = 202 * MiB, WS_VA = 206 * MiB, WS_QB = 210 * MiB, WS_KB = 242 * MiB, WS_VB = 274 * MiB, WS_O = 306 * MiB;
constexpr size_t WS_ACT = 170 * MiB;
constexpr size_t WS_MIX = 370 * MiB, WS_Y = 434 * MiB;
constexpr size_t WS_CTL = 169 * MiB + 768 * 1024, CTL_BYTES = 64 * 1024;
constexpr size_t WS_END = 498 * MiB;

typedef unsigned short bf16_t;
typedef unsigned v4u __attribute__((ext_vector_type(4)));
typedef float f32x4 __attribute__((ext_vector_type(4)));

__device__ __forceinline__ unsigned f2bf(float f) { unsigned u = __builtin_bit_cast(unsigned, f); return (u + 0x7fffu + ((u >> 16) & 1u)) >> 16; }
__device__ __forceinline__ unsigned pk2(float lo, float hi) { return f2bf(lo) | (f2bf(hi) << 16); }
__device__ __forceinline__ float bf2f(unsigned h) { return __builtin_bit_cast(float, h << 16); }
__device__ __forceinline__ float wave_sum(float v) {
#pragma unroll
    for (int o = 1; o < 64; o <<= 1) v += __shfl_xor(v, o);
    return v;
}
__device__ __forceinline__ float wave_max(float v) {
#pragma unroll
    for (int o = 1; o < 64; o <<= 1) v = fmaxf(v, __shfl_xor(v, o));
    return v;
}

__device__ __forceinline__ int rowmap(int n, int map) {
    if (map == 0) return n;
    if (n < DFF) return ((n >> 7) << 8) + (n & 127);
    const int g = n - DFF; return ((g >> 7) << 8) + 128 + (g & 127);
}
__device__ __forceinline__ void transpose_item(const float* W, int K, int N, int Npad, bf16_t* WT, int map, float* scr, int item, int lane, const float* ks0 = nullptr, const float* ks1 = nullptr) {
    const int nblk = Npad / 32, kb = item / nblk, nb = item % nblk, k0 = 128 * kb, n0 = 32 * nb;
    { const int n4 = lane & 7, n = n0 + 4 * n4;
      f32x4 w[16];
#pragma unroll
      for (int i = 0; i < 16; ++i) { const int kk = (lane >> 3) + 8 * i; w[i] = (n < N) ? *(const f32x4*)(W + (size_t)(k0 + kk) * N + n) : (f32x4){0.f, 0.f, 0.f, 0.f}; }
#pragma unroll
      for (int i = 0; i < 16; ++i) { const int kk = (lane >> 3) + 8 * i;
          if (ks0) w[i] = w[i] * ((k0 < 1024) ? ks0[k0 + kk] : ks1[k0 + kk - 1024]);
#pragma unroll
          for (int j = 0; j < 4; ++j) scr[kk * 33 + 4 * n4 + j] = w[i][j]; } }
    __builtin_amdgcn_s_waitcnt(0); asm volatile("" ::: "memory");
    const int c = lane & 15;
#pragma unroll
    for (int j = 0; j < 8; ++j) { const int n = (lane >> 4) + 4 * j; const float* s = scr + (8 * c) * 33 + n;
        v4u o; o.x = pk2(s[0 * 33], s[1 * 33]); o.y = pk2(s[2 * 33], s[3 * 33]); o.z = pk2(s[4 * 33], s[5 * 33]); o.w = pk2(s[6 * 33], s[7 * 33]);
        *(v4u*)(WT + (size_t)rowmap(n0 + n, map) * K + k0 + 8 * c) = o; }
    __builtin_amdgcn_s_waitcnt(0); asm volatile("" ::: "memory");
}
struct Ptrs {
    const float *x, *pre_mix_g, *w_in, *b_forget, *sinks, *grp_swa_g, *grp_fox_g, *w_out, *post_mix_g, *pre_ffn_g, *w_up, *conv_w, *conv_b, *w_down, *post_ffn_g;
    float* out; unsigned char* ws;
    int use_cg, pad;
};
constexpr int I_IN = (DM / 128) * (DINP / 32), I_OUT = (DM / 128) * (DM / 32), I_UP = (DM / 128) * (NUP / 32), I_DN = (DFF / 128) * (DM / 32);
constexpr int I_CUT = I_IN + I_OUT, I_ALL = I_IN + I_OUT + I_UP + I_DN;
__device__ __forceinline__ void convert_items(const Ptrs& P, float* scr_all, int lo, int hi, int gw, int NGW) {
    const int tid = threadIdx.x, lane = tid & 63, wave = tid >> 6;
    float* scr = scr_all + wave * 128 * 33;
    for (int it = lo + gw; it < hi; it += NGW) {
        int r = it;
        if (r < I_IN) { transpose_item(P.w_in, DM, DIN, DINP, (bf16_t*)(P.ws + WS_WIN), 0, scr, r, lane); continue; } r -= I_IN;
        if (r < I_OUT) { transpose_item(P.w_out, DM, DM, DM, (bf16_t*)(P.ws + WS_WOUT), 0, scr, r, lane, P.grp_swa_g, P.grp_fox_g); continue; } r -= I_OUT;
        if (r < I_UP) { transpose_item(P.w_up, DM, NUP, NUP, (bf16_t*)(P.ws + WS_WUP), 1, scr, r, lane); continue; } r -= I_UP;
        transpose_item(P.w_down, DFF, DM, DM, (bf16_t*)(P.ws + WS_WDN), 0, scr, r, lane);
    }
}
__device__ __forceinline__ void ph_prologue(const Ptrs& P, float* scr_all) {
    const int tid = threadIdx.x;
    const bool defer = (gridDim.x == 256);
    convert_items(P, scr_all, 0, defer ? I_CUT : I_ALL, blockIdx.x * 8 + (tid >> 6), gridDim.x * 8);
    for (int i = blockIdx.x * 512 + tid; i < M * 2; i += gridDim.x * 512) ((float*)(P.ws + WS_CS))[i] = 0.f;
}

__device__ __forceinline__ void row_load(const float* row, int lane, f32x4 (&v)[8]) {
#pragma unroll
    for (int j = 0; j < 8; ++j) v[j] = ((const f32x4*)row)[lane + 64 * j];
}
__device__ __forceinline__ void row_load_bf16(const bf16_t* row, int lane, f32x4 (&v)[8]) {
#pragma unroll
    for (int j = 0; j < 8; ++j) { const unsigned long long w = ((const unsigned long long*)row)[lane + 64 * j];
        v[j] = (f32x4){bf2f((unsigned)w & 0xffffu), bf2f(((unsigned)w >> 16)), bf2f((unsigned)(w >> 32) & 0xffffu), bf2f((unsigned)(w >> 48))}; }
}
__device__ __forceinline__ float row_sumsq(const f32x4 (&v)[8]) {
    float s = 0.f;
#pragma unroll
    for (int j = 0; j < 8; ++j) s += (v[j].x * v[j].x + v[j].y * v[j].y) + (v[j].z * v[j].z + v[j].w * v[j].w);
    return wave_sum(s);
}
__device__ __forceinline__ void row_store_bf16(bf16_t* orow, int lane, const f32x4 (&v)[8]) {
#pragma unroll
    for (int j = 0; j < 8; ++j) ((unsigned long long*)orow)[lane + 64 * j] = (unsigned long long)pk2(v[j].x, v[j].y) | ((unsigned long long)pk2(v[j].z, v[j].w) << 32);
}
__device__ __forceinline__ void pass_prenorm(const float* x, const float* g, bf16_t* xn, float* r0s, int gw, int NGW, int lane) {
    f32x4 gv[8]; row_load(g, lane, gv);
    for (int m = gw; m < M; m += NGW) {
        f32x4 v[8]; row_load(x + (size_t)m * DM, lane, v);
        const float r = 1.0f / sqrtf(row_sumsq(v) * (1.0f / DM) + EPS);
#pragma unroll
        for (int j = 0; j < 8; ++j) v[j] = v[j] * r * gv[j];
        row_store_bf16(xn + (size_t)m * DM, lane, v);
        if (lane == 0) r0s[m] = r;
    }
}
__device__ __forceinline__ void pass_postmix(bf16_t* xn, const float* r0s, const float* gpm, const bf16_t* mix, const float* gpost, const float* gpre, float* r2s, int gw, int NGW, int lane) {
    f32x4 ig[8]; row_load(gpm, lane, ig);
#pragma unroll
    for (int j = 0; j < 8; ++j) { ig[j][0] = __builtin_amdgcn_rcpf(ig[j][0]); ig[j][1] = __builtin_amdgcn_rcpf(ig[j][1]); ig[j][2] = __builtin_amdgcn_rcpf(ig[j][2]); ig[j][3] = __builtin_amdgcn_rcpf(ig[j][3]); }
    for (int m = gw; m < M; m += NGW) {
        f32x4 v[8], xv[8], gv[8]; row_load_bf16(mix + (size_t)m * DM, lane, v); row_load_bf16(xn + (size_t)m * DM, lane, xv); row_load(gpost, lane, gv);
        const float ir0 = __builtin_amdgcn_rcpf(r0s[m]);
        const float r = 1.0f / sqrtf(row_sumsq(v) * (1.0f / DM) + EPS);
#pragma unroll
        for (int j = 0; j < 8; ++j) v[j] = xv[j] * ig[j] * ir0 + v[j] * r * gv[j];
        const float r2 = 1.0f / sqrtf(row_sumsq(v) * (1.0f / DM) + EPS);
        row_load(gpre, lane, gv);
#pragma unroll
        for (int j = 0; j < 8; ++j) v[j] = v[j] * r2 * gv[j];
        row_store_bf16(xn + (size_t)m * DM, lane, v);
        if (lane == 0) r2s[m] = r2;
    }
}
__device__ __forceinline__ void pass_final(const bf16_t* xn, const float* r2s, const float* gpre, const bf16_t* y, const float* g, float* out, int gw, int NGW, int lane) {
    f32x4 ig[8]; row_load(gpre, lane, ig);
#pragma unroll
    for (int j = 0; j < 8; ++j) { ig[j][0] = __builtin_amdgcn_rcpf(ig[j][0]); ig[j][1] = __builtin_amdgcn_rcpf(ig[j][1]); ig[j][2] = __builtin_amdgcn_rcpf(ig[j][2]); ig[j][3] = __builtin_amdgcn_rcpf(ig[j][3]); }
    f32x4 gv[8]; row_load(g, lane, gv);
    for (int m = gw; m < M; m += NGW) {
        f32x4 v[8], xv[8]; row_load_bf16(xn + (size_t)m * DM, lane, xv); row_load_bf16(y + (size_t)m * DM, lane, v);
        const float ir2 = __builtin_amdgcn_rcpf(r2s[m]);
        const float r = 1.0f / sqrtf(row_sumsq(v) * (1.0f / DM) + EPS);
#pragma unroll
        for (int j = 0; j < 8; ++j) ((f32x4*)(out + (size_t)m * DM))[lane + 64 * j] = xv[j] * ig[j] * ir2 + v[j] * r * gv[j];
    }
}
__device__ __forceinline__ float log_sigmoid(float z) { return z >= 0.f ? -log1pf(expf(-z)) : z - log1pf(expf(z)); }
__device__ __forceinline__ float gelu_tanh(float x) {
    const float z = 0.7978845608028654f * (x + 0.044715f * x * x * x);
    return x / (1.0f + exp2f(-2.0f * LOG2E * z));
}
namespace pg8 {
#define PG8_LAS __attribute__((address_space(3)))
typedef unsigned short bf16_t;
typedef short bf16x8 __attribute__((ext_vector_type(8)));
typedef float f32x4 __attribute__((ext_vector_type(4)));
typedef unsigned u32x4 __attribute__((ext_vector_type(4)));
constexpr int BM = 256, BK = 64, HALF = 128, HTB = HALF * BK * 2  , STAGE_BYTES = 8 * HTB, NXCD = 8, WGM = 8;

__host__ __device__ __forceinline__ int lds_byte(int r, int c) { const int st = (r >> 4) * 2 + (c >> 5), rr = r & 15, cc = c & 31, ob = rr * 64 + cc * 2; return st * 1024 + (ob ^ (((ob >> 9) & 1) << 5)); }
__host__ __device__ __forceinline__ void stage_rc(int b, int& R, int& C) { const int st = b / 1024, sb = b % 1024, swz = sb ^ (((sb >> 9) & 1) << 5); R = (st >> 1) * 16 + swz / 64; C = (st & 1) * 32 + (swz % 64) / 2; }
__host__ __device__ __forceinline__ int perm32(int rho) { const int n = rho >> 4, i = rho & 15; return 8 * (i >> 2) + 4 * n + (i & 3); }

struct Unit { int pm, pn; };
struct Gemm { const bf16_t* A; const bf16_t* Bt; int M, N, K; };

struct StaticOrder {
    int nM, nN, nwg, G, c;
    __host__ __device__ void init(int M, int N, int G_, int c_) { nM = M / BM; nN = N / BM; nwg = nM * nN; G = G_; c = c_; }
    __host__ __device__ bool next(int i, Unit& u) const {
        const long L = (long)i * G + c; if (L >= nwg) return false;
        int wgid = (int)L; { const int q = nwg / NXCD, r = nwg % NXCD, xcd = wgid % NXCD, off = wgid / NXCD; wgid = (xcd < r ? xcd * (q + 1) : r * (q + 1) + (xcd - r) * q) + off; }
        const int nig = WGM * nN, gid = wgid / nig, fm = gid * WGM, gsz = (nM - fm) < WGM ? (nM - fm) : WGM;
        u.pm = fm + ((wgid % nig) % gsz); u.pn = (wgid % nig) / gsz; return true;
    }
    __device__ __forceinline__ void a_ready(const Unit&) const {}
    __device__ __forceinline__ void done(const Unit&) const {}
};

__device__ __forceinline__ unsigned cvt_pk_bf16(float lo, float hi) { unsigned r; asm volatile("v_cvt_pk_bf16_f32 %0, %1, %2" : "=v"(r) : "v"(lo), "v"(hi)); return r; }
typedef float f32x2 __attribute__((ext_vector_type(2)));
template <class Epi, class Sched, bool ALIGN_EPI = false, bool SP2 = false>
__device__ __forceinline__ void gemm_phase(PG8_LAS unsigned char* lds, const Gemm g, const Sched& S, const Epi& E) {
    int tid = threadIdx.x; asm volatile("" : "+v"(tid));
    const int wid = __builtin_amdgcn_readfirstlane(tid >> 6), lane = tid & 63, wr = wid >> 2, wc = wid & 3, fr = lane & 15, fq = lane >> 4;
    const int K = g.K, nt = K / BK;
    unsigned voffA[2], voffB[2];
#pragma unroll
    for (int i = 0; i < 2; ++i) { int R, C; stage_rc(tid * 16 + i * 8192, R, C); const int Rb = Epi::PERM ? ((R & ~31) + perm32(R & 31)) : R;
        voffA[i] = (unsigned)(R * K + C) * 2u; voffB[i] = (unsigned)(Rb * K + C) * 2u; }
    const size_t kstep = (size_t)(BK * 2);
    const size_t hstep = (size_t)HALF * K * 2;
    const size_t tstep = 2 * hstep;
    const unsigned ldsw = (unsigned)wid * 1024u;
    const int aoff = lds_byte(wr * 64 + fr, fq * 8), boff = lds_byte(wc * 32 + fr, fq * 8);
#define PG8_SA(b, h) (((b) * 2 + (h)) * HTB)
#define PG8_SB(b, h) ((4 + (b) * 2 + (h)) * HTB)
#define PG8_STAGE(bufoff, gbase, voff) do { _Pragma("unroll") for (int _i = 0; _i < 2; ++_i) \
        __builtin_amdgcn_global_load_lds((const unsigned*)((const char*)(gbase) + (voff)[_i]), (PG8_LAS unsigned*)(lds + (bufoff) + ldsw + _i * 8192), 16, 0, 0); } while (0)
#define PG8_LDA(dst, b, h) do { _Pragma("unroll") for (int m = 0; m < 4; ++m) _Pragma("unroll") for (int k = 0; k < 2; ++k) dst[m][k] = *(const PG8_LAS bf16x8*)(lds + PG8_SA(b, h) + aoff + m * 2048 + k * 1024); } while (0)
#define PG8_LDB(dst, b, h) do { _Pragma("unroll") for (int n = 0; n < 2; ++n) _Pragma("unroll") for (int k = 0; k < 2; ++k) dst[n][k] = *(const PG8_LAS bf16x8*)(lds + PG8_SB(b, h) + boff + n * 2048 + k * 1024); } while (0)
#define PG8_MMA(ai, bj, At, Bt) do { __builtin_amdgcn_s_setprio(1); _Pragma("unroll") for (int m = 0; m < 4; ++m) _Pragma("unroll") for (int n = 0; n < 2; ++n) _Pragma("unroll") for (int k = 0; k < 2; ++k) \
        acc[ai][bj][m][n] = __builtin_amdgcn_mfma_f32_16x16x32_bf16(Bt[n][k], At[m][k], acc[ai][bj][m][n], 0, 0, 0); __builtin_amdgcn_s_setprio(0); } while (0)
#define PG8_WAIT_V(n) asm volatile("s_waitcnt vmcnt(" #n ")" ::: "memory")
#define PG8_WAIT_L(n) asm volatile("s_waitcnt lgkmcnt(" #n ")" ::: "memory")
#define PG8_BAR __builtin_amdgcn_s_barrier()
#define PG8_SCHED __builtin_amdgcn_sched_barrier(0)
    Unit cur, nxt; int ui = 0;
    if (!S.next(0, cur)) return;
    f32x4 acc[2][2][4][2];
#pragma unroll
    for (int a = 0; a < 2; ++a)
#pragma unroll
        for (int b = 0; b < 2; ++b)
#pragma unroll
            for (int m = 0; m < 4; ++m)
#pragma unroll
                for (int n = 0; n < 2; ++n) acc[a][b][m][n] = (f32x4){0.f, 0.f, 0.f, 0.f};
    bf16x8 At[4][2], B0[2][2], B1[2][2];
    const char* cA = (const char*)g.A + (size_t)cur.pm * tstep; const char* cB = (const char*)g.Bt + (size_t)cur.pn * tstep;
    S.a_ready(cur);
    if constexpr (SP2) {
        PG8_STAGE(PG8_SB(0, 0), cB, voffB); PG8_STAGE(PG8_SB(0, 1), cB + hstep, voffB); PG8_STAGE(PG8_SA(0, 0), cA, voffA); PG8_STAGE(PG8_SA(0, 1), cA + hstep, voffA);
        if (wr == 1) PG8_BAR;
        PG8_WAIT_V(2); PG8_BAR;
        PG8_STAGE(PG8_SB(1, 0), cB + kstep, voffB); PG8_STAGE(PG8_SA(1, 0), cA + kstep, voffA); PG8_STAGE(PG8_SB(1, 1), cB + hstep + kstep, voffB);
        PG8_WAIT_V(6); PG8_BAR;
    } else {
        PG8_STAGE(PG8_SB(0, 0), cB, voffB); PG8_STAGE(PG8_SA(0, 0), cA, voffA); PG8_STAGE(PG8_SB(0, 1), cB + hstep, voffB); PG8_STAGE(PG8_SA(0, 1), cA + hstep, voffA);
        if (wr == 1) PG8_BAR;
        PG8_WAIT_V(4); PG8_BAR;
        PG8_STAGE(PG8_SB(1, 0), cB + kstep, voffB); PG8_STAGE(PG8_SA(1, 0), cA + kstep, voffA); PG8_STAGE(PG8_SB(1, 1), cB + hstep + kstep, voffB);
        PG8_WAIT_V(6); PG8_BAR;
    }
    for (;;) {
        const bool has_next = S.next(ui + 1, nxt);
        const char* nA = has_next ? (const char*)g.A + (size_t)nxt.pm * tstep : cA; const char* nB = has_next ? (const char*)g.Bt + (size_t)nxt.pn * tstep : cB;
        for (int t = 0; t < nt; t += 2) {
            if constexpr (Epi::MIDK) { if (t == nt / 2) E.midk(acc, ui, wr, fr); }
            const bool last = (t == nt - 2);
            const char* a1 = cA + (size_t)(t + 1) * kstep;
            const char* a2 = last ? nA : cA + (size_t)(t + 2) * kstep; const char* b2 = last ? nB : cB + (size_t)(t + 2) * kstep;
            const char* a3 = a2 + kstep; const char* b3 = b2 + kstep;
            if (last && has_next) S.a_ready(nxt);
            if constexpr (SP2) {
            PG8_LDB(B0, 0, 0); PG8_LDB(B1, 0, 1); PG8_SCHED; PG8_LDA(At, 0, 0); PG8_STAGE(PG8_SA(1, 1), a1 + hstep, voffA);
            PG8_WAIT_V(8); PG8_WAIT_L(0); PG8_BAR; PG8_MMA(0, 0, At, B0); PG8_MMA(0, 1, At, B1); PG8_BAR; PG8_SCHED;
            PG8_LDA(At, 0, 1); PG8_STAGE(PG8_SB(0, 0), b2, voffB); PG8_STAGE(PG8_SB(0, 1), b2 + hstep, voffB); PG8_STAGE(PG8_SA(0, 0), a2, voffA);
            PG8_WAIT_V(8); PG8_WAIT_L(0); PG8_BAR; PG8_MMA(1, 0, At, B0); PG8_MMA(1, 1, At, B1); PG8_BAR; PG8_SCHED;
            PG8_LDB(B0, 1, 0); PG8_LDB(B1, 1, 1); PG8_SCHED; PG8_LDA(At, 1, 0); PG8_STAGE(PG8_SA(0, 1), a2 + hstep, voffA);
            PG8_WAIT_V(8); PG8_WAIT_L(0); PG8_BAR; PG8_MMA(0, 0, At, B0); PG8_MMA(0, 1, At, B1); PG8_BAR; PG8_SCHED;
            PG8_LDA(At, 1, 1); PG8_STAGE(PG8_SB(1, 0), b3, voffB); PG8_STAGE(PG8_SB(1, 1), b3 + hstep, voffB); PG8_STAGE(PG8_SA(1, 0), a3, voffA);
            PG8_WAIT_V(8); PG8_WAIT_L(0); PG8_BAR; PG8_MMA(1, 0, At, B0); PG8_MMA(1, 1, At, B1); PG8_BAR; PG8_SCHED;
            } else {
            PG8_LDB(B0, 0, 0); PG8_SCHED; PG8_LDA(At, 0, 0); PG8_STAGE(PG8_SA(1, 1), a1 + hstep, voffA);
            PG8_WAIT_L(8); PG8_BAR; PG8_WAIT_L(0); PG8_MMA(0, 0, At, B0); PG8_BAR; PG8_SCHED;
            PG8_LDB(B1, 0, 1); PG8_STAGE(PG8_SB(0, 0), b2, voffB);
            PG8_BAR; PG8_WAIT_L(0); PG8_MMA(0, 1, At, B1); PG8_BAR;
            PG8_LDA(At, 0, 1); PG8_STAGE(PG8_SA(0, 0), a2, voffA);
            PG8_BAR; PG8_WAIT_L(0); PG8_MMA(1, 0, At, B0); PG8_BAR; PG8_SCHED;
            PG8_STAGE(PG8_SB(0, 1), b2 + hstep, voffB);
            PG8_WAIT_V(6); PG8_BAR; PG8_MMA(1, 1, At, B1); PG8_BAR;
            PG8_LDB(B0, 1, 0); PG8_SCHED; PG8_LDA(At, 1, 0); PG8_STAGE(PG8_SA(0, 1), a2 + hstep, voffA);
            PG8_WAIT_L(8); PG8_BAR; PG8_WAIT_L(0); PG8_MMA(0, 0, At, B0); PG8_BAR; PG8_SCHED;
            PG8_LDB(B1, 1, 1); PG8_STAGE(PG8_SB(1, 0), b3, voffB);
            PG8_BAR; PG8_WAIT_L(0); PG8_MMA(0, 1, At, B1); PG8_BAR;
            PG8_LDA(At, 1, 1); PG8_STAGE(PG8_SA(1, 0), a3, voffA);
            PG8_BAR; PG8_WAIT_L(0); PG8_MMA(1, 0, At, B0); PG8_BAR; PG8_SCHED;
            PG8_STAGE(PG8_SB(1, 1), b3 + hstep, voffB);
            PG8_WAIT_V(6); PG8_BAR; PG8_MMA(1, 1, At, B1); PG8_BAR;
            }
        }
        if constexpr (ALIGN_EPI) { if (wr == 0) PG8_BAR; }
        if constexpr (Epi::MIDK) { E.epi(acc, cur, ui, wr, wc, fr, fq); S.done(cur); }
        else if constexpr (!Epi::AFTER_DRAIN) { E(acc, cur, wr, wc, fr, fq); S.done(cur); }
        if (!has_next) break;
#pragma unroll
        for (int a = 0; a < 2; ++a)
#pragma unroll
            for (int b = 0; b < 2; ++b)
#pragma unroll
                for (int m = 0; m < 4; ++m)
#pragma unroll
                    for (int n = 0; n < 2; ++n) acc[a][b][m][n] = (f32x4){0.f, 0.f, 0.f, 0.f};
        cur = nxt; cA = nA; cB = nB; ++ui;
        if constexpr (ALIGN_EPI) { if (wr == 1) PG8_BAR; }
    }
    PG8_WAIT_V(0);
    if constexpr (!ALIGN_EPI) { if (wr == 0) PG8_BAR; }
    PG8_BAR;
    if constexpr (Epi::AFTER_DRAIN) { E.fused(acc, cur, wr, wc, fr, fq, lds, wid, lane); S.done(cur); }
#undef PG8_SA
#undef PG8_SB
#undef PG8_STAGE
#undef PG8_LDA
#undef PG8_LDB
#undef PG8_MMA
#undef PG8_WAIT_V
#undef PG8_WAIT_L
#undef PG8_BAR
#undef PG8_SCHED
}
}

namespace pg8 {
struct EpiInProjT {
    static constexpr bool PERM = true, AFTER_DRAIN = false, MIDK = false;
    unsigned char* ws;
    __device__ __forceinline__ void operator()(const f32x4 (&acc)[2][2][4][2], const Unit& u, int wr, int wc, int fr, int fq) const {
        const int row0 = u.pm * BM + wr * 64 + fr, pn = u.pn, cin = wc * 32 + 8 * fq;
        if (pn == 17) {
            if (wc == 0 && fq < 2) { float* F = (float*)(ws + WS_F);
#pragma unroll
                for (int ai = 0; ai < 2; ++ai)
#pragma unroll
                    for (int m = 0; m < 4; ++m)
#pragma unroll
                        for (int n = 0; n < 2; ++n)
#pragma unroll
                            for (int j = 0; j < 4; ++j) F[(size_t)(8 * fq + 4 * n + j) * M + row0 + ai * HALF + m * 16] = acc[ai][0][m][n][j]; }
            return;
        }
        bf16_t *b0, *b1; int ldc; float sc = 1.f;
        if (pn < 4) { b0 = (bf16_t*)(ws + WS_QA) + pn * 256 + cin; b1 = b0 + HALF; ldc = 1024; sc = C2; }
        else if (pn == 4) { b0 = (bf16_t*)(ws + WS_KA) + cin; b1 = (bf16_t*)(ws + WS_VA) + cin; ldc = 128; }
        else if (pn < 9) { b0 = (bf16_t*)(ws + WS_QB) + (pn - 5) * 256 + cin; b1 = b0 + HALF; ldc = 1024; sc = C2; }
        else if (pn < 13) { b0 = (bf16_t*)(ws + WS_KB) + (pn - 9) * 256 + cin; b1 = b0 + HALF; ldc = 1024; }
        else { b0 = (bf16_t*)(ws + WS_VB) + (pn - 13) * 256 + cin; b1 = b0 + HALF; ldc = 1024; }
#pragma unroll
        for (int ai = 0; ai < 2; ++ai)
#pragma unroll
            for (int m = 0; m < 4; ++m) { const size_t ro = (size_t)(row0 + ai * HALF + m * 16) * ldc;
#pragma unroll
                for (int bj = 0; bj < 2; ++bj) { const f32x4 v0 = acc[ai][bj][m][0] * sc, v1 = acc[ai][bj][m][1] * sc;
                    u32x4 w; w.x = cvt_pk_bf16(v0[0], v0[1]); w.y = cvt_pk_bf16(v0[2], v0[3]); w.z = cvt_pk_bf16(v1[0], v1[1]); w.w = cvt_pk_bf16(v1[2], v1[3]);
                    *(u32x4*)((bj ? b1 : b0) + ro) = w; } }
    }
};
struct EpiBf16T {
    static constexpr bool PERM = true, AFTER_DRAIN = false, MIDK = false;
    bf16_t* C; int ldc;
    __device__ __forceinline__ void operator()(const f32x4 (&acc)[2][2][4][2], const Unit& u, int wr, int wc, int fr, int fq) const {
        const int row0 = u.pm * BM + wr * 64 + fr, col0 = u.pn * BM + wc * 32 + 8 * fq;
#pragma unroll
        for (int ai = 0; ai < 2; ++ai)
#pragma unroll
            for (int m = 0; m < 4; ++m) { bf16_t* rp = C + (size_t)(row0 + ai * HALF + m * 16) * ldc + col0;
#pragma unroll
                for (int bj = 0; bj < 2; ++bj) { const f32x4 v0 = acc[ai][bj][m][0], v1 = acc[ai][bj][m][1];
                    u32x4 w; w.x = cvt_pk_bf16(v0[0], v0[1]); w.y = cvt_pk_bf16(v0[2], v0[3]); w.z = cvt_pk_bf16(v1[0], v1[1]); w.w = cvt_pk_bf16(v1[2], v1[3]);
                    *(u32x4*)(rp + bj * HALF) = w; } }
    }
};
struct EpiOutT {
    static constexpr bool PERM = true, AFTER_DRAIN = false, MIDK = true;
    bf16_t* C; int ldc; const PG8_LAS float* T;
    __device__ __forceinline__ void midk(f32x4 (&acc)[2][2][4][2], int ui, int wr, int fr) const {
#pragma unroll
        for (int ai = 0; ai < 2; ++ai)
#pragma unroll
            for (int m = 0; m < 4; ++m) { const float r = T[((ui & 1) * 256 + ai * HALF + wr * 64 + m * 16 + fr) * 2];
#pragma unroll
                for (int bj = 0; bj < 2; ++bj)
#pragma unroll
                    for (int n = 0; n < 2; ++n) acc[ai][bj][m][n] *= r; }
    }
    __device__ __forceinline__ void epi(const f32x4 (&acc)[2][2][4][2], const Unit& u, int ui, int wr, int wc, int fr, int fq) const {
        const int row0 = u.pm * BM + wr * 64 + fr, col0 = u.pn * BM + wc * 32 + 8 * fq;
#pragma unroll
        for (int ai = 0; ai < 2; ++ai)
#pragma unroll
            for (int m = 0; m < 4; ++m) { bf16_t* rp = C + (size_t)(row0 + ai * HALF + m * 16) * ldc + col0; const float r = T[((ui & 1) * 256 + ai * HALF + wr * 64 + m * 16 + fr) * 2 + 1];
#pragma unroll
                for (int bj = 0; bj < 2; ++bj) { const f32x4 v0 = acc[ai][bj][m][0] * r, v1 = acc[ai][bj][m][1] * r;
                    u32x4 w; w.x = cvt_pk_bf16(v0[0], v0[1]); w.y = cvt_pk_bf16(v0[2], v0[3]); w.z = cvt_pk_bf16(v1[0], v1[1]); w.w = cvt_pk_bf16(v1[2], v1[3]);
                    *(u32x4*)(rp + bj * HALF) = w; } }
    }
};
}

namespace pg8 {
__device__ __forceinline__ float dpp_ror1(float x) { return __builtin_bit_cast(float, __builtin_amdgcn_mov_dpp(__builtin_bit_cast(int, x), 0x121, 0xf, 0xf, true)); }
__device__ __forceinline__ float dpp_ror2(float x) { return __builtin_bit_cast(float, __builtin_amdgcn_mov_dpp(__builtin_bit_cast(int, x), 0x122, 0xf, 0xf, true)); }
__device__ __forceinline__ float gelu_tanh_fast(float x) {
    const float e = __builtin_amdgcn_exp2f(-2.3022082f * x * (1.0f + 0.044715f * x * x));
    return x * __builtin_amdgcn_rcpf(1.0f + e);
}
__device__ __forceinline__ f32x4 geglu4(f32x4 g, f32x4 v) {
    const f32x4 t = (g * g) * 0.044715f + 1.0f, a = (g * -2.3022082f) * t;
    f32x4 e; e[0] = __builtin_amdgcn_exp2f(a[0]); e[1] = __builtin_amdgcn_exp2f(a[1]); e[2] = __builtin_amdgcn_exp2f(a[2]); e[3] = __builtin_amdgcn_exp2f(a[3]);
    e = e + 1.0f;
    f32x4 r; r[0] = __builtin_amdgcn_rcpf(e[0]); r[1] = __builtin_amdgcn_rcpf(e[1]); r[2] = __builtin_amdgcn_rcpf(e[2]); r[3] = __builtin_amdgcn_rcpf(e[3]);
    return (g * v) * r;
}
constexpr size_t SIDE_HEAD = 0, SIDE_TAIL = 6 * MiB;
struct EpiUpT {
    static constexpr bool PERM = true, AFTER_DRAIN = false, MIDK = false;
    bf16_t* act; const float* cw; const float* cb; float* side; PG8_LAS float* X;
    __device__ __forceinline__ void operator()(const f32x4 (&acc)[2][2][4][2], const Unit& u, int wr, int wc, int fr, int fq) const {
        const int cin = wc * 32 + 8 * fq;
        f32x4 Wt[2][2][4];
#define EPIUP_LOADW(n_) do { _Pragma("unroll") for (int bj_ = 0; bj_ < 2; ++bj_) { const int col_ = bj_ * DFF + HALF * u.pn + cin + 4 * (n_); \
            Wt[n_][bj_][1] = *(const f32x4*)(cw + NUP + col_); Wt[n_][bj_][2] = *(const f32x4*)(cw + 2 * NUP + col_); } } while (0)
#define EPIUP_LOADB(n_) do { _Pragma("unroll") for (int bj_ = 0; bj_ < 2; ++bj_) { Wt[n_][bj_][3] = *(const f32x4*)(cb + bj_ * DFF + HALF * u.pn + cin + 4 * (n_)); Wt[n_][bj_][0] = *(const f32x4*)(cw + bj_ * DFF + HALF * u.pn + cin + 4 * (n_)); } } while (0)
        EPIUP_LOADW(0); EPIUP_LOADB(0);
        if (fr >= 14) {
#pragma unroll
            for (int ai = 0; ai < 2; ++ai)
#pragma unroll
                for (int bj = 0; bj < 2; ++bj)
#pragma unroll
                    for (int n = 0; n < 2; ++n) *(PG8_LAS f32x4*)(X + ((2 * ai + wr) * 2 + (fr - 14)) * 256 + bj * HALF + cin + 4 * n) = acc[ai][bj][3][n];
            if (wr == 1) {
#pragma unroll
                for (int bj = 0; bj < 2; ++bj)
#pragma unroll
                    for (int n = 0; n < 2; ++n) *(f32x4*)(side + SIDE_TAIL / 4 + ((size_t)u.pm * 2 + (fr - 14)) * NUP + u.pn * BM + bj * HALF + cin + 4 * n) = acc[1][bj][3][n];
            }
        }
        if (fr < 2 && wr == 0) {
#pragma unroll
            for (int bj = 0; bj < 2; ++bj)
#pragma unroll
                for (int n = 0; n < 2; ++n) *(f32x4*)(side + SIDE_HEAD / 4 + ((size_t)u.pm * 2 + fr) * NUP + u.pn * BM + bj * HALF + cin + 4 * n) = acc[0][bj][0][n];
        }
        asm volatile("s_waitcnt lgkmcnt(0)" ::: "memory"); __builtin_amdgcn_s_barrier(); asm volatile("" ::: "memory");
#pragma unroll
        for (int n = 0; n < 2; ++n) {
            if (n == 0) { EPIUP_LOADW(1); __builtin_amdgcn_sched_barrier(0); } else { EPIUP_LOADB(1); __builtin_amdgcn_sched_barrier(0); }
#pragma unroll
            for (int ai = 0; ai < 2; ++ai) {
                const int b4 = 2 * ai + wr;
                f32x4 p1[2], p2[2];
#pragma unroll
                for (int bj = 0; bj < 2; ++bj) {
                    f32x4 h62 = (f32x4){0.f, 0.f, 0.f, 0.f}, h63 = h62;
                    if (b4 > 0) { h62 = *(const PG8_LAS f32x4*)(X + ((b4 - 1) * 2 + 0) * 256 + bj * HALF + cin + 4 * n); h63 = *(const PG8_LAS f32x4*)(X + ((b4 - 1) * 2 + 1) * 256 + bj * HALF + cin + 4 * n); }
                    p1[bj] = h63; p2[bj] = (fr == 1) ? h63 : h62;
                }
#pragma unroll
                for (int m = 0; m < 4; ++m) {
                    f32x4 y[2];
#pragma unroll
                    for (int bj = 0; bj < 2; ++bj) {
                        const f32x4 v = acc[ai][bj][m][n];
                        f32x4 r1, r2;
#pragma unroll
                        for (int j = 0; j < 4; ++j) { r1[j] = dpp_ror1(v[j]); r2[j] = dpp_ror2(v[j]); }
                        const f32x4 q1 = (fr >= 1) ? r1 : p1[bj], q2 = (fr >= 2) ? r2 : p2[bj];
                        y[bj] = (Wt[n][bj][2] * v + Wt[n][bj][1] * q1) + (Wt[n][bj][0] * q2 + Wt[n][bj][3]);
                        p1[bj] = r1; p2[bj] = r2;
                    }
                    typedef unsigned u32x2v __attribute__((ext_vector_type(2)));
                    const f32x4 o4 = geglu4(y[0], y[1]); u32x2v w; w.x = cvt_pk_bf16(o4[0], o4[1]); w.y = cvt_pk_bf16(o4[2], o4[3]);
                    *(u32x2v*)(act + (size_t)(u.pm * BM + ai * HALF + wr * 64 + m * 16 + fr) * DFF + HALF * u.pn + cin + 4 * n) = w;
                    __builtin_amdgcn_sched_barrier(0);
                }
            }
            asm volatile("" ::: "memory"); __builtin_amdgcn_sched_barrier(0);
        }
#undef EPIUP_LOADW
#undef EPIUP_LOADB
    }
};
}
__device__ __forceinline__ void ph_convfix(const float* side, const float* cw, const float* cb, bf16_t* act) {
    const float* head = side + pg8::SIDE_HEAD / 4; const float* tail = side + pg8::SIDE_TAIL / 4;
    for (int idx = blockIdx.x * 512 + threadIdx.x; idx < 64 * 2 * DFF; idx += gridDim.x * 512) {
        const int pm = idx / (2 * DFF), r = (idx / DFF) & 1, n = idx % DFF;
        if ((pm & 15) == 0) continue;
        const int pg = ((n >> 7) << 8) + (n & 127);
        float y[2];
#pragma unroll
        for (int h = 0; h < 2; ++h) { const int pc = pg + 128 * h, col = h * DFF + n;
            const float H0 = head[((size_t)pm * 2 + 0) * NUP + pc], H1 = head[((size_t)pm * 2 + 1) * NUP + pc];
            const float T0 = tail[((size_t)(pm - 1) * 2 + 0) * NUP + pc], T1 = tail[((size_t)(pm - 1) * 2 + 1) * NUP + pc];
            const float w0 = cw[col], w1 = cw[NUP + col], w2 = cw[2 * NUP + col];
            y[h] = cb[col] + (r == 0 ? (w2 * H0 + w1 * T1 + w0 * T0) : (w2 * H1 + w1 * H0 + w0 * T1)); }
        act[(size_t)(256 * pm + r) * DFF + n] = (bf16_t)f2bf(gelu_tanh(y[0]) * y[1]);
    }
}
#include <hip/hip_bf16.h>
#include <cmath>
namespace attn_body {
using bf16=__hip_bfloat16;
using bf16x8=__attribute__((ext_vector_type(8)))short;
using s16x4=__attribute__((ext_vector_type(4)))short;
using f32x16=__attribute__((ext_vector_type(16)))float;
using u32x4=__attribute__((ext_vector_type(4)))unsigned;
using f32x4v=__attribute__((ext_vector_type(4)))float;
constexpr int BATCH=4,NHEAD=16,SEQ=4096,D=64,QP=1024,OP=2048;
constexpr int NW=8,QBLK=32,QB=QBLK*NW,KVBLK=64,NQB=SEQ/QB;
constexpr int ATTN_UNIT_ROWS=QB;
__device__ __forceinline__ int crow(int r,int hi){return (r&3)+8*(r>>2)+4*hi;}
#define SBAR() __builtin_amdgcn_sched_barrier(0)
template<bool WIN> __device__ __forceinline__ void amask(f32x16&p0,f32x16&p1,int koff,int qrel,int hi){
  const float NEG=-INFINITY; int d=qrel-(koff+4*hi); asm volatile("":"+v"(d));
  #pragma unroll
  for(int r=0;r<16;++r){const int kc=(r&3)+8*(r>>2);
    if(kc>d||(WIN&&kc<=d-128))p0[r]=NEG; if(kc+32>d||(WIN&&kc+32<=d-128))p1[r]=NEG;}
}

constexpr int NSLOT=3, SLOTB=8192;
constexpr int LDS_K=0, LDS_V=NSLOT*SLOTB, LDS_WS=2*NSLOT*SLOTB, LDS_OST=LDS_WS+NW*64*4, LDS_CL=LDS_OST+NW*4096+2048, LDS_CL2=LDS_CL+SEQ*4, LDS_WT=LDS_CL2+384*4, LDS_BYTES=LDS_WT+64;
constexpr float C2=0.125f*1.4426950408889634f;
__device__ __forceinline__ void glds16(const void*gsrc,unsigned lds_dst){unsigned keep;
  asm volatile("s_mov_b32 %0, m0\n\ts_mov_b32 m0, %2\n\ts_nop 0\n\tglobal_load_lds_dwordx4 %1, off\n\ts_mov_b32 m0, %0":"=&s"(keep):"v"(gsrc),"s"(lds_dst):"memory");}
__device__ __forceinline__ float max3f(float a,float b,float c){float r;asm("v_max3_f32 %0, %1, %2, %3":"=v"(r):"v"(a),"v"(b),"v"(c));return r;}
__device__ __forceinline__ float max2f(float a,float b){float r;asm("v_max_f32_e32 %0, %1, %2":"=v"(r):"v"(a),"v"(b));return r;}
__device__ __forceinline__ float fadd_s(float a,float b){float r;asm("v_add_f32_e32 %0, %1, %2":"=v"(r):"v"(a),"v"(b));return r;}
__device__ __forceinline__ float fsub_s(float a,float b){float r;asm("v_sub_f32_e32 %0, %1, %2":"=v"(r):"v"(a),"v"(b));return r;}
typedef float f32x2_t __attribute__((ext_vector_type(2))); typedef __bf16 bf16x2_t __attribute__((ext_vector_type(2)));
__device__ __forceinline__ unsigned cvtpk_s(float lo,float hi){f32x2_t v={lo,hi};bf16x2_t b=__builtin_convertvector(v,bf16x2_t);return __builtin_bit_cast(unsigned,b);}
#define WAIT_BAR(N) asm volatile("s_waitcnt vmcnt(" #N ") lgkmcnt(0)\n\ts_barrier":::"memory")

__device__ __forceinline__ void qkt(f32x16&p0,f32x16&p1,const char*Kslot,const bf16x8*qr,int r32,int hi){
  const char*kb=Kslot+hi*1024+r32*16;
  #pragma unroll
  for(int d0=0;d0<4;++d0){
    const bf16x8 b0=*reinterpret_cast<const bf16x8*>(kb+d0*2048);
    const bf16x8 b1=*reinterpret_cast<const bf16x8*>(kb+d0*2048+512);
    if(d0==0){p0=__builtin_amdgcn_mfma_f32_32x32x16_bf16(b0,qr[0],p0,0,0,0);p1=__builtin_amdgcn_mfma_f32_32x32x16_bf16(b1,qr[0],p1,0,0,0);}
    else{p0=__builtin_amdgcn_mfma_f32_32x32x16_bf16(b0,qr[d0],p0,0,0,0);p1=__builtin_amdgcn_mfma_f32_32x32x16_bf16(b1,qr[d0],p1,0,0,0);}}
}
typedef __attribute__((address_space(3))) const char* lds_cptr;
typedef short v4i16_t __attribute__((ext_vector_type(4)));
__device__ __forceinline__ void kload8(bf16x8*kf,lds_cptr kp){
  kf[0]=*(const __attribute__((address_space(3))) bf16x8*)(kp);      kf[1]=*(const __attribute__((address_space(3))) bf16x8*)(kp+512);
  kf[2]=*(const __attribute__((address_space(3))) bf16x8*)(kp+2048); kf[3]=*(const __attribute__((address_space(3))) bf16x8*)(kp+2560);
  kf[4]=*(const __attribute__((address_space(3))) bf16x8*)(kp+4096); kf[5]=*(const __attribute__((address_space(3))) bf16x8*)(kp+4608);
  kf[6]=*(const __attribute__((address_space(3))) bf16x8*)(kp+6144); kf[7]=*(const __attribute__((address_space(3))) bf16x8*)(kp+6656);
}
__device__ __forceinline__ void kload2(bf16x8*kf,lds_cptr kp,int j){ kf[2*j]=*(const __attribute__((address_space(3))) bf16x8*)(kp+j*2048); kf[2*j+1]=*(const __attribute__((address_space(3))) bf16x8*)(kp+j*2048+512); }
__device__ __forceinline__ s16x4 vtr(lds_cptr p){ return __builtin_bit_cast(s16x4,__builtin_amdgcn_ds_read_tr16_b64_v4i16((__attribute__((address_space(3))) v4i16_t*)p)); }
__device__ __forceinline__ float rowmax(const f32x16&p0,const f32x16&p1){
  float a=max3f(p0[0],p0[1],p1[0]),b=max3f(p0[2],p0[3],p1[1]);a=max3f(a,p1[2],p1[3]);
  #pragma unroll
  for(int r=4;r<16;r+=4){a=max3f(a,p0[r],p0[r+1]);b=max3f(b,p0[r+2],p0[r+3]);a=max3f(a,p1[r],p1[r+1]);b=max3f(b,p1[r+2],p1[r+3]);}
  const float m=max2f(a,b);
  auto rr=__builtin_amdgcn_permlane32_swap(__float_as_uint(m),__float_as_uint(m),false,false);
  return max2f(__uint_as_float(rr[0]),__uint_as_float(rr[1]));
}
__device__ __forceinline__ void pv(f32x16*o,int vb,bf16x8 pa0,bf16x8 pa1,bf16x8 pa2,bf16x8 pa3){
  #pragma unroll
  for(int d0=0;d0<2;++d0){s16x4 lo[4],hi[4];
    #pragma unroll
    for(int ks=0;ks<4;++ks){
      asm volatile("ds_read_b64_tr_b16 %0,%1 offset:%c2":"=&v"(lo[ks]):"v"(vb),"i"(d0*4096+ks*1024):"memory");
      asm volatile("ds_read_b64_tr_b16 %0,%1 offset:%c2":"=&v"(hi[ks]):"v"(vb),"i"(d0*4096+ks*1024+512):"memory");}
    asm volatile("s_waitcnt lgkmcnt(0)":::"memory");SBAR();
    #define PK(k) (bf16x8){lo[k][0],lo[k][1],lo[k][2],lo[k][3],hi[k][0],hi[k][1],hi[k][2],hi[k][3]}
    o[d0]=__builtin_amdgcn_mfma_f32_32x32x16_bf16(pa0,PK(0),o[d0],0,0,0);
    o[d0]=__builtin_amdgcn_mfma_f32_32x32x16_bf16(pa1,PK(1),o[d0],0,0,0);
    o[d0]=__builtin_amdgcn_mfma_f32_32x32x16_bf16(pa2,PK(2),o[d0],0,0,0);
    o[d0]=__builtin_amdgcn_mfma_f32_32x32x16_bf16(pa3,PK(3),o[d0],0,0,0);
    #undef PK
  }
}

#ifndef ATTN_STORE16
#define ATTN_STORE16(p,v) (*(u32x4*)(p)=(v))
#endif
template<int THRL,int MODE> __device__ __forceinline__ void attn_unit(int b,int h,int qb,const bf16*Q,const bf16*__restrict__ K,const bf16*__restrict__ V,int KP,int kvcol,bf16*O,int ocol,float*ssq,float slope_l2,float sink_l2,char*shm){
  int tid=threadIdx.x; asm volatile("":"+v"(tid));
  const int lane=tid&63,r32=lane&31,hi=lane>>5; const int wid=__builtin_amdgcn_readfirstlane(tid>>6);
  const long rowbase=(long)b*SEQ; const int q0=qb*QB;
  const int t0=(MODE==0)?((qb>0)?4*qb-2:0):0;
  const bf16*Qw=Q+(rowbase+q0+wid*QBLK)*QP+h*D;
  const bf16*Kh=K+(rowbase+(long)t0*KVBLK)*KP+kvcol,*Vh=V+(rowbase+(long)t0*KVBLK)*KP+kvcol;
  const unsigned lds0=(unsigned)(uintptr_t)shm;
  float*wsf=(float*)(shm+LDS_WS)+wid*64;
  const bf16*ksrc=Kh+(long)lane*KP+wid*8;
  const bf16*vsrc=Vh+(long)(16*(wid&3)+(lane>>2))*KP+(wid>>2)*32+(lane&3)*8;
  const unsigned kdst=lds0+LDS_K+wid*1024, vdst=lds0+LDS_V+wid*1024;
  #define DMA_K(t,slot) glds16(ksrc+(long)(t)*KVBLK*KP,(unsigned)__builtin_amdgcn_readfirstlane(kdst+(slot)))
  #define DMA_V(t,slot) glds16(vsrc+(long)(t)*KVBLK*KP,(unsigned)__builtin_amdgcn_readfirstlane(vdst+(slot)))
  const int vb0=(int)(lds0+LDS_V)+((lane>>4)&1)*32+(lane&3)*8+(4*hi+((lane&15)>>2))*64;
  const char*Kbase=shm+LDS_K; bf16x8 kf[8];
  const lds_cptr shm3=(lds_cptr)shm; const lds_cptr kp0=shm3+LDS_K+hi*1024+r32*16; const lds_cptr vp0=shm3+LDS_V+((lane>>4)&1)*32+(lane&3)*8+(4*hi+((lane&15)>>2))*64;
  const int NT=(MODE==0)?((qb>0)?6:4):(q0+QB)/KVBLK;
  typedef __attribute__((address_space(3))) float* lds_fptr;
  const lds_fptr cl=(lds_fptr)((lds_cptr)shm+((MODE==1)?LDS_CL:LDS_CL2));
  if(MODE==0){ if(tid<384)cl[tid]=-slope_l2*(float)tid; }
  DMA_K(0,0);DMA_V(0,0);DMA_K(1,SLOTB);
  bf16x8 qr[4];
  #pragma unroll
  for(int d0=0;d0<4;++d0)qr[d0]=*reinterpret_cast<const bf16x8*>(&Qw[(long)r32*QP+d0*16+hi*8]);
  float mhat=0.f,l_reg=0.f;f32x16 o[2];o[0]=f32x16{};o[1]=f32x16{};
  const int qrel=wid*QBLK+r32;
  asm volatile("s_waitcnt lgkmcnt(0)\n\ts_barrier":::"memory");
  const float ct=cl[q0-t0*KVBLK+qrel];
  float nm=ct;
  #define CINIT(I0,I1,t) do{ const lds_fptr cp_=cl+64*(t)+4*hi; _Pragma("unroll") for(int g_=0;g_<4;++g_){ \
      const f32x4v a_=*(const __attribute__((address_space(3))) f32x4v*)(cp_+8*g_), b_=*(const __attribute__((address_space(3))) f32x4v*)(cp_+8*g_+32); \
      _Pragma("unroll") for(int j_=0;j_<4;++j_){ I0[4*g_+j_]=nm-a_[j_]; I1[4*g_+j_]=nm-b_[j_]; } SBAR(); } }while(0)
  #define CMASK(P0,P1,t) do{int ko_=64*((t)-(NT-4)); if(MODE==0||ko_>=0)amask<MODE==0>(P0,P1,ko_,qrel,hi);}while(0)
  bool resc=false;
  #define START(P0,P1) do{ const float rm=rowmax(P0,P1); resc=false; \
    { const float dl=__builtin_fmaxf(rm,-1000.f); mhat=fadd_s(mhat,dl); \
      _Pragma("unroll") for(int r=0;r<16;++r){P0[r]=fsub_s(P0[r],dl);P1[r]=fsub_s(P1[r],dl);} \
      nm=ct-mhat; } \
    _Pragma("unroll") for(int r=0;r<16;++r)P0[r]=__builtin_amdgcn_exp2f(P0[r]); }while(0)
  #define RESC() do{ if(resc){ asm volatile("s_waitcnt lgkmcnt(0)":::"memory"); \
      _Pragma("unroll") for(int d_=0;d_<2;++d_) _Pragma("unroll") for(int r=0;r<16;++r)o[d_][r]*=wsf[crow(r,hi)]; } }while(0)
  f32x16 pA0,pA1,pB0,pB1;
  int sl_prev=0,sl_cur=0,sl_next=SLOTB;
  #define ROT() do{sl_prev=sl_cur;sl_cur=sl_next;sl_next=(sl_next==(NSLOT-1)*SLOTB)?0:sl_next+SLOTB;}while(0)
  DMA_K(2,2*SLOTB);
  WAIT_BAR(3);
  CINIT(pA0,pA1,0); qkt(pA0,pA1,Kbase,qr,r32,hi);asm volatile("s_nop 15\n\ts_nop 7":"+v"(pA0),"+v"(pA1));CMASK(pA0,pA1,0);
  START(pA0,pA1);
  _Pragma("unroll") for(int r=0;r<16;++r)pA1[r]=__builtin_amdgcn_exp2f(pA1[r]);
  WAIT_BAR(0);
  DMA_K(3,0);DMA_V(1,SLOTB);
  ROT();
  kload8(kf,kp0+sl_cur);
  WAIT_BAR(2);
  s16x4 vlo[8],vhi[8]; u32x4 pw0,pw1,pw2,pw3;
  #define PKW(P,B) cvtpk_s(P[B],P[B+1])
  #define PAF(k) __builtin_bit_cast(bf16x8,pw##k)
  #define VFR(i) (bf16x8){vlo[i][0],vlo[i][1],vlo[i][2],vlo[i][3],vhi[i][0],vhi[i][1],vhi[i][2],vhi[i][3]}
  #define PIN(x) asm volatile("":"+v"(x))
  #define MX3(a,b,c) __builtin_fmaxf(__builtin_fmaxf((a),(b)),(c))
  #define GAPA(MF,A0,A1,A2,A3,W0,W1,PW) do{ MF; sacc+=A0; sacc+=A1; sacc+=A2; sacc+=A3; PIN(sacc); W0; W1; PIN(PW); SBAR(); }while(0)
  #define EX(v) __builtin_amdgcn_exp2f(v)
  #define GAPB(MF,X,B) do{ MF; X[B]=EX(X[B]); X[B+1]=EX(X[B+1]); X[B+2]=EX(X[B+2]); X[B+3]=EX(X[B+3]); PIN(X); SBAR(); }while(0)
  #define VRD(i) do{ vlo[i]=vtr(vp_+(((i)>>2)*4096+((i)&3)*1024)); vhi[i]=vtr(vp_+(((i)>>2)*4096+((i)&3)*1024+512)); }while(0)
  #define KRD(G,j) do{ if(G){ kload2(kf,kp0+sl_next,j); SBAR(); } }while(0)
  #define STEP(C0,C1,P0,P1,t,GK,GV,GL) do{ SBAR(); CINIT(C0,C1,t); SBAR(); \
    const lds_cptr vp_=vp0+sl_prev; \
    VRD(0); SBAR(); float sacc=(P0[0]+P0[1]); \
    GAPA(C0=__builtin_amdgcn_mfma_f32_32x32x16_bf16(kf[0],qr[0],C0,0,0,0), P0[2],P0[3],P0[4],P0[5],     pw0[0]=PKW(P0,0), pw0[1]=PKW(P0,2), pw0); \
    VRD(4); SBAR(); GAPA(C1=__builtin_amdgcn_mfma_f32_32x32x16_bf16(kf[1],qr[0],C1,0,0,0), P0[6],P0[7],P0[8],P0[9],     pw0[2]=PKW(P0,4), pw0[3]=PKW(P0,6), pw0); \
    VRD(1); SBAR(); GAPA(C0=__builtin_amdgcn_mfma_f32_32x32x16_bf16(kf[2],qr[1],C0,0,0,0),   P0[10],P0[11],P0[12],P0[13], pw1[0]=PKW(P0,8), pw1[1]=PKW(P0,10), pw1); \
    VRD(5); SBAR(); GAPA(C1=__builtin_amdgcn_mfma_f32_32x32x16_bf16(kf[3],qr[1],C1,0,0,0),   P0[14],P0[15],P1[0],P1[1],   pw1[2]=PKW(P0,12),pw1[3]=PKW(P0,14), pw1); \
    VRD(2); SBAR(); GAPA(C0=__builtin_amdgcn_mfma_f32_32x32x16_bf16(kf[4],qr[2],C0,0,0,0),   P1[2],P1[3],P1[4],P1[5],     pw2[0]=PKW(P1,0), pw2[1]=PKW(P1,2), pw2); \
    VRD(6); SBAR(); GAPA(C1=__builtin_amdgcn_mfma_f32_32x32x16_bf16(kf[5],qr[2],C1,0,0,0),   P1[6],P1[7],P1[8],P1[9],     pw2[2]=PKW(P1,4), pw2[3]=PKW(P1,6), pw2); \
    VRD(3); SBAR(); GAPA(C0=__builtin_amdgcn_mfma_f32_32x32x16_bf16(kf[6],qr[3],C0,0,0,0),   P1[10],P1[11],P1[12],P1[13], pw3[0]=PKW(P1,8), pw3[1]=PKW(P1,10), pw3); \
    VRD(7); SBAR(); GAPA(C1=__builtin_amdgcn_mfma_f32_32x32x16_bf16(kf[7],qr[3],C1,0,0,0),   P1[14],P1[15],0.f,0.f,       pw3[2]=PKW(P1,12),pw3[3]=PKW(P1,14), pw3); \
    l_reg+=sacc; \
    if(GK){DMA_K((t)+3,sl_cur);} if(GV){DMA_V((t)+1,sl_next);} \
    CMASK(C0,C1,t); \
    { float a=MX3(C0[0],C0[1],C1[0]),b=MX3(C0[2],C0[3],C1[1]); a=MX3(a,C1[2],C1[3]); \
      _Pragma("unroll") for(int r=4;r<16;r+=4){a=MX3(a,C0[r],C0[r+1]);b=MX3(b,C0[r+2],C0[r+3]);a=MX3(a,C1[r],C1[r+1]);b=MX3(b,C1[r+2],C1[r+3]);} \
      float rm=__builtin_fmaxf(a,b); { auto rr=__builtin_amdgcn_permlane32_swap(__float_as_uint(rm),__float_as_uint(rm),false,false); rm=__builtin_fmaxf(__uint_as_float(rr[0]),__uint_as_float(rr[1])); } \
      resc=false; \
      if(__builtin_expect(__any(rm>(float)THRL),0)){ const float dl=__builtin_fmaxf(rm,0.f); mhat+=dl; \
        _Pragma("unroll") for(int r=0;r<16;++r){C0[r]-=dl;C1[r]-=dl;} \
        nm=ct-mhat; \
        const float f=__builtin_amdgcn_exp2f(-dl); l_reg*=f; if(hi==0)wsf[r32]=f; resc=true; } } \
    SBAR(); \
    GAPB(o[0]=__builtin_amdgcn_mfma_f32_32x32x16_bf16(PAF(0),VFR(0),o[0],0,0,0), C0,0); \
    GAPB(o[1]=__builtin_amdgcn_mfma_f32_32x32x16_bf16(PAF(0),VFR(4),o[1],0,0,0), C0,4); \
    KRD(GL,0); GAPB(o[0]=__builtin_amdgcn_mfma_f32_32x32x16_bf16(PAF(1),VFR(1),o[0],0,0,0), C0,8); \
    KRD(GL,1); GAPB(o[1]=__builtin_amdgcn_mfma_f32_32x32x16_bf16(PAF(1),VFR(5),o[1],0,0,0), C0,12); \
    KRD(GL,2); GAPB(o[0]=__builtin_amdgcn_mfma_f32_32x32x16_bf16(PAF(2),VFR(2),o[0],0,0,0), C1,0); \
    KRD(GL,3); GAPB(o[1]=__builtin_amdgcn_mfma_f32_32x32x16_bf16(PAF(2),VFR(6),o[1],0,0,0), C1,4); \
    GAPB(o[0]=__builtin_amdgcn_mfma_f32_32x32x16_bf16(PAF(3),VFR(3),o[0],0,0,0), C1,8); \
    GAPB(o[1]=__builtin_amdgcn_mfma_f32_32x32x16_bf16(PAF(3),VFR(7),o[1],0,0,0), C1,12); \
    }while(0)
  #define ACT(tt) ((64*((tt)-(NT-4))+63>=32*wid-127)&&(64*((tt)-(NT-4))<=32*wid+31))
  #define STEPW(C0,C1,P0,P1,t,GK,GV,GL) do{ SBAR(); \
    const bool aq_=ACT(t), ap_=ACT((t)-1); \
    const lds_cptr vp_=vp0+sl_prev; \
    if(ap_){ VRD(0);VRD(4);VRD(1);VRD(5);VRD(2);VRD(6);VRD(3);VRD(7); \
      float sacc=(P0[0]+P0[1]); _Pragma("unroll") for(int r=2;r<16;++r)sacc+=P0[r]; _Pragma("unroll") for(int r=0;r<16;++r)sacc+=P1[r]; l_reg+=sacc; \
      pw0=(u32x4){PKW(P0,0),PKW(P0,2),PKW(P0,4),PKW(P0,6)};pw1=(u32x4){PKW(P0,8),PKW(P0,10),PKW(P0,12),PKW(P0,14)};pw2=(u32x4){PKW(P1,0),PKW(P1,2),PKW(P1,4),PKW(P1,6)};pw3=(u32x4){PKW(P1,8),PKW(P1,10),PKW(P1,12),PKW(P1,14)}; } \
    SBAR(); \
    if(aq_){ CINIT(C0,C1,t); \
      C0=__builtin_amdgcn_mfma_f32_32x32x16_bf16(kf[0],qr[0],C0,0,0,0); C1=__builtin_amdgcn_mfma_f32_32x32x16_bf16(kf[1],qr[0],C1,0,0,0); \
      C0=__builtin_amdgcn_mfma_f32_32x32x16_bf16(kf[2],qr[1],C0,0,0,0); C1=__builtin_amdgcn_mfma_f32_32x32x16_bf16(kf[3],qr[1],C1,0,0,0); \
      C0=__builtin_amdgcn_mfma_f32_32x32x16_bf16(kf[4],qr[2],C0,0,0,0); C1=__builtin_amdgcn_mfma_f32_32x32x16_bf16(kf[5],qr[2],C1,0,0,0); \
      C0=__builtin_amdgcn_mfma_f32_32x32x16_bf16(kf[6],qr[3],C0,0,0,0); C1=__builtin_amdgcn_mfma_f32_32x32x16_bf16(kf[7],qr[3],C1,0,0,0); } \
    if(GK){DMA_K((t)+3,sl_cur);} if(GV){DMA_V((t)+1,sl_next);} \
    resc=false; \
    if(aq_){ CMASK(C0,C1,t); \
      float a=MX3(C0[0],C0[1],C1[0]),b=MX3(C0[2],C0[3],C1[1]); a=MX3(a,C1[2],C1[3]); \
      _Pragma("unroll") for(int r=4;r<16;r+=4){a=MX3(a,C0[r],C0[r+1]);b=MX3(b,C0[r+2],C0[r+3]);a=MX3(a,C1[r],C1[r+1]);b=MX3(b,C1[r+2],C1[r+3]);} \
      float rm=__builtin_fmaxf(a,b); { auto rr=__builtin_amdgcn_permlane32_swap(__float_as_uint(rm),__float_as_uint(rm),false,false); rm=__builtin_fmaxf(__uint_as_float(rr[0]),__uint_as_float(rr[1])); } \
      if(__builtin_expect(__any(rm>(float)THRL),0)){ const float dl=__builtin_fmaxf(rm,0.f); mhat+=dl; \
        _Pragma("unroll") for(int r=0;r<16;++r){C0[r]-=dl;C1[r]-=dl;} \
        nm=ct-mhat; \
        const float f=__builtin_amdgcn_exp2f(-dl); l_reg*=f; if(hi==0)wsf[r32]=f; resc=true; } } \
    SBAR(); \
    if(ap_){ \
      o[0]=__builtin_amdgcn_mfma_f32_32x32x16_bf16(PAF(0),VFR(0),o[0],0,0,0); o[1]=__builtin_amdgcn_mfma_f32_32x32x16_bf16(PAF(0),VFR(4),o[1],0,0,0); \
      o[0]=__builtin_amdgcn_mfma_f32_32x32x16_bf16(PAF(1),VFR(1),o[0],0,0,0); o[1]=__builtin_amdgcn_mfma_f32_32x32x16_bf16(PAF(1),VFR(5),o[1],0,0,0); \
      o[0]=__builtin_amdgcn_mfma_f32_32x32x16_bf16(PAF(2),VFR(2),o[0],0,0,0); o[1]=__builtin_amdgcn_mfma_f32_32x32x16_bf16(PAF(2),VFR(6),o[1],0,0,0); \
      o[0]=__builtin_amdgcn_mfma_f32_32x32x16_bf16(PAF(3),VFR(3),o[0],0,0,0); o[1]=__builtin_amdgcn_mfma_f32_32x32x16_bf16(PAF(3),VFR(7),o[1],0,0,0); } \
    if((GL)&&ACT((t)+1)){ kload2(kf,kp0+sl_next,0); kload2(kf,kp0+sl_next,1); kload2(kf,kp0+sl_next,2); kload2(kf,kp0+sl_next,3); } \
    if(aq_){ _Pragma("unroll") for(int r=0;r<16;++r){C0[r]=EX(C0[r]);C1[r]=EX(C1[r]);} } else { C0=f32x16{}; C1=f32x16{}; } \
    SBAR(); \
    }while(0)
  #define STEPX(C0,C1,P0,P1,t,GK,GV,GL) do{ if(MODE==0){ STEPW(C0,C1,P0,P1,t,GK,GV,GL); } else { STEP(C0,C1,P0,P1,t,GK,GV,GL); } }while(0)
  int t=1;
  #undef CMASK
  #define CMASK(P0,P1,t) do{}while(0)
  for(;t+5<NT;t+=2){
    STEP(pB0,pB1,pA0,pA1,t,true,true,true);     WAIT_BAR(2); RESC(); ROT();
    STEP(pA0,pA1,pB0,pB1,t+1,true,true,true);   WAIT_BAR(2); RESC(); ROT();
  }
  #undef CMASK
  #define CMASK(P0,P1,t) do{int ko_=64*((t)-(NT-4)); if(MODE==0||ko_>=0)amask<MODE==0>(P0,P1,ko_,qrel,hi);}while(0)
  #define ENDW(tt) do{ if((tt)+3<NT){WAIT_BAR(2);} else if((tt)+2<NT){WAIT_BAR(1);} else {WAIT_BAR(0);} }while(0)
  for(;t+1<NT;t+=2){
    STEPX(pB0,pB1,pA0,pA1,t,(t+3<NT),(t+1<NT),(t+1<NT));       ENDW(t);   RESC(); ROT();
    STEPX(pA0,pA1,pB0,pB1,t+1,(t+4<NT),(t+2<NT),(t+2<NT));     ENDW(t+1); RESC(); ROT();
  }
  STEPX(pB0,pB1,pA0,pA1,NT-1,false,false,false); RESC();
  if(MODE==1||ACT(NT-1))
  { float sacc=pB0[0]+pB0[1]; _Pragma("unroll") for(int r=2;r<16;++r)sacc+=pB0[r]; _Pragma("unroll") for(int r=0;r<16;++r)sacc+=pB1[r]; l_reg+=sacc;
    pw0=(u32x4){PKW(pB0,0),PKW(pB0,2),PKW(pB0,4),PKW(pB0,6)};pw1=(u32x4){PKW(pB0,8),PKW(pB0,10),PKW(pB0,12),PKW(pB0,14)};pw2=(u32x4){PKW(pB1,0),PKW(pB1,2),PKW(pB1,4),PKW(pB1,6)};pw3=(u32x4){PKW(pB1,8),PKW(pB1,10),PKW(pB1,12),PKW(pB1,14)};
    SBAR(); pv(o,vb0+sl_cur,PAF(0),PAF(1),PAF(2),PAF(3)); }
  #undef PKW
  #undef PAF
  #undef VFR
  #undef PIN
  #undef MX3
  #undef GAPA
  #undef GAPB
  #undef EX
  #undef VRD
  #undef KRD
  #undef STEP
  #undef ENDW
  #undef STEPX
  #undef STEPW
  #undef ACT
  {auto rr=__builtin_amdgcn_permlane32_swap(__float_as_uint(l_reg),__float_as_uint(l_reg),false,false);l_reg=__uint_as_float(rr[0])+__uint_as_float(rr[1]);}
  if(MODE==0)l_reg+=__builtin_amdgcn_exp2f(sink_l2-mhat);
  if(hi==0)wsf[32+r32]=l_reg;asm volatile("s_waitcnt lgkmcnt(0)":::"memory");
  float rli[16];
  #pragma unroll
  for(int r=0;r<16;++r)rli[r]=__builtin_amdgcn_rcpf(wsf[32+crow(r,hi)]);
  bf16*Ow=O+(rowbase+q0+wid*QBLK)*OP+ocol;
  { bf16*stg=(bf16*)(shm+LDS_OST)+wid*2048;
    #pragma unroll
    for(int r=0;r<16;++r){const int orow=crow(r,hi);
      #pragma unroll
      for(int d0=0;d0<2;++d0)stg[orow*64+d0*32+r32]=__float2bfloat16(o[d0][r]*rli[r]);}
    asm volatile("s_waitcnt lgkmcnt(0)":::"memory");
    #pragma unroll
    for(int i=0;i<4;++i){const int row=i*8+(lane>>3),ch=lane&7; const u32x4 v=*(const u32x4*)(stg+row*64+ch*8); ATTN_STORE16(Ow+(long)row*OP+ch*8,v);
      float ss=0.f;
      #pragma unroll
      for(int e=0;e<4;++e){const float lo=__builtin_bit_cast(float,v[e]<<16),hh=__builtin_bit_cast(float,v[e]&0xffff0000u); ss+=lo*lo+hh*hh;}
      ss+=__shfl_xor(ss,1); ss+=__shfl_xor(ss,2); ss+=__shfl_xor(ss,4);
      if(ch==0)__hip_atomic_fetch_add(ssq+(rowbase+q0+wid*QBLK+row)*2+MODE,ss,__ATOMIC_RELAXED,__HIP_MEMORY_SCOPE_AGENT); } }
  asm volatile("s_waitcnt lgkmcnt(0)\n\ts_barrier":::"memory");
  #undef CINIT
  #undef DMA_K
  #undef DMA_V
  #undef CMASK
  #undef START
  #undef RESC
  #undef ROT
}
constexpr int ATTN_LDS_BYTES=LDS_BYTES;
#undef SBAR
#undef WAIT_BAR
}

__device__ __forceinline__ void fox_cumsum(const float* Ft, float bias, int b, int h, char* lds) {
    typedef __attribute__((address_space(3))) float* lds_fptr; typedef __attribute__((address_space(3))) const char* lds_cptr;
    const lds_fptr cl = (lds_fptr)((lds_cptr)lds + attn_body::LDS_CL), wt = (lds_fptr)((lds_cptr)lds + attn_body::LDS_WT);
    int tid = threadIdx.x; asm volatile("" : "+v"(tid));
    const int lane = tid & 63, wave = tid >> 6;
    const f32x4* f = (const f32x4*)(Ft + (size_t)h * M + (size_t)b * SEQ + 8 * tid);
    const f32x4 a = f[0], c = f[1];
    float v[8] = {a[0], a[1], a[2], a[3], c[0], c[1], c[2], c[3]};
#pragma unroll
    for (int k = 0; k < 8; ++k) v[k] = log_sigmoid(v[k] + bias);
#pragma unroll
    for (int k = 1; k < 8; ++k) v[k] += v[k - 1];
    float inc = v[7];
#pragma unroll
    for (int o = 1; o < 64; o <<= 1) { const float t = __shfl_up(inc, o); if (lane >= o) inc += t; }
    if (lane == 63) wt[wave] = inc;
    __syncthreads();
    float base = inc - v[7];
#pragma unroll
    for (int w = 0; w < 8; ++w) if (w < wave) base += wt[w];
    *(__attribute__((address_space(3))) f32x4*)(cl + 8 * tid) = (f32x4){(v[0] + base) * LOG2E, (v[1] + base) * LOG2E, (v[2] + base) * LOG2E, (v[3] + base) * LOG2E};
    *(__attribute__((address_space(3))) f32x4*)(cl + 8 * tid + 4) = (f32x4){(v[4] + base) * LOG2E, (v[5] + base) * LOG2E, (v[6] + base) * LOG2E, (v[7] + base) * LOG2E};
    __syncthreads();
}
__device__ __forceinline__ void attn_phase(const Ptrs& P, char* lds) {
    unsigned char* ws = P.ws;
    const int G = gridDim.x, bx = blockIdx.x, vcu0 = (G % 8 == 0) ? (bx % 8) * (G / 8) + bx / 8 : bx;
    for (int v = vcu0; v < 256; v += G) {
        const int bh = v >> 2, s = v & 3, b = bh >> 4, h = bh & 15;
        fox_cumsum((const float*)(ws + WS_F), P.b_forget[h], b, h, lds);
        for (int i = 0; i < 4; ++i) {
            const int qb = (i == 0) ? s : (i == 1) ? 7 - s : (i == 2) ? 8 + s : 15 - s;
            attn_body::attn_unit<60, 1>(b, h, qb, (const attn_body::bf16*)(ws + WS_QB), (const attn_body::bf16*)(ws + WS_KB), (const attn_body::bf16*)(ws + WS_VB), 1024, h * 64,
                                        (attn_body::bf16*)(ws + WS_O), 1024 + h * 64, (float*)(ws + WS_CS), 0.f, 0.f, lds);
        }
        for (int i = 0; i < 4; ++i) {
            const int qb = (i == 0) ? s : (i == 1) ? 7 - s : (i == 2) ? 8 + s : 15 - s;
            attn_body::attn_unit<8, 0>(b, h, qb, (const attn_body::bf16*)(ws + WS_QA), (const attn_body::bf16*)(ws + WS_KA), (const attn_body::bf16*)(ws + WS_VA), 128, (h >> 3) * 64,
                                       (attn_body::bf16*)(ws + WS_O), h * 64, (float*)(ws + WS_CS), exp2f(-0.5f * (float)(h + 1)) * LOG2E, P.sinks[h] * LOG2E, lds);
        }
    }
}
#define LAS __attribute__((address_space(3)))
#define XB_TMO      128
#define XB_XCNT(j)  (256  + 64 * (j))
#define XB_XSUB(j)  (1280 + 64 * (j))
#define XB_XGEN(j)  (2304 + 64 * (j))
#define XB_TOP      3328
#define XB_TOPGEN   3392
#define XCD_BAR_WORDS 3456
#define XB_SPIN_CAP (1u << 18)

__device__ __forceinline__ unsigned xb_ld(unsigned* p)              { return __hip_atomic_load(p, __ATOMIC_RELAXED, __HIP_MEMORY_SCOPE_AGENT); }
__device__ __forceinline__ unsigned xb_add(unsigned* p, unsigned v) { return __hip_atomic_fetch_add(p, v, __ATOMIC_RELAXED, __HIP_MEMORY_SCOPE_AGENT); }
__device__ __forceinline__ unsigned xb_xcc_id() { return (unsigned)__builtin_amdgcn_s_getreg((3 << 11) | 20) & 0xFu; }
#define XB_SPIN(cond, bar) do { unsigned _sp = 0; while (cond) { __builtin_amdgcn_s_sleep(1); \
    if ((++_sp & 255u) == 0u) { if (xb_ld(&(bar)[XB_TMO])) break; if (_sp > XB_SPIN_CAP) { atomicAdd(&(bar)[XB_TMO], 1u); break; } } } } while (0)

struct XcdBarrier {
    unsigned* bar; unsigned x;
    volatile LAS unsigned* st;
};

__device__ __forceinline__ XcdBarrier xcd_barrier_post(unsigned* bar, volatile LAS unsigned* st) {
    XcdBarrier b; b.bar = bar; b.x = xb_xcc_id(); b.st = st;
    if (threadIdx.x == 0) (void)xb_add(&bar[XB_XCNT(b.x)], 1u);
    return b;
}
__device__ __forceinline__ void xcd_barrier_complete(unsigned* bar, unsigned x, unsigned& nloc, unsigned& nx) {
    const unsigned G = gridDim.x * gridDim.y * gridDim.z;
    unsigned sum, cnt, mine, sp = 0u;
    for (;;) {
        sum = 0u; cnt = 0u; mine = 0u;
#pragma unroll
        for (unsigned j = 0; j < 16; ++j) { const unsigned c = xb_ld(&bar[XB_XCNT(j)]); sum += c; cnt += (c > 0u) ? 1u : 0u; mine = (j == x) ? c : mine; }
        if (sum == G) break;
        __builtin_amdgcn_s_sleep(1);
        if ((++sp & 255u) == 0u) { if (xb_ld(&bar[XB_TMO])) break; if (sp > XB_SPIN_CAP) { atomicAdd(&bar[XB_TMO], 1u); break; } }
    }
    nloc = mine > 0u ? mine : 1u; nx = cnt > 0u ? cnt : 1u;
}

__device__ __forceinline__ void xcd_barrier(const XcdBarrier& b) {
    asm volatile("s_waitcnt vmcnt(0)" ::: "memory");
    __syncthreads();
    if (threadIdx.x == 0) {
        unsigned* bar = b.bar;
        __builtin_amdgcn_s_waitcnt(0);
        unsigned nloc = b.st[0], nx = b.st[1];
        if (nloc == 0u) { xcd_barrier_complete(bar, b.x, nloc, nx); b.st[0] = nloc; b.st[1] = nx; }
        const unsigned old = xb_add(&bar[XB_XSUB(b.x)], 1u);
        const unsigned gen = old / nloc;
        if (old + 1u == (gen + 1u) * nloc) {
            __builtin_amdgcn_fence(__ATOMIC_RELEASE, "agent");
            asm volatile("s_waitcnt vmcnt(0)" ::: "memory");
            const unsigned og = xb_add(&bar[XB_TOP], 1u);
            const unsigned tg = og / nx;
            if (og + 1u == (tg + 1u) * nx) xb_add(&bar[XB_TOPGEN], 1u);
            else XB_SPIN(xb_ld(&bar[XB_TOPGEN]) == tg, bar);
            __builtin_amdgcn_fence(__ATOMIC_ACQUIRE, "agent");
            xb_add(&bar[XB_XGEN(b.x)], 1u);
            asm volatile("s_waitcnt vmcnt(0)" ::: "memory");
        } else {
            XB_SPIN(xb_ld(&bar[XB_XGEN(b.x)]) == gen, bar);
            __builtin_amdgcn_fence(__ATOMIC_ACQUIRE, "agent");
            asm volatile("s_waitcnt vmcnt(0)" ::: "memory");
        }
    }
    __syncthreads();
}

constexpr int LDS_BYTES = 147456;
__global__ void __launch_bounds__(512, 2) mega_fwd(Ptrs P) {
    extern __shared__ __attribute__((aligned(16))) unsigned char lds[];
    cg::grid_group grid = cg::this_grid();
    if (P.use_cg) grid.sync();
    unsigned char* ws = P.ws;
    PG8_LAS unsigned char* ldsp = (PG8_LAS unsigned char*)lds;
    const int NGW = gridDim.x * 8;
    volatile LAS unsigned* bst = (volatile LAS unsigned*)(ldsp + 143360);
    if (threadIdx.x == 0) { bst[0] = 0u; bst[1] = 0u; }
    __syncthreads();
    const XcdBarrier bar = xcd_barrier_post((unsigned*)(ws + WS_CTL), bst);
#define GRID_SYNC() xcd_barrier(bar)
#define FRESH_IDS() int tid_; asm volatile("v_mov_b32 %0, %1" : "=v"(tid_) : "v"(threadIdx.x)); const int lane = tid_ & 63, gw = blockIdx.x * 8 + (tid_ >> 6)
    ph_prologue(P, (float*)lds);
    { FRESH_IDS(); pass_prenorm(P.x, P.pre_mix_g, (bf16_t*)(ws + WS_XN), (float*)(ws + WS_CS + 512 * 1024), gw, NGW, lane); }
    GRID_SYNC();
    { pg8::Gemm g{(const bf16_t*)(ws + WS_XN), (const bf16_t*)(ws + WS_WIN), M, DINP, DM}; pg8::StaticOrder S; S.init(M, DINP, (int)gridDim.x, (int)blockIdx.x);
      pg8::gemm_phase<pg8::EpiInProjT, pg8::StaticOrder, true, true>(ldsp, g, S, pg8::EpiInProjT{ws}); }
    if (gridDim.x == 256 && blockIdx.x >= 128) convert_items(P, (float*)lds, I_CUT, I_ALL, (blockIdx.x - 128) * 8 + (threadIdx.x >> 6), 128 * 8);
    GRID_SYNC();
    attn_phase(P, (char*)lds);
    GRID_SYNC();
    { pg8::Gemm g{(const bf16_t*)(ws + WS_O), (const bf16_t*)(ws + WS_WOUT), M, DM, DM}; pg8::StaticOrder S; S.init(M, DM, (int)gridDim.x, (int)blockIdx.x);
      PG8_LAS float* T = (PG8_LAS float*)(ldsp + 139264);
      { pg8::Unit u; const float* SS = (const float*)(ws + WS_CS);
        for (int i = 0; i < 2; ++i) if (S.next(i, u) && threadIdx.x < 256) { const int row = u.pm * 256 + (int)threadIdx.x;
            const float ra = 1.0f / sqrtf(SS[row * 2] * (1.0f / 1024.f) + EPS), rb = 1.0f / sqrtf(SS[row * 2 + 1] * (1.0f / 1024.f) + EPS);
            T[(i * 256 + (int)threadIdx.x) * 2] = ra / rb; T[(i * 256 + (int)threadIdx.x) * 2 + 1] = rb; } }
      __syncthreads();
      pg8::gemm_phase<pg8::EpiOutT, pg8::StaticOrder, true, true>(ldsp, g, S, pg8::EpiOutT{(bf16_t*)(ws + WS_MIX), DM, T}); }
    GRID_SYNC();
    { FRESH_IDS(); pass_postmix((bf16_t*)(ws + WS_XN), (const float*)(ws + WS_CS + 512 * 1024), P.pre_mix_g, (const bf16_t*)(ws + WS_MIX), P.post_mix_g, P.pre_ffn_g, (float*)(ws + WS_CS + 256 * 1024), gw, NGW, lane); }
    GRID_SYNC();
    { pg8::Gemm g{(const bf16_t*)(ws + WS_XN), (const bf16_t*)(ws + WS_WUP), M, NUP, DM}; pg8::StaticOrder S; S.init(M, NUP, (int)gridDim.x, (int)blockIdx.x);
      pg8::gemm_phase<pg8::EpiUpT, pg8::StaticOrder, true, true>(ldsp, g, S, pg8::EpiUpT{(bf16_t*)(ws + WS_ACT), P.conv_w, P.conv_b, (float*)(ws + WS_SIDE), (PG8_LAS float*)(ldsp + 131072)}); }
    GRID_SYNC();
    ph_convfix((const float*)(ws + WS_SIDE), P.conv_w, P.conv_b, (bf16_t*)(ws + WS_ACT));
    GRID_SYNC();
    { pg8::Gemm g{(const bf16_t*)(ws + WS_ACT), (const bf16_t*)(ws + WS_WDN), M, DM, DFF}; pg8::StaticOrder S; S.init(M, DM, (int)gridDim.x, (int)blockIdx.x);
      pg8::gemm_phase<pg8::EpiBf16T, pg8::StaticOrder, true, true>(ldsp, g, S, pg8::EpiBf16T{(bf16_t*)(ws + WS_Y), DM}); }
    GRID_SYNC();
    { FRESH_IDS(); pass_final((const bf16_t*)(ws + WS_XN), (const float*)(ws + WS_CS + 256 * 1024), P.pre_ffn_g, (const bf16_t*)(ws + WS_Y), P.post_ffn_g, P.out, gw, NGW, lane); }
}

extern "C" void kernel_launch(void* const* d_in, const int* in_sizes, int n_in, void* d_out, int out_size, void* d_ws, size_t ws_size, hipStream_t stream) {
    if (n_in != 15 || ws_size < WS_END || out_size != M * DM) { fprintf(stderr, "kernel_launch: unexpected sizes n_in %d ws %zu out %d\n", n_in, ws_size, out_size); return; }
    static int grid_blocks = 0;
    if (!grid_blocks) {
        int dev = 0, cus = 0, per_cu = 0;
        hipGetDevice(&dev);
        hipDeviceGetAttribute(&cus, hipDeviceAttributeMultiprocessorCount, dev);
        if (hipFuncSetAttribute((const void*)mega_fwd, hipFuncAttributeMaxDynamicSharedMemorySize, LDS_BYTES) != hipSuccess) fprintf(stderr, "kernel_launch: hipFuncSetAttribute failed\n");
        hipOccupancyMaxActiveBlocksPerMultiprocessor(&per_cu, (const void*)mega_fwd, 512, LDS_BYTES);
        if (per_cu < 1) { fprintf(stderr, "kernel_launch: occupancy query gave %d\n", per_cu); per_cu = 1; }
        grid_blocks = cus * per_cu;
        if (grid_blocks != 256) fprintf(stderr, "kernel_launch: expected 256 resident workgroups, got %d (the output projection assumes two units per workgroup)\n", grid_blocks);
        (void)hipGetLastError();
    }
    Ptrs P{};
    const float** pp = (const float**)&P;
    for (int i = 0; i < 15; ++i) pp[i] = (const float*)d_in[i];
    P.out = (float*)d_out; P.ws = (unsigned char*)d_ws;
    P.use_cg = 0; P.pad = 0;
    if (hipMemsetAsync((char*)d_ws + WS_CTL, 0, CTL_BYTES, stream) != hipSuccess) { fprintf(stderr, "kernel_launch: hipMemsetAsync failed\n"); return; }
    void* args[] = {&P};
    hipError_t e = hipLaunchCooperativeKernel((const void*)mega_fwd, dim3(grid_blocks), dim3(512), args, LDS_BYTES, stream);
    if (e != hipSuccess) fprintf(stderr, "cooperative launch failed: %s (grid %d)\n", hipGetErrorString(e), grid_blocks);
}
```

```cpp
#include <hip/hip_runtime.h>
#include <hip/hip_cooperative_groups.h>
namespace cg = cooperative_groups;
#include <cstdio>
#include <cstdint>

constexpr int NB = 4, SEQ = 4096, DM = 2048, M = NB * SEQ;
constexpr int HD = 64, NHA = 16, NKVA = 2, NHB = 16, WIN = 128, DFF = 5632, NUP = 2 * DFF;
constexpr int DIN = 4368, DINP = 4608;
constexpr float EPS = 1e-6f;
constexpr float LOG2E = 1.4426950408889634f;
constexpr float C2 = 0.125f * LOG2E;

constexpr size_t MiB = 1u << 20;
constexpr size_t WS_WIN = 0, WS_WOUT = 18 * MiB, WS_WUP = 26 * MiB, WS_WDN = 70 * MiB;
constexpr size_t WS_XN = 92 * MiB;
constexpr size_t WS_CS = 156 * MiB, WS_F = 157 * MiB, WS_SIDE = 158 * MiB;
constexpr size_t WS_QA = 170 * MiB, WS_KA = 202 * MiB, WS_VA = 206 * MiB, WS_QB = 210 * MiB, WS_KB = 242 * MiB, WS_VB = 274 * MiB, WS_O = 306 * MiB;
constexpr size_t WS_ACT = 170 * MiB;
constexpr size_t WS_MIX = 370 * MiB, WS_Y = 434 * MiB;
constexpr size_t WS_CTL = 169 * MiB + 768 * 1024, CTL_BYTES = 64 * 1024;
constexpr size_t WS_END = 498 * MiB;

typedef unsigned short bf16_t;
typedef unsigned v4u __attribute__((ext_vector_type(4)));
typedef float f32x4 __attribute__((ext_vector_type(4)));

__device__ __forceinline__ unsigned f2bf(float f) { unsigned u = __builtin_bit_cast(unsigned, f); return (u + 0x7fffu + ((u >> 16) & 1u)) >> 16; }
__device__ __forceinline__ unsigned pk2(float lo, float hi) { return f2bf(lo) | (f2bf(hi) << 16); }
__device__ __forceinline__ float bf2f(unsigned h) { return __builtin_bit_cast(float, h << 16); }
__device__ __forceinline__ float wave_sum(float v) {
#pragma unroll
    for (int o = 1; o < 64; o <<= 1) v += __shfl_xor(v, o);
    return v;
}
__device__ __forceinline__ float wave_max(float v) {
#pragma unroll
    for (int o = 1; o < 64; o <<= 1) v = fmaxf(v, __shfl_xor(v, o));
    return v;
}

__device__ __forceinline__ int rowmap(int n, int map) {
    if (map == 0) return n;
    if (n < DFF) return ((n >> 7) << 8) + (n & 127);
    const int g = n - DFF; return ((g >> 7) << 8) + 128 + (g & 127);
}
__device__ __forceinline__ void transpose_item(const float* W, int K, int N, int Npad, bf16_t* WT, int map, float* scr, int item, int lane, const float* ks0 = nullptr, const float* ks1 = nullptr) {
    const int nblk = Npad / 32, kb = item / nblk, nb = item % nblk, k0 = 128 * kb, n0 = 32 * nb;
    { const int n4 = lane & 7, n = n0 + 4 * n4;
      f32x4 w[16];
#pragma unroll
      for (int i = 0; i < 16; ++i) { const int kk = (lane >> 3) + 8 * i; w[i] = (n < N) ? *(const f32x4*)(W + (size_t)(k0 + kk) * N + n) : (f32x4){0.f, 0.f, 0.f, 0.f}; }
#pragma unroll
      for (int i = 0; i < 16; ++i) { const int kk = (lane >> 3) + 8 * i;
          if (ks0) w[i] = w[i] * ((k0 < 1024) ? ks0[k0 + kk] : ks1[k0 + kk - 1024]);
#pragma unroll
          for (int j = 0; j < 4; ++j) scr[kk * 33 + 4 * n4 + j] = w[i][j]; } }
    __builtin_amdgcn_s_waitcnt(0); asm volatile("" ::: "memory");
    const int c = lane & 15;
#pragma unroll
    for (int j = 0; j < 8; ++j) { const int n = (lane >> 4) + 4 * j; const float* s = scr + (8 * c) * 33 + n;
        v4u o; o.x = pk2(s[0 * 33], s[1 * 33]); o.y = pk2(s[2 * 33], s[3 * 33]); o.z = pk2(s[4 * 33], s[5 * 33]); o.w = pk2(s[6 * 33], s[7 * 33]);
        *(v4u*)(WT + (size_t)rowmap(n0 + n, map) * K + k0 + 8 * c) = o; }
    __builtin_amdgcn_s_waitcnt(0); asm volatile("" ::: "memory");
}
struct Ptrs {
    const float *x, *pre_mix_g, *w_in, *b_forget, *sinks, *grp_swa_g, *grp_fox_g, *w_out, *post_mix_g, *pre_ffn_g, *w_up, *conv_w, *conv_b, *w_down, *post_ffn_g;
    float* out; unsigned char* ws;
    int use_cg, pad;
};
constexpr int I_IN = (DM / 128) * (DINP / 32), I_OUT = (DM / 128) * (DM / 32), I_UP = (DM / 128) * (NUP / 32), I_DN = (DFF / 128) * (DM / 32);
constexpr int I_CUT = I_IN + I_OUT, I_ALL = I_IN + I_OUT + I_UP + I_DN;
__device__ __forceinline__ void convert_items(const Ptrs& P, float* scr_all, int lo, int hi, int gw, int NGW) {
    const int tid = threadIdx.x, lane = tid & 63, wave = tid >> 6;
    float* scr = scr_all + wave * 128 * 33;
    for (int it = lo + gw; it < hi; it += NGW) {
        int r = it;
        if (r < I_IN) { transpose_item(P.w_in, DM, DIN, DINP, (bf16_t*)(P.ws + WS_WIN), 0, scr, r, lane); continue; } r -= I_IN;
        if (r < I_OUT) { transpose_item(P.w_out, DM, DM, DM, (bf16_t*)(P.ws + WS_WOUT), 0, scr, r, lane, P.grp_swa_g, P.grp_fox_g); continue; } r -= I_OUT;
        if (r < I_UP) { transpose_item(P.w_up, DM, NUP, NUP, (bf16_t*)(P.ws + WS_WUP), 1, scr, r, lane); continue; } r -= I_UP;
        transpose_item(P.w_down, DFF, DM, DM, (bf16_t*)(P.ws + WS_WDN), 0, scr, r, lane);
    }
}
__device__ __forceinline__ void ph_prologue(const Ptrs& P, float* scr_all) {
    const int tid = threadIdx.x;
    const bool defer = (gridDim.x == 256);
    convert_items(P, scr_all, 0, defer ? I_CUT : I_ALL, blockIdx.x * 8 + (tid >> 6), gridDim.x * 8);
    for (int i = blockIdx.x * 512 + tid; i < M * 2; i += gridDim.x * 512) ((float*)(P.ws + WS_CS))[i] = 0.f;
}

__device__ __forceinline__ void row_load(const float* row, int lane, f32x4 (&v)[8]) {
#pragma unroll
    for (int j = 0; j < 8; ++j) v[j] = ((const f32x4*)row)[lane + 64 * j];
}
__device__ __forceinline__ void row_load_bf16(const bf16_t* row, int lane, f32x4 (&v)[8]) {
#pragma unroll
    for (int j = 0; j < 8; ++j) { const unsigned long long w = ((const unsigned long long*)row)[lane + 64 * j];
        v[j] = (f32x4){bf2f((unsigned)w & 0xffffu), bf2f(((unsigned)w >> 16)), bf2f((unsigned)(w >> 32) & 0xffffu), bf2f((unsigned)(w >> 48))}; }
}
__device__ __forceinline__ float row_sumsq(const f32x4 (&v)[8]) {
    float s = 0.f;
#pragma unroll
    for (int j = 0; j < 8; ++j) s += (v[j].x * v[j].x + v[j].y * v[j].y) + (v[j].z * v[j].z + v[j].w * v[j].w);
    return wave_sum(s);
}
__device__ __forceinline__ void row_store_bf16(bf16_t* orow, int lane, const f32x4 (&v)[8]) {
#pragma unroll
    for (int j = 0; j < 8; ++j) ((unsigned long long*)orow)[lane + 64 * j] = (unsigned long long)pk2(v[j].x, v[j].y) | ((unsigned long long)pk2(v[j].z, v[j].w) << 32);
}
__device__ __forceinline__ void pass_prenorm(const float* x, const float* g, bf16_t* xn, float* r0s, int gw, int NGW, int lane) {
    f32x4 gv[8]; row_load(g, lane, gv);
    for (int m = gw; m < M; m += NGW) {
        f32x4 v[8]; row_load(x + (size_t)m * DM, lane, v);
        const float r = 1.0f / sqrtf(row_sumsq(v) * (1.0f / DM) + EPS);
#pragma unroll
        for (int j = 0; j < 8; ++j) v[j] = v[j] * r * gv[j];
        row_store_bf16(xn + (size_t)m * DM, lane, v);
        if (lane == 0) r0s[m] = r;
    }
}
__device__ __forceinline__ void pass_postmix(bf16_t* xn, const float* r0s, const float* gpm, const bf16_t* mix, const float* gpost, const float* gpre, float* r2s, int gw, int NGW, int lane) {
    f32x4 ig[8]; row_load(gpm, lane, ig);
#pragma unroll
    for (int j = 0; j < 8; ++j) { ig[j][0] = __builtin_amdgcn_rcpf(ig[j][0]); ig[j][1] = __builtin_amdgcn_rcpf(ig[j][1]); ig[j][2] = __builtin_amdgcn_rcpf(ig[j][2]); ig[j][3] = __builtin_amdgcn_rcpf(ig[j][3]); }
    for (int m = gw; m < M; m += NGW) {
        f32x4 v[8], xv[8], gv[8]; row_load_bf16(mix + (size_t)m * DM, lane, v); row_load_bf16(xn + (size_t)m * DM, lane, xv); row_load(gpost, lane, gv);
        const float ir0 = __builtin_amdgcn_rcpf(r0s[m]);
        const float r = 1.0f / sqrtf(row_sumsq(v) * (1.0f / DM) + EPS);
#pragma unroll
        for (int j = 0; j < 8; ++j) v[j] = xv[j] * ig[j] * ir0 + v[j] * r * gv[j];
        const float r2 = 1.0f / sqrtf(row_sumsq(v) * (1.0f / DM) + EPS);
        row_load(gpre, lane, gv);
#pragma unroll
        for (int j = 0; j < 8; ++j) v[j] = v[j] * r2 * gv[j];
        row_store_bf16(xn + (size_t)m * DM, lane, v);
        if (lane == 0) r2s[m] = r2;
    }
}
__device__ __forceinline__ void pass_final(const bf16_t* xn, const float* r2s, const float* gpre, const bf16_t* y, const float* g, float* out, int gw, int NGW, int lane) {
    f32x4 ig[8]; row_load(gpre, lane, ig);
#pragma unroll
    for (int j = 0; j < 8; ++j) { ig[j][0] = __builtin_amdgcn_rcpf(ig[j][0]); ig[j][1] = __builtin_amdgcn_rcpf(ig[j][1]); ig[j][2] = __builtin_amdgcn_rcpf(ig[j][2]); ig[j][3] = __builtin_amdgcn_rcpf(ig[j][3]); }
    f32x4 gv[8]; row_load(g, lane, gv);
    for (int m = gw; m < M; m += NGW) {
        f32x4 v[8], xv[8]; row_load_bf16(xn + (size_t)m * DM, lane, xv); row_load_bf16(y + (size_t)m * DM, lane, v);
        const float ir2 = __builtin_amdgcn_rcpf(r2s[m]);
        const float r = 1.0f / sqrtf(row_sumsq(v) * (1.0f / DM) + EPS);
#pragma unroll
        for (int j = 0; j < 8; ++j) ((f32x4*)(out + (size_t)m * DM))[lane + 64 * j] = xv[j] * ig[j] * ir2 + v[j] * r * gv[j];
    }
}
__device__ __forceinline__ float log_sigmoid(float z) { return z >= 0.f ? -log1pf(expf(-z)) : z - log1pf(expf(z)); }
__device__ __forceinline__ float gelu_tanh(float x) {
    const float z = 0.7978845608028654f * (x + 0.044715f * x * x * x);
    return x / (1.0f + exp2f(-2.0f * LOG2E * z));
}
namespace pg8 {
#define PG8_LAS __attribute__((address_space(3)))
typedef unsigned short bf16_t;
typedef short bf16x8 __attribute__((ext_vector_type(8)));
typedef float f32x4 __attribute__((ext_vector_type(4)));
typedef unsigned u32x4 __attribute__((ext_vector_type(4)));
constexpr int BM = 256, BK = 64, HALF = 128, HTB = HALF * BK * 2  , STAGE_BYTES = 8 * HTB, NXCD = 8, WGM = 8;

__host__ __device__ __forceinline__ int lds_byte(int r, int c) { const int st = (r >> 4) * 2 + (c >> 5), rr = r & 15, cc = c & 31, ob = rr * 64 + cc * 2; return st * 1024 + (ob ^ (((ob >> 9) & 1) << 5)); }
__host__ __device__ __forceinline__ void stage_rc(int b, int& R, int& C) { const int st = b / 1024, sb = b % 1024, swz = sb ^ (((sb >> 9) & 1) << 5); R = (st >> 1) * 16 + swz / 64; C = (st & 1) * 32 + (swz % 64) / 2; }
__host__ __device__ __forceinline__ int perm32(int rho) { const int n = rho >> 4, i = rho & 15; return 8 * (i >> 2) + 4 * n + (i & 3); }

struct Unit { int pm, pn; };
struct Gemm { const bf16_t* A; const bf16_t* Bt; int M, N, K; };

struct StaticOrder {
    int nM, nN, nwg, G, c;
    __host__ __device__ void init(int M, int N, int G_, int c_) { nM = M / BM; nN = N / BM; nwg = nM * nN; G = G_; c = c_; }
    __host__ __device__ bool next(int i, Unit& u) const {
        const long L = (long)i * G + c; if (L >= nwg) return false;
        int wgid = (int)L; { const int q = nwg / NXCD, r = nwg % NXCD, xcd = wgid % NXCD, off = wgid / NXCD; wgid = (xcd < r ? xcd * (q + 1) : r * (q + 1) + (xcd - r) * q) + off; }
        const int nig = WGM * nN, gid = wgid / nig, fm = gid * WGM, gsz = (nM - fm) < WGM ? (nM - fm) : WGM;
        u.pm = fm + ((wgid % nig) % gsz); u.pn = (wgid % nig) / gsz; return true;
    }
    __device__ __forceinline__ void a_ready(const Unit&) const {}
    __device__ __forceinline__ void done(const Unit&) const {}
};

__device__ __forceinline__ unsigned cvt_pk_bf16(float lo, float hi) { unsigned r; asm volatile("v_cvt_pk_bf16_f32 %0, %1, %2" : "=v"(r) : "v"(lo), "v"(hi)); return r; }
typedef float f32x2 __attribute__((ext_vector_type(2)));
template <class Epi, class Sched, bool ALIGN_EPI = false, bool SP2 = false>
__device__ __forceinline__ void gemm_phase(PG8_LAS unsigned char* lds, const Gemm g, const Sched& S, const Epi& E) {
    int tid = threadIdx.x; asm volatile("" : "+v"(tid));
    const int wid = __builtin_amdgcn_readfirstlane(tid >> 6), lane = tid & 63, wr = wid >> 2, wc = wid & 3, fr = lane & 15, fq = lane >> 4;
    const int K = g.K, nt = K / BK;
    unsigned voffA[2], voffB[2];
#pragma unroll
    for (int i = 0; i < 2; ++i) { int R, C; stage_rc(tid * 16 + i * 8192, R, C); const int Rb = Epi::PERM ? ((R & ~31) + perm32(R & 31)) : R;
        voffA[i] = (unsigned)(R * K + C) * 2u; voffB[i] = (unsigned)(Rb * K + C) * 2u; }
    const size_t kstep = (size_t)(BK * 2);
    const size_t hstep = (size_t)HALF * K * 2;
    const size_t tstep = 2 * hstep;
    const unsigned ldsw = (unsigned)wid * 1024u;
    const int aoff = lds_byte(wr * 64 + fr, fq * 8), boff = lds_byte(wc * 32 + fr, fq * 8);
#define PG8_SA(b, h) (((b) * 2 + (h)) * HTB)
#define PG8_SB(b, h) ((4 + (b) * 2 + (h)) * HTB)
    const unsigned ldsb = (unsigned)(uintptr_t)lds + ldsw;
#define PG8_STAGE(bufoff, gbase, voff) do { _Pragma("unroll") for (int _i = 0; _i < 2; ++_i) { unsigned keep_; \
        asm volatile("s_mov_b32 %0, m0\n\ts_mov_b32 m0, %3\n\ts_nop 0\n\tglobal_load_lds_dwordx4 %1, %2\n\ts_mov_b32 m0, %0" : "=&s"(keep_) \
                     : "v"((voff)[_i]), "s"((const char*)(gbase)), "s"((unsigned)__builtin_amdgcn_readfirstlane(ldsb + (unsigned)((bufoff) + _i * 8192))) : "memory"); } } while (0)
#define PG8_LDA(dst, b, h) do { _Pragma("unroll") for (int m = 0; m < 4; ++m) _Pragma("unroll") for (int k = 0; k < 2; ++k) dst[m][k] = *(const PG8_LAS bf16x8*)(lds + PG8_SA(b, h) + aoff + m * 2048 + k * 1024); } while (0)
#define PG8_LDB(dst, b, h) do { _Pragma("unroll") for (int n = 0; n < 2; ++n) _Pragma("unroll") for (int k = 0; k < 2; ++k) dst[n][k] = *(const PG8_LAS bf16x8*)(lds + PG8_SB(b, h) + boff + n * 2048 + k * 1024); } while (0)
#define PG8_MMA(ai, bj, At, Bt) do { __builtin_amdgcn_s_setprio(1); _Pragma("unroll") for (int m = 0; m < 4; ++m) _Pragma("unroll") for (int n = 0; n < 2; ++n) _Pragma("unroll") for (int k = 0; k < 2; ++k) \
        acc[ai][bj][m][n] = __builtin_amdgcn_mfma_f32_16x16x32_bf16(Bt[n][k], At[m][k], acc[ai][bj][m][n], 0, 0, 0); __builtin_amdgcn_s_setprio(0); } while (0)
#define PG8_WAIT_V(n) asm volatile("s_waitcnt vmcnt(" #n ")" ::: "memory")
#define PG8_WAIT_L(n) asm volatile("s_waitcnt lgkmcnt(" #n ")" ::: "memory")
#define PG8_BAR __builtin_amdgcn_s_barrier()
#define PG8_SCHED __builtin_amdgcn_sched_barrier(0)
    Unit cur, nxt; int ui = 0;
    if (!S.next(0, cur)) return;
    f32x4 acc[2][2][4][2];
#pragma unroll
    for (int a = 0; a < 2; ++a)
#pragma unroll
        for (int b = 0; b < 2; ++b)
#pragma unroll
            for (int m = 0; m < 4; ++m)
#pragma unroll
                for (int n = 0; n < 2; ++n) acc[a][b][m][n] = (f32x4){0.f, 0.f, 0.f, 0.f};
    bf16x8 At[4][2], B0[2][2], B1[2][2];
    const char* cA = (const char*)g.A + (size_t)cur.pm * tstep; const char* cB = (const char*)g.Bt + (size_t)cur.pn * tstep;
    S.a_ready(cur);
    if constexpr (SP2) {
        PG8_STAGE(PG8_SB(0, 0), cB, voffB); PG8_STAGE(PG8_SB(0, 1), cB + hstep, voffB); PG8_STAGE(PG8_SA(0, 0), cA, voffA); PG8_STAGE(PG8_SA(0, 1), cA + hstep, voffA);
        if (wr == 1) PG8_BAR;
        PG8_WAIT_V(2); PG8_BAR;
        PG8_STAGE(PG8_SB(1, 0), cB + kstep, voffB); PG8_STAGE(PG8_SA(1, 0), cA + kstep, voffA); PG8_STAGE(PG8_SB(1, 1), cB + hstep + kstep, voffB);
        PG8_WAIT_V(6); PG8_BAR;
    } else {
        PG8_STAGE(PG8_SB(0, 0), cB, voffB); PG8_STAGE(PG8_SA(0, 0), cA, voffA); PG8_STAGE(PG8_SB(0, 1), cB + hstep, voffB); PG8_STAGE(PG8_SA(0, 1), cA + hstep, voffA);
        if (wr == 1) PG8_BAR;
        PG8_WAIT_V(4); PG8_BAR;
        PG8_STAGE(PG8_SB(1, 0), cB + kstep, voffB); PG8_STAGE(PG8_SA(1, 0), cA + kstep, voffA); PG8_STAGE(PG8_SB(1, 1), cB + hstep + kstep, voffB);
        PG8_WAIT_V(6); PG8_BAR;
    }
    for (;;) {
        const bool has_next = S.next(ui + 1, nxt);
        const char* nA = has_next ? (const char*)g.A + (size_t)nxt.pm * tstep : cA; const char* nB = has_next ? (const char*)g.Bt + (size_t)nxt.pn * tstep : cB;
        for (int t = 0; t < nt; t += 2) {
            if constexpr (Epi::MIDK) { if (t == nt / 2) E.midk(acc, ui, wr, fr); }
            const bool last = (t == nt - 2);
            const char* a1 = cA + (size_t)(t + 1) * kstep;
            const char* a2 = last ? nA : cA + (size_t)(t + 2) * kstep; const char* b2 = last ? nB : cB + (size_t)(t + 2) * kstep;
            const char* a3 = a2 + kstep; const char* b3 = b2 + kstep;
            if (last && has_next) S.a_ready(nxt);
            if constexpr (SP2) {
            PG8_LDB(B0, 0, 0); PG8_LDB(B1, 0, 1); PG8_SCHED; PG8_LDA(At, 0, 0); PG8_STAGE(PG8_SA(1, 1), a1 + hstep, voffA);
            PG8_WAIT_V(8); PG8_WAIT_L(0); PG8_BAR; PG8_MMA(0, 0, At, B0); PG8_MMA(0, 1, At, B1); PG8_BAR; PG8_SCHED;
            PG8_LDA(At, 0, 1); PG8_STAGE(PG8_SB(0, 0), b2, voffB); PG8_STAGE(PG8_SB(0, 1), b2 + hstep, voffB); PG8_STAGE(PG8_SA(0, 0), a2, voffA);
            PG8_WAIT_V(8); PG8_WAIT_L(0); PG8_BAR; PG8_MMA(1, 0, At, B0); PG8_MMA(1, 1, At, B1); PG8_BAR; PG8_SCHED;
            PG8_LDB(B0, 1, 0); PG8_LDB(B1, 1, 1); PG8_SCHED; PG8_LDA(At, 1, 0); PG8_STAGE(PG8_SA(0, 1), a2 + hstep, voffA);
            PG8_WAIT_V(8); PG8_WAIT_L(0); PG8_BAR; PG8_MMA(0, 0, At, B0); PG8_MMA(0, 1, At, B1); PG8_BAR; PG8_SCHED;
            PG8_LDA(At, 1, 1); PG8_STAGE(PG8_SB(1, 0), b3, voffB); PG8_STAGE(PG8_SB(1, 1), b3 + hstep, voffB); PG8_STAGE(PG8_SA(1, 0), a3, voffA);
            PG8_WAIT_V(8); PG8_WAIT_L(0); PG8_BAR; PG8_MMA(1, 0, At, B0); PG8_MMA(1, 1, At, B1); PG8_BAR; PG8_SCHED;
            } else {
            PG8_LDB(B0, 0, 0); PG8_SCHED; PG8_LDA(At, 0, 0); PG8_STAGE(PG8_SA(1, 1), a1 + hstep, voffA);
            PG8_WAIT_L(8); PG8_BAR; PG8_WAIT_L(0); PG8_MMA(0, 0, At, B0); PG8_BAR; PG8_SCHED;
            PG8_LDB(B1, 0, 1); PG8_STAGE(PG8_SB(0, 0), b2, voffB);
            PG8_BAR; PG8_WAIT_L(0); PG8_MMA(0, 1, At, B1); PG8_BAR;
            PG8_LDA(At, 0, 1); PG8_STAGE(PG8_SA(0, 0), a2, voffA);
            PG8_BAR; PG8_WAIT_L(0); PG8_MMA(1, 0, At, B0); PG8_BAR; PG8_SCHED;
            PG8_STAGE(PG8_SB(0, 1), b2 + hstep, voffB);
            PG8_WAIT_V(6); PG8_BAR; PG8_MMA(1, 1, At, B1); PG8_BAR;
            PG8_LDB(B0, 1, 0); PG8_SCHED; PG8_LDA(At, 1, 0); PG8_STAGE(PG8_SA(0, 1), a2 + hstep, voffA);
            PG8_WAIT_L(8); PG8_BAR; PG8_WAIT_L(0); PG8_MMA(0, 0, At, B0); PG8_BAR; PG8_SCHED;
            PG8_LDB(B1, 1, 1); PG8_STAGE(PG8_SB(1, 0), b3, voffB);
            PG8_BAR; PG8_WAIT_L(0); PG8_MMA(0, 1, At, B1); PG8_BAR;
            PG8_LDA(At, 1, 1); PG8_STAGE(PG8_SA(1, 0), a3, voffA);
            PG8_BAR; PG8_WAIT_L(0); PG8_MMA(1, 0, At, B0); PG8_BAR; PG8_SCHED;
            PG8_STAGE(PG8_SB(1, 1), b3 + hstep, voffB);
            PG8_WAIT_V(6); PG8_BAR; PG8_MMA(1, 1, At, B1); PG8_BAR;
            }
        }
        if constexpr (ALIGN_EPI) { if (wr == 0) PG8_BAR; }
        if constexpr (Epi::MIDK) { E.epi(acc, cur, ui, wr, wc, fr, fq); S.done(cur); }
        else if constexpr (!Epi::AFTER_DRAIN) { E(acc, cur, wr, wc, fr, fq); S.done(cur); }
        if (!has_next) break;
#pragma unroll
        for (int a = 0; a < 2; ++a)
#pragma unroll
            for (int b = 0; b < 2; ++b)
#pragma unroll
                for (int m = 0; m < 4; ++m)
#pragma unroll
                    for (int n = 0; n < 2; ++n) acc[a][b][m][n] = (f32x4){0.f, 0.f, 0.f, 0.f};
        cur = nxt; cA = nA; cB = nB; ++ui;
        if constexpr (ALIGN_EPI) { if (wr == 1) PG8_BAR; }
    }
    PG8_WAIT_V(0);
    if constexpr (!ALIGN_EPI) { if (wr == 0) PG8_BAR; }
    PG8_BAR;
    if constexpr (Epi::AFTER_DRAIN) { E.fused(acc, cur, wr, wc, fr, fq, lds, wid, lane); S.done(cur); }
#undef PG8_SA
#undef PG8_SB
#undef PG8_STAGE
#undef PG8_LDA
#undef PG8_LDB
#undef PG8_MMA
#undef PG8_WAIT_V
#undef PG8_WAIT_L
#undef PG8_BAR
#undef PG8_SCHED
}
}

namespace pg8 {
struct EpiInProjT {
    static constexpr bool PERM = true, AFTER_DRAIN = false, MIDK = false;
    unsigned char* ws;
    __device__ __forceinline__ void operator()(const f32x4 (&acc)[2][2][4][2], const Unit& u, int wr, int wc, int fr, int fq) const {
        const int row0 = u.pm * BM + wr * 64 + fr, pn = u.pn, cin = wc * 32 + 8 * fq;
        if (pn == 17) {
            if (wc == 0 && fq < 2) { float* F = (float*)(ws + WS_F);
#pragma unroll
                for (int ai = 0; ai < 2; ++ai)
#pragma unroll
                    for (int m = 0; m < 4; ++m)
#pragma unroll
                        for (int n = 0; n < 2; ++n)
#pragma unroll
                            for (int j = 0; j < 4; ++j) F[(size_t)(8 * fq + 4 * n + j) * M + row0 + ai * HALF + m * 16] = acc[ai][0][m][n][j]; }
            return;
        }
        bf16_t *b0, *b1; int ldc; float sc = 1.f;
        if (pn < 4) { b0 = (bf16_t*)(ws + WS_QA) + pn * 256 + cin; b1 = b0 + HALF; ldc = 1024; sc = C2; }
        else if (pn == 4) { b0 = (bf16_t*)(ws + WS_KA) + cin; b1 = (bf16_t*)(ws + WS_VA) + cin; ldc = 128; }
        else if (pn < 9) { b0 = (bf16_t*)(ws + WS_QB) + (pn - 5) * 256 + cin; b1 = b0 + HALF; ldc = 1024; sc = C2; }
        else if (pn < 13) { b0 = (bf16_t*)(ws + WS_KB) + (pn - 9) * 256 + cin; b1 = b0 + HALF; ldc = 1024; }
        else { b0 = (bf16_t*)(ws + WS_VB) + (pn - 13) * 256 + cin; b1 = b0 + HALF; ldc = 1024; }
#pragma unroll
        for (int ai = 0; ai < 2; ++ai)
#pragma unroll
            for (int m = 0; m < 4; ++m) { const size_t ro = (size_t)(row0 + ai * HALF + m * 16) * ldc;
#pragma unroll
                for (int bj = 0; bj < 2; ++bj) { const f32x4 v0 = acc[ai][bj][m][0] * sc, v1 = acc[ai][bj][m][1] * sc;
                    u32x4 w; w.x = cvt_pk_bf16(v0[0], v0[1]); w.y = cvt_pk_bf16(v0[2], v0[3]); w.z = cvt_pk_bf16(v1[0], v1[1]); w.w = cvt_pk_bf16(v1[2], v1[3]);
                    *(u32x4*)((bj ? b1 : b0) + ro) = w; } }
    }
};
struct EpiBf16T {
    static constexpr bool PERM = true, AFTER_DRAIN = false, MIDK = false;
    bf16_t* C; int ldc;
    __device__ __forceinline__ void operator()(const f32x4 (&acc)[2][2][4][2], const Unit& u, int wr, int wc, int fr, int fq) const {
        const int row0 = u.pm * BM + wr * 64 + fr, col0 = u.pn * BM + wc * 32 + 8 * fq;
#pragma unroll
        for (int ai = 0; ai < 2; ++ai)
#pragma unroll
            for (int m = 0; m < 4; ++m) { bf16_t* rp = C + (size_t)(row0 + ai * HALF + m * 16) * ldc + col0;
#pragma unroll
                for (int bj = 0; bj < 2; ++bj) { const f32x4 v0 = acc[ai][bj][m][0], v1 = acc[ai][bj][m][1];
                    u32x4 w; w.x = cvt_pk_bf16(v0[0], v0[1]); w.y = cvt_pk_bf16(v0[2], v0[3]); w.z = cvt_pk_bf16(v1[0], v1[1]); w.w = cvt_pk_bf16(v1[2], v1[3]);
                    *(u32x4*)(rp + bj * HALF) = w; } }
    }
};
struct EpiOutT {
    static constexpr bool PERM = true, AFTER_DRAIN = false, MIDK = true;
    bf16_t* C; int ldc; const PG8_LAS float* T;
    __device__ __forceinline__ void midk(f32x4 (&acc)[2][2][4][2], int ui, int wr, int fr) const {
#pragma unroll
        for (int ai = 0; ai < 2; ++ai)
#pragma unroll
            for (int m = 0; m < 4; ++m) { const float r = T[((ui & 1) * 256 + ai * HALF + wr * 64 + m * 16 + fr) * 2];
#pragma unroll
                for (int bj = 0; bj < 2; ++bj)
#pragma unroll
                    for (int n = 0; n < 2; ++n) acc[ai][bj][m][n] *= r; }
    }
    __device__ __forceinline__ void epi(const f32x4 (&acc)[2][2][4][2], const Unit& u, int ui, int wr, int wc, int fr, int fq) const {
        const int row0 = u.pm * BM + wr * 64 + fr, col0 = u.pn * BM + wc * 32 + 8 * fq;
#pragma unroll
        for (int ai = 0; ai < 2; ++ai)
#pragma unroll
            for (int m = 0; m < 4; ++m) { bf16_t* rp = C + (size_t)(row0 + ai * HALF + m * 16) * ldc + col0; const float r = T[((ui & 1) * 256 + ai * HALF + wr * 64 + m * 16 + fr) * 2 + 1];
#pragma unroll
                for (int bj = 0; bj < 2; ++bj) { const f32x4 v0 = acc[ai][bj][m][0] * r, v1 = acc[ai][bj][m][1] * r;
                    u32x4 w; w.x = cvt_pk_bf16(v0[0], v0[1]); w.y = cvt_pk_bf16(v0[2], v0[3]); w.z = cvt_pk_bf16(v1[0], v1[1]); w.w = cvt_pk_bf16(v1[2], v1[3]);
                    *(u32x4*)(rp + bj * HALF) = w; } }
    }
};
}

namespace pg8 {
__device__ __forceinline__ float dpp_ror1(float x) { return __builtin_bit_cast(float, __builtin_amdgcn_mov_dpp(__builtin_bit_cast(int, x), 0x121, 0xf, 0xf, true)); }
__device__ __forceinline__ float dpp_ror2(float x) { return __builtin_bit_cast(float, __builtin_amdgcn_mov_dpp(__builtin_bit_cast(int, x), 0x122, 0xf, 0xf, true)); }
__device__ __forceinline__ float gelu_tanh_fast(float x) {
    const float e = __builtin_amdgcn_exp2f(-2.3022082f * x * (1.0f + 0.044715f * x * x));
    return x * __builtin_amdgcn_rcpf(1.0f + e);
}
__device__ __forceinline__ f32x4 geglu4(f32x4 g, f32x4 v) {
    const f32x4 t = (g * g) * 0.044715f + 1.0f, a = (g * -2.3022082f) * t;
    f32x4 e; e[0] = __builtin_amdgcn_exp2f(a[0]); e[1] = __builtin_amdgcn_exp2f(a[1]); e[2] = __builtin_amdgcn_exp2f(a[2]); e[3] = __builtin_amdgcn_exp2f(a[3]);
    e = e + 1.0f;
    f32x4 r; r[0] = __builtin_amdgcn_rcpf(e[0]); r[1] = __builtin_amdgcn_rcpf(e[1]); r[2] = __builtin_amdgcn_rcpf(e[2]); r[3] = __builtin_amdgcn_rcpf(e[3]);
    return (g * v) * r;
}
constexpr size_t SIDE_HEAD = 0, SIDE_TAIL = 6 * MiB;
struct EpiUpT {
    static constexpr bool PERM = true, AFTER_DRAIN = false, MIDK = false;
    bf16_t* act; const float* cw; const float* cb; float* side; PG8_LAS float* X;
    __device__ __forceinline__ void operator()(const f32x4 (&acc)[2][2][4][2], const Unit& u, int wr, int wc, int fr, int fq) const {
        const int cin = wc * 32 + 8 * fq;
        f32x4 Wt[2][2][4];
#define EPIUP_LOADW(n_) do { _Pragma("unroll") for (int bj_ = 0; bj_ < 2; ++bj_) { const int col_ = bj_ * DFF + HALF * u.pn + cin + 4 * (n_); \
            Wt[n_][bj_][1] = *(const f32x4*)(cw + NUP + col_); Wt[n_][bj_][2] = *(const f32x4*)(cw + 2 * NUP + col_); } } while (0)
#define EPIUP_LOADB(n_) do { _Pragma("unroll") for (int bj_ = 0; bj_ < 2; ++bj_) { Wt[n_][bj_][3] = *(const f32x4*)(cb + bj_ * DFF + HALF * u.pn + cin + 4 * (n_)); Wt[n_][bj_][0] = *(const f32x4*)(cw + bj_ * DFF + HALF * u.pn + cin + 4 * (n_)); } } while (0)
        EPIUP_LOADW(0); EPIUP_LOADB(0);
        if (fr >= 14) {
#pragma unroll
            for (int ai = 0; ai < 2; ++ai)
#pragma unroll
                for (int bj = 0; bj < 2; ++bj)
#pragma unroll
                    for (int n = 0; n < 2; ++n) *(PG8_LAS f32x4*)(X + ((2 * ai + wr) * 2 + (fr - 14)) * 256 + bj * HALF + cin + 4 * n) = acc[ai][bj][3][n];
            if (wr == 1) {
#pragma unroll
                for (int bj = 0; bj < 2; ++bj)
#pragma unroll
                    for (int n = 0; n < 2; ++n) *(f32x4*)(side + SIDE_TAIL / 4 + ((size_t)u.pm * 2 + (fr - 14)) * NUP + u.pn * BM + bj * HALF + cin + 4 * n) = acc[1][bj][3][n];
            }
        }
        if (fr < 2 && wr == 0) {
#pragma unroll
            for (int bj = 0; bj < 2; ++bj)
#pragma unroll
                for (int n = 0; n < 2; ++n) *(f32x4*)(side + SIDE_HEAD / 4 + ((size_t)u.pm * 2 + fr) * NUP + u.pn * BM + bj * HALF + cin + 4 * n) = acc[0][bj][0][n];
        }
        asm volatile("s_waitcnt lgkmcnt(0)" ::: "memory"); __builtin_amdgcn_s_barrier(); asm volatile("" ::: "memory");
#pragma unroll
        for (int n = 0; n < 2; ++n) {
            if (n == 0) { EPIUP_LOADW(1); __builtin_amdgcn_sched_barrier(0); } else { EPIUP_LOADB(1); __builtin_amdgcn_sched_barrier(0); }
#pragma unroll
            for (int ai = 0; ai < 2; ++ai) {
                const int b4 = 2 * ai + wr;
                f32x4 p1[2], p2[2];
#pragma unroll
                for (int bj = 0; bj < 2; ++bj) {
                    f32x4 h62 = (f32x4){0.f, 0.f, 0.f, 0.f}, h63 = h62;
                    if (b4 > 0) { h62 = *(const PG8_LAS f32x4*)(X + ((b4 - 1) * 2 + 0) * 256 + bj * HALF + cin + 4 * n); h63 = *(const PG8_LAS f32x4*)(X + ((b4 - 1) * 2 + 1) * 256 + bj * HALF + cin + 4 * n); }
                    p1[bj] = h63; p2[bj] = (fr == 1) ? h63 : h62;
                }
#pragma unroll
                for (int m = 0; m < 4; ++m) {
                    f32x4 y[2];
#pragma unroll
                    for (int bj = 0; bj < 2; ++bj) {
                        const f32x4 v = acc[ai][bj][m][n];
                        f32x4 r1, r2;
#pragma unroll
                        for (int j = 0; j < 4; ++j) { r1[j] = dpp_ror1(v[j]); r2[j] = dpp_ror2(v[j]); }
                        const f32x4 q1 = (fr >= 1) ? r1 : p1[bj], q2 = (fr >= 2) ? r2 : p2[bj];
                        y[bj] = (Wt[n][bj][2] * v + Wt[n][bj][1] * q1) + (Wt[n][bj][0] * q2 + Wt[n][bj][3]);
                        p1[bj] = r1; p2[bj] = r2;
                    }
                    typedef unsigned u32x2v __attribute__((ext_vector_type(2)));
                    const f32x4 o4 = geglu4(y[0], y[1]); u32x2v w; w.x = cvt_pk_bf16(o4[0], o4[1]); w.y = cvt_pk_bf16(o4[2], o4[3]);
                    *(u32x2v*)(act + (size_t)(u.pm * BM + ai * HALF + wr * 64 + m * 16 + fr) * DFF + HALF * u.pn + cin + 4 * n) = w;
                    __builtin_amdgcn_sched_barrier(0);
                }
            }
            asm volatile("" ::: "memory"); __builtin_amdgcn_sched_barrier(0);
        }
#undef EPIUP_LOADW
#undef EPIUP_LOADB
    }
};
}
__device__ __forceinline__ void ph_convfix(const float* side, const float* cw, const float* cb, bf16_t* act) {
    const float* head = side + pg8::SIDE_HEAD / 4; const float* tail = side + pg8::SIDE_TAIL / 4;
    for (int idx = blockIdx.x * 512 + threadIdx.x; idx < 64 * 2 * DFF; idx += gridDim.x * 512) {
        const int pm = idx / (2 * DFF), r = (idx / DFF) & 1, n = idx % DFF;
        if ((pm & 15) == 0) continue;
        const int pg = ((n >> 7) << 8) + (n & 127);
        float y[2];
#pragma unroll
        for (int h = 0; h < 2; ++h) { const int pc = pg + 128 * h, col = h * DFF + n;
            const float H0 = head[((size_t)pm * 2 + 0) * NUP + pc], H1 = head[((size_t)pm * 2 + 1) * NUP + pc];
            const float T0 = tail[((size_t)(pm - 1) * 2 + 0) * NUP + pc], T1 = tail[((size_t)(pm - 1) * 2 + 1) * NUP + pc];
            const float w0 = cw[col], w1 = cw[NUP + col], w2 = cw[2 * NUP + col];
            y[h] = cb[col] + (r == 0 ? (w2 * H0 + w1 * T1 + w0 * T0) : (w2 * H1 + w1 * H0 + w0 * T1)); }
        act[(size_t)(256 * pm + r) * DFF + n] = (bf16_t)f2bf(gelu_tanh(y[0]) * y[1]);
    }
}
#include <hip/hip_bf16.h>
#include <cmath>
namespace attn_body {
using bf16=__hip_bfloat16;
using bf16x8=__attribute__((ext_vector_type(8)))short;
using s16x4=__attribute__((ext_vector_type(4)))short;
using f32x16=__attribute__((ext_vector_type(16)))float;
using u32x4=__attribute__((ext_vector_type(4)))unsigned;
using f32x4v=__attribute__((ext_vector_type(4)))float;
constexpr int BATCH=4,NHEAD=16,SEQ=4096,D=64,QP=1024,OP=2048;
constexpr int NW=8,QBLK=32,QB=QBLK*NW,KVBLK=64,NQB=SEQ/QB;
constexpr int ATTN_UNIT_ROWS=QB;
__device__ __forceinline__ int crow(int r,int hi){return (r&3)+8*(r>>2)+4*hi;}
#define SBAR() __builtin_amdgcn_sched_barrier(0)
template<bool WIN> __device__ __forceinline__ void amask(f32x16&p0,f32x16&p1,int koff,int qrel,int hi){
  const float NEG=-INFINITY; int d=qrel-(koff+4*hi); asm volatile("":"+v"(d));
  #pragma unroll
  for(int r=0;r<16;++r){const int kc=(r&3)+8*(r>>2);
    if(kc>d||(WIN&&kc<=d-128))p0[r]=NEG; if(kc+32>d||(WIN&&kc+32<=d-128))p1[r]=NEG;}
}

constexpr int NSLOT=3, SLOTB=8192;
constexpr int LDS_K=0, LDS_V=NSLOT*SLOTB, LDS_WS=2*NSLOT*SLOTB, LDS_OST=LDS_WS+NW*64*4, LDS_CL=LDS_OST+NW*4096+2048, LDS_CL2=LDS_CL+SEQ*4, LDS_WT=LDS_CL2+384*4, LDS_BYTES=LDS_WT+64;
constexpr float C2=0.125f*1.4426950408889634f;
__device__ __forceinline__ void glds16(const void*gsrc,unsigned lds_dst){unsigned keep;
  asm volatile("s_mov_b32 %0, m0\n\ts_mov_b32 m0, %2\n\ts_nop 0\n\tglobal_load_lds_dwordx4 %1, off\n\ts_mov_b32 m0, %0":"=&s"(keep):"v"(gsrc),"s"(lds_dst):"memory");}
__device__ __forceinline__ float max3f(float a,float b,float c){float r;asm("v_max3_f32 %0, %1, %2, %3":"=v"(r):"v"(a),"v"(b),"v"(c));return r;}
__device__ __forceinline__ float max2f(float a,float b){float r;asm("v_max_f32_e32 %0, %1, %2":"=v"(r):"v"(a),"v"(b));return r;}
__device__ __forceinline__ float fadd_s(float a,float b){float r;asm("v_add_f32_e32 %0, %1, %2":"=v"(r):"v"(a),"v"(b));return r;}
__device__ __forceinline__ float fsub_s(float a,float b){float r;asm("v_sub_f32_e32 %0, %1, %2":"=v"(r):"v"(a),"v"(b));return r;}
typedef float f32x2_t __attribute__((ext_vector_type(2))); typedef __bf16 bf16x2_t __attribute__((ext_vector_type(2)));
__device__ __forceinline__ unsigned cvtpk_s(float lo,float hi){f32x2_t v={lo,hi};bf16x2_t b=__builtin_convertvector(v,bf16x2_t);return __builtin_bit_cast(unsigned,b);}
#define WAIT_BAR(N) asm volatile("s_waitcnt vmcnt(" #N ") lgkmcnt(0)\n\ts_barrier":::"memory")

__device__ __forceinline__ void qkt(f32x16&p0,f32x16&p1,const char*Kslot,const bf16x8*qr,int r32,int hi){
  const char*kb=Kslot+hi*1024+r32*16;
  #pragma unroll
  for(int d0=0;d0<4;++d0){
    const bf16x8 b0=*reinterpret_cast<const bf16x8*>(kb+d0*2048);
    const bf16x8 b1=*reinterpret_cast<const bf16x8*>(kb+d0*2048+512);
    if(d0==0){p0=__builtin_amdgcn_mfma_f32_32x32x16_bf16(b0,qr[0],p0,0,0,0);p1=__builtin_amdgcn_mfma_f32_32x32x16_bf16(b1,qr[0],p1,0,0,0);}
    else{p0=__builtin_amdgcn_mfma_f32_32x32x16_bf16(b0,qr[d0],p0,0,0,0);p1=__builtin_amdgcn_mfma_f32_32x32x16_bf16(b1,qr[d0],p1,0,0,0);}}
}
typedef __attribute__((address_space(3))) const char* lds_cptr;
typedef short v4i16_t __attribute__((ext_vector_type(4)));
__device__ __forceinline__ void kload8(bf16x8*kf,lds_cptr kp){
  kf[0]=*(const __attribute__((address_space(3))) bf16x8*)(kp);      kf[1]=*(const __attribute__((address_space(3))) bf16x8*)(kp+512);
  kf[2]=*(const __attribute__((address_space(3))) bf16x8*)(kp+2048); kf[3]=*(const __attribute__((address_space(3))) bf16x8*)(kp+2560);
  kf[4]=*(const __attribute__((address_space(3))) bf16x8*)(kp+4096); kf[5]=*(const __attribute__((address_space(3))) bf16x8*)(kp+4608);
  kf[6]=*(const __attribute__((address_space(3))) bf16x8*)(kp+6144); kf[7]=*(const __attribute__((address_space(3))) bf16x8*)(kp+6656);
}
__device__ __forceinline__ void kload2(bf16x8*kf,lds_cptr kp,int j){ kf[2*j]=*(const __attribute__((address_space(3))) bf16x8*)(kp+j*2048); kf[2*j+1]=*(const __attribute__((address_space(3))) bf16x8*)(kp+j*2048+512); }
__device__ __forceinline__ s16x4 vtr(lds_cptr p){ return __builtin_bit_cast(s16x4,__builtin_amdgcn_ds_read_tr16_b64_v4i16((__attribute__((address_space(3))) v4i16_t*)p)); }
__device__ __forceinline__ float rowmax(const f32x16&p0,const f32x16&p1){
  float a=max3f(p0[0],p0[1],p1[0]),b=max3f(p0[2],p0[3],p1[1]);a=max3f(a,p1[2],p1[3]);
  #pragma unroll
  for(int r=4;r<16;r+=4){a=max3f(a,p0[r],p0[r+1]);b=max3f(b,p0[r+2],p0[r+3]);a=max3f(a,p1[r],p1[r+1]);b=max3f(b,p1[r+2],p1[r+3]);}
  const float m=max2f(a,b);
  auto rr=__builtin_amdgcn_permlane32_swap(__float_as_uint(m),__float_as_uint(m),false,false);
  return max2f(__uint_as_float(rr[0]),__uint_as_float(rr[1]));
}
__device__ __forceinline__ void pv(f32x16*o,int vb,bf16x8 pa0,bf16x8 pa1,bf16x8 pa2,bf16x8 pa3){
  #pragma unroll
  for(int d0=0;d0<2;++d0){s16x4 lo[4],hi[4];
    #pragma unroll
    for(int ks=0;ks<4;++ks){
      asm volatile("ds_read_b64_tr_b16 %0,%1 offset:%c2":"=&v"(lo[ks]):"v"(vb),"i"(d0*4096+ks*1024):"memory");
      asm volatile("ds_read_b64_tr_b16 %0,%1 offset:%c2":"=&v"(hi[ks]):"v"(vb),"i"(d0*4096+ks*1024+512):"memory");}
    asm volatile("s_waitcnt lgkmcnt(0)":::"memory");SBAR();
    #define PK(k) (bf16x8){lo[k][0],lo[k][1],lo[k][2],lo[k][3],hi[k][0],hi[k][1],hi[k][2],hi[k][3]}
    o[d0]=__builtin_amdgcn_mfma_f32_32x32x16_bf16(pa0,PK(0),o[d0],0,0,0);
    o[d0]=__builtin_amdgcn_mfma_f32_32x32x16_bf16(pa1,PK(1),o[d0],0,0,0);
    o[d0]=__builtin_amdgcn_mfma_f32_32x32x16_bf16(pa2,PK(2),o[d0],0,0,0);
    o[d0]=__builtin_amdgcn_mfma_f32_32x32x16_bf16(pa3,PK(3),o[d0],0,0,0);
    #undef PK
  }
}

#ifndef ATTN_STORE16
#define ATTN_STORE16(p,v) (*(u32x4*)(p)=(v))
#endif
template<int THRL,int MODE> __device__ __forceinline__ void attn_unit(int b,int h,int qb,const bf16*Q,const bf16*__restrict__ K,const bf16*__restrict__ V,int KP,int kvcol,bf16*O,int ocol,float*ssq,float slope_l2,float sink_l2,char*shm){
  int tid=threadIdx.x; asm volatile("":"+v"(tid));
  const int lane=tid&63,r32=lane&31,hi=lane>>5; const int wid=__builtin_amdgcn_readfirstlane(tid>>6);
  const long rowbase=(long)b*SEQ; const int q0=qb*QB;
  const int t0=(MODE==0)?((qb>0)?4*qb-2:0):0;
  const bf16*Qw=Q+(rowbase+q0+wid*QBLK)*QP+h*D;
  const bf16*Kh=K+(rowbase+(long)t0*KVBLK)*KP+kvcol,*Vh=V+(rowbase+(long)t0*KVBLK)*KP+kvcol;
  const unsigned lds0=(unsigned)(uintptr_t)shm;
  float*wsf=(float*)(shm+LDS_WS)+wid*64;
  const bf16*ksrc=Kh+(long)lane*KP+wid*8;
  const bf16*vsrc=Vh+(long)(16*(wid&3)+(lane>>2))*KP+(wid>>2)*32+(lane&3)*8;
  const unsigned kdst=lds0+LDS_K+wid*1024, vdst=lds0+LDS_V+wid*1024;
  #define DMA_K(t,slot) glds16(ksrc+(long)(t)*KVBLK*KP,(unsigned)__builtin_amdgcn_readfirstlane(kdst+(slot)))
  #define DMA_V(t,slot) glds16(vsrc+(long)(t)*KVBLK*KP,(unsigned)__builtin_amdgcn_readfirstlane(vdst+(slot)))
  const int vb0=(int)(lds0+LDS_V)+((lane>>4)&1)*32+(lane&3)*8+(4*hi+((lane&15)>>2))*64;
  const char*Kbase=shm+LDS_K; bf16x8 kf[8];
  const lds_cptr shm3=(lds_cptr)shm; const lds_cptr kp0=shm3+LDS_K+hi*1024+r32*16; const lds_cptr vp0=shm3+LDS_V+((lane>>4)&1)*32+(lane&3)*8+(4*hi+((lane&15)>>2))*64;
  const int NT=(MODE==0)?((qb>0)?6:4):(q0+QB)/KVBLK;
  typedef __attribute__((address_space(3))) float* lds_fptr;
  const lds_fptr cl=(lds_fptr)((lds_cptr)shm+((MODE==1)?LDS_CL:LDS_CL2));
  if(MODE==0){ if(tid<384)cl[tid]=-slope_l2*(float)tid; }
  DMA_K(0,0);DMA_V(0,0);DMA_K(1,SLOTB);
  bf16x8 qr[4];
  #pragma unroll
  for(int d0=0;d0<4;++d0)qr[d0]=*reinterpret_cast<const bf16x8*>(&Qw[(long)r32*QP+d0*16+hi*8]);
  float mhat=0.f,l_reg=0.f;f32x16 o[2];o[0]=f32x16{};o[1]=f32x16{};
  const int qrel=wid*QBLK+r32;
  asm volatile("s_waitcnt lgkmcnt(0)\n\ts_barrier":::"memory");
  const float ct=cl[q0-t0*KVBLK+qrel];
  float nm=ct;
  #define CINIT(I0,I1,t) do{ const lds_fptr cp_=cl+64*(t)+4*hi; _Pragma("unroll") for(int g_=0;g_<4;++g_){ \
      const f32x4v a_=*(const __attribute__((address_space(3))) f32x4v*)(cp_+8*g_), b_=*(const __attribute__((address_space(3))) f32x4v*)(cp_+8*g_+32); \
      _Pragma("unroll") for(int j_=0;j_<4;++j_){ I0[4*g_+j_]=nm-a_[j_]; I1[4*g_+j_]=nm-b_[j_]; } SBAR(); } }while(0)
  #define CMASK(P0,P1,t) do{int ko_=64*((t)-(NT-4)); if(MODE==0||ko_>=0)amask<MODE==0>(P0,P1,ko_,qrel,hi);}while(0)
  bool resc=false;
  #define START(P0,P1) do{ const float rm=rowmax(P0,P1); resc=false; \
    { const float dl=__builtin_fmaxf(rm,-1000.f); mhat=fadd_s(mhat,dl); \
      _Pragma("unroll") for(int r=0;r<16;++r){P0[r]=fsub_s(P0[r],dl);P1[r]=fsub_s(P1[r],dl);} \
      nm=ct-mhat; } \
    _Pragma("unroll") for(int r=0;r<16;++r)P0[r]=__builtin_amdgcn_exp2f(P0[r]); }while(0)
  #define RESC() do{ if(resc){ asm volatile("s_waitcnt lgkmcnt(0)":::"memory"); \
      _Pragma("unroll") for(int d_=0;d_<2;++d_) _Pragma("unroll") for(int r=0;r<16;++r)o[d_][r]*=wsf[crow(r,hi)]; } }while(0)
  f32x16 pA0,pA1,pB0,pB1;
  int sl_prev=0,sl_cur=0,sl_next=SLOTB;
  #define ROT() do{sl_prev=sl_cur;sl_cur=sl_next;sl_next=(sl_next==(NSLOT-1)*SLOTB)?0:sl_next+SLOTB;}while(0)
  DMA_K(2,2*SLOTB);
  WAIT_BAR(3);
  CINIT(pA0,pA1,0); qkt(pA0,pA1,Kbase,qr,r32,hi);asm volatile("s_nop 15\n\ts_nop 7":"+v"(pA0),"+v"(pA1));CMASK(pA0,pA1,0);
  START(pA0,pA1);
  _Pragma("unroll") for(int r=0;r<16;++r)pA1[r]=__builtin_amdgcn_exp2f(pA1[r]);
  WAIT_BAR(0);
  DMA_K(3,0);DMA_V(1,SLOTB);
  ROT();
  kload8(kf,kp0+sl_cur);
  WAIT_BAR(2);
  s16x4 vlo[8],vhi[8]; u32x4 pw0,pw1,pw2,pw3;
  #define PKW(P,B) cvtpk_s(P[B],P[B+1])
  #define PAF(k) __builtin_bit_cast(bf16x8,pw##k)
  #define VFR(i) (bf16x8){vlo[i][0],vlo[i][1],vlo[i][2],vlo[i][3],vhi[i][0],vhi[i][1],vhi[i][2],vhi[i][3]}
  #define PIN(x) asm volatile("":"+v"(x))
  #define MX3(a,b,c) __builtin_fmaxf(__builtin_fmaxf((a),(b)),(c))
  #define GAPA(MF,A0,A1,A2,A3,W0,W1,PW) do{ MF; sacc+=A0; sacc+=A1; sacc+=A2; sacc+=A3; PIN(sacc); W0; W1; PIN(PW); SBAR(); }while(0)
  #define EX(v) __builtin_amdgcn_exp2f(v)
  #define GAPB(MF,X,B) do{ MF; X[B]=EX(X[B]); X[B+1]=EX(X[B+1]); X[B+2]=EX(X[B+2]); X[B+3]=EX(X[B+3]); PIN(X); SBAR(); }while(0)
  #define VRD(i) do{ vlo[i]=vtr(vp_+(((i)>>2)*4096+((i)&3)*1024)); vhi[i]=vtr(vp_+(((i)>>2)*4096+((i)&3)*1024+512)); }while(0)
  #define KRD(G,j) do{ if(G){ kload2(kf,kp0+sl_next,j); SBAR(); } }while(0)
  #define STEP(C0,C1,P0,P1,t,GK,GV,GL) do{ SBAR(); CINIT(C0,C1,t); SBAR(); \
    const lds_cptr vp_=vp0+sl_prev; \
    VRD(0); SBAR(); float sacc=(P0[0]+P0[1]); \
    GAPA(C0=__builtin_amdgcn_mfma_f32_32x32x16_bf16(kf[0],qr[0],C0,0,0,0), P0[2],P0[3],P0[4],P0[5],     pw0[0]=PKW(P0,0), pw0[1]=PKW(P0,2), pw0); \
    VRD(4); SBAR(); GAPA(C1=__builtin_amdgcn_mfma_f32_32x32x16_bf16(kf[1],qr[0],C1,0,0,0), P0[6],P0[7],P0[8],P0[9],     pw0[2]=PKW(P0,4), pw0[3]=PKW(P0,6), pw0); \
    VRD(1); SBAR(); GAPA(C0=__builtin_amdgcn_mfma_f32_32x32x16_bf16(kf[2],qr[1],C0,0,0,0),   P0[10],P0[11],P0[12],P0[13], pw1[0]=PKW(P0,8), pw1[1]=PKW(P0,10), pw1); \
    VRD(5); SBAR(); GAPA(C1=__builtin_amdgcn_mfma_f32_32x32x16_bf16(kf[3],qr[1],C1,0,0,0),   P0[14],P0[15],P1[0],P1[1],   pw1[2]=PKW(P0,12),pw1[3]=PKW(P0,14), pw1); \
    VRD(2); SBAR(); GAPA(C0=__builtin_amdgcn_mfma_f32_32x32x16_bf16(kf[4],qr[2],C0,0,0,0),   P1[2],P1[3],P1[4],P1[5],     pw2[0]=PKW(P1,0), pw2[1]=PKW(P1,2), pw2); \
    VRD(6); SBAR(); GAPA(C1=__builtin_amdgcn_mfma_f32_32x32x16_bf16(kf[5],qr[2],C1,0,0,0),   P1[6],P1[7],P1[8],P1[9],     pw2[2]=PKW(P1,4), pw2[3]=PKW(P1,6), pw2); \
    VRD(3); SBAR(); GAPA(C0=__builtin_amdgcn_mfma_f32_32x32x16_bf16(kf[6],qr[3],C0,0,0,0),   P1[10],P1[11],P1[12],P1[13], pw3[0]=PKW(P1,8), pw3[1]=PKW(P1,10), pw3); \
    VRD(7); SBAR(); GAPA(C1=__builtin_amdgcn_mfma_f32_32x32x16_bf16(kf[7],qr[3],C1,0,0,0),   P1[14],P1[15],0.f,0.f,       pw3[2]=PKW(P1,12),pw3[3]=PKW(P1,14), pw3); \
    l_reg+=sacc; \
    if(GK){DMA_K((t)+3,sl_cur);} if(GV){DMA_V((t)+1,sl_next);} \
    CMASK(C0,C1,t); \
    { float a=MX3(C0[0],C0[1],C1[0]),b=MX3(C0[2],C0[3],C1[1]); a=MX3(a,C1[2],C1[3]); \
      _Pragma("unroll") for(int r=4;r<16;r+=4){a=MX3(a,C0[r],C0[r+1]);b=MX3(b,C0[r+2],C0[r+3]);a=MX3(a,C1[r],C1[r+1]);b=MX3(b,C1[r+2],C1[r+3]);} \
      float rm=__builtin_fmaxf(a,b); { auto rr=__builtin_amdgcn_permlane32_swap(__float_as_uint(rm),__float_as_uint(rm),false,false); rm=__builtin_fmaxf(__uint_as_float(rr[0]),__uint_as_float(rr[1])); } \
      resc=false; \
      if(__builtin_expect(__any(rm>(float)THRL),0)){ const float dl=__builtin_fmaxf(rm,0.f); mhat+=dl; \
        _Pragma("unroll") for(int r=0;r<16;++r){C0[r]-=dl;C1[r]-=dl;} \
        nm=ct-mhat; \
        const float f=__builtin_amdgcn_exp2f(-dl); l_reg*=f; if(hi==0)wsf[r32]=f; resc=true; } } \
    SBAR(); \
    GAPB(o[0]=__builtin_amdgcn_mfma_f32_32x32x16_bf16(PAF(0),VFR(0),o[0],0,0,0), C0,0); \
    GAPB(o[1]=__builtin_amdgcn_mfma_f32_32x32x16_bf16(PAF(0),VFR(4),o[1],0,0,0), C0,4); \
    KRD(GL,0); GAPB(o[0]=__builtin_amdgcn_mfma_f32_32x32x16_bf16(PAF(1),VFR(1),o[0],0,0,0), C0,8); \
    KRD(GL,1); GAPB(o[1]=__builtin_amdgcn_mfma_f32_32x32x16_bf16(PAF(1),VFR(5),o[1],0,0,0), C0,12); \
    KRD(GL,2); GAPB(o[0]=__builtin_amdgcn_mfma_f32_32x32x16_bf16(PAF(2),VFR(2),o[0],0,0,0), C1,0); \
    KRD(GL,3); GAPB(o[1]=__builtin_amdgcn_mfma_f32_32x32x16_bf16(PAF(2),VFR(6),o[1],0,0,0), C1,4); \
    GAPB(o[0]=__builtin_amdgcn_mfma_f32_32x32x16_bf16(PAF(3),VFR(3),o[0],0,0,0), C1,8); \
    GAPB(o[1]=__builtin_amdgcn_mfma_f32_32x32x16_bf16(PAF(3),VFR(7),o[1],0,0,0), C1,12); \
    }while(0)
  #define ACT(tt) ((64*((tt)-(NT-4))+63>=32*wid-127)&&(64*((tt)-(NT-4))<=32*wid+31))
  #define STEPW(C0,C1,P0,P1,t,GK,GV,GL) do{ SBAR(); \
    const bool aq_=ACT(t), ap_=ACT((t)-1); \
    const lds_cptr vp_=vp0+sl_prev; \
    if(ap_){ VRD(0);VRD(4);VRD(1);VRD(5);VRD(2);VRD(6);VRD(3);VRD(7); \
      float sacc=(P0[0]+P0[1]); _Pragma("unroll") for(int r=2;r<16;++r)sacc+=P0[r]; _Pragma("unroll") for(int r=0;r<16;++r)sacc+=P1[r]; l_reg+=sacc; \
      pw0=(u32x4){PKW(P0,0),PKW(P0,2),PKW(P0,4),PKW(P0,6)};pw1=(u32x4){PKW(P0,8),PKW(P0,10),PKW(P0,12),PKW(P0,14)};pw2=(u32x4){PKW(P1,0),PKW(P1,2),PKW(P1,4),PKW(P1,6)};pw3=(u32x4){PKW(P1,8),PKW(P1,10),PKW(P1,12),PKW(P1,14)}; } \
    SBAR(); \
    if(aq_){ CINIT(C0,C1,t); \
      C0=__builtin_amdgcn_mfma_f32_32x32x16_bf16(kf[0],qr[0],C0,0,0,0); C1=__builtin_amdgcn_mfma_f32_32x32x16_bf16(kf[1],qr[0],C1,0,0,0); \
      C0=__builtin_amdgcn_mfma_f32_32x32x16_bf16(kf[2],qr[1],C0,0,0,0); C1=__builtin_amdgcn_mfma_f32_32x32x16_bf16(kf[3],qr[1],C1,0,0,0); \
      C0=__builtin_amdgcn_mfma_f32_32x32x16_bf16(kf[4],qr[2],C0,0,0,0); C1=__builtin_amdgcn_mfma_f32_32x32x16_bf16(kf[5],qr[2],C1,0,0,0); \
      C0=__builtin_amdgcn_mfma_f32_32x32x16_bf16(kf[6],qr[3],C0,0,0,0); C1=__builtin_amdgcn_mfma_f32_32x32x16_bf16(kf[7],qr[3],C1,0,0,0); } \
    if(GK){DMA_K((t)+3,sl_cur);} if(GV){DMA_V((t)+1,sl_next);} \
    resc=false; \
    if(aq_){ CMASK(C0,C1,t); \
      float a=MX3(C0[0],C0[1],C1[0]),b=MX3(C0[2],C0[3],C1[1]); a=MX3(a,C1[2],C1[3]); \
      _Pragma("unroll") for(int r=4;r<16;r+=4){a=MX3(a,C0[r],C0[r+1]);b=MX3(b,C0[r+2],C0[r+3]);a=MX3(a,C1[r],C1[r+1]);b=MX3(b,C1[r+2],C1[r+3]);} \
      float rm=__builtin_fmaxf(a,b); { auto rr=__builtin_amdgcn_permlane32_swap(__float_as_uint(rm),__float_as_uint(rm),false,false); rm=__builtin_fmaxf(__uint_as_float(rr[0]),__uint_as_float(rr[1])); } \
      if(__builtin_expect(__any(rm>(float)THRL),0)){ const float dl=__builtin_fmaxf(rm,0.f); mhat+=dl; \
        _Pragma("unroll") for(int r=0;r<16;++r){C0[r]-=dl;C1[r]-=dl;} \
        nm=ct-mhat; \
        const float f=__builtin_amdgcn_exp2f(-dl); l_reg*=f; if(hi==0)wsf[r32]=f; resc=true; } } \
    SBAR(); \
    if(ap_){ \
      o[0]=__builtin_amdgcn_mfma_f32_32x32x16_bf16(PAF(0),VFR(0),o[0],0,0,0); o[1]=__builtin_amdgcn_mfma_f32_32x32x16_bf16(PAF(0),VFR(4),o[1],0,0,0); \
      o[0]=__builtin_amdgcn_mfma_f32_32x32x16_bf16(PAF(1),VFR(1),o[0],0,0,0); o[1]=__builtin_amdgcn_mfma_f32_32x32x16_bf16(PAF(1),VFR(5),o[1],0,0,0); \
      o[0]=__builtin_amdgcn_mfma_f32_32x32x16_bf16(PAF(2),VFR(2),o[0],0,0,0); o[1]=__builtin_amdgcn_mfma_f32_32x32x16_bf16(PAF(2),VFR(6),o[1],0,0,0); \
      o[0]=__builtin_amdgcn_mfma_f32_32x32x16_bf16(PAF(3),VFR(3),o[0],0,0,0); o[1]=__builtin_amdgcn_mfma_f32_32x32x16_bf16(PAF(3),VFR(7),o[1],0,0,0); } \
    if((GL)&&ACT((t)+1)){ kload2(kf,kp0+sl_next,0); kload2(kf,kp0+sl_next,1); kload2(kf,kp0+sl_next,2); kload2(kf,kp0+sl_next,3); } \
    if(aq_){ _Pragma("unroll") for(int r=0;r<16;++r){C0[r]=EX(C0[r]);C1[r]=EX(C1[r]);} } else { C0=f32x16{}; C1=f32x16{}; } \
    SBAR(); \
    }while(0)
  #define STEPX(C0,C1,P0,P1,t,GK,GV,GL) do{ if(MODE==0){ STEPW(C0,C1,P0,P1,t,GK,GV,GL); } else { STEP(C0,C1,P0,P1,t,GK,GV,GL); } }while(0)
  int t=1;
  #undef CMASK
  #define CMASK(P0,P1,t) do{}while(0)
  for(;t+5<NT;t+=2){
    STEP(pB0,pB1,pA0,pA1,t,true,true,true);     WAIT_BAR(2); RESC(); ROT();
    STEP(pA0,pA1,pB0,pB1,t+1,true,true,true);   WAIT_BAR(2); RESC(); ROT();
  }
  #undef CMASK
  #define CMASK(P0,P1,t) do{int ko_=64*((t)-(NT-4)); if(MODE==0||ko_>=0)amask<MODE==0>(P0,P1,ko_,qrel,hi);}while(0)
  #define ENDW(tt) do{ if((tt)+3<NT){WAIT_BAR(2);} else if((tt)+2<NT){WAIT_BAR(1);} else {WAIT_BAR(0);} }while(0)
  for(;t+1<NT;t+=2){
    STEPX(pB0,pB1,pA0,pA1,t,(t+3<NT),(t+1<NT),(t+1<NT));       ENDW(t);   RESC(); ROT();
    STEPX(pA0,pA1,pB0,pB1,t+1,(t+4<NT),(t+2<NT),(t+2<NT));     ENDW(t+1); RESC(); ROT();
  }
  STEPX(pB0,pB1,pA0,pA1,NT-1,false,false,false); RESC();
  if(MODE==1||ACT(NT-1))
  { float sacc=pB0[0]+pB0[1]; _Pragma("unroll") for(int r=2;r<16;++r)sacc+=pB0[r]; _Pragma("unroll") for(int r=0;r<16;++r)sacc+=pB1[r]; l_reg+=sacc;
    pw0=(u32x4){PKW(pB0,0),PKW(pB0,2),PKW(pB0,4),PKW(pB0,6)};pw1=(u32x4){PKW(pB0,8),PKW(pB0,10),PKW(pB0,12),PKW(pB0,14)};pw2=(u32x4){PKW(pB1,0),PKW(pB1,2),PKW(pB1,4),PKW(pB1,6)};pw3=(u32x4){PKW(pB1,8),PKW(pB1,10),PKW(pB1,12),PKW(pB1,14)};
    SBAR(); pv(o,vb0+sl_cur,PAF(0),PAF(1),PAF(2),PAF(3)); }
  #undef PKW
  #undef PAF
  #undef VFR
  #undef PIN
  #undef MX3
  #undef GAPA
  #undef GAPB
  #undef EX
  #undef VRD
  #undef KRD
  #undef STEP
  #undef ENDW
  #undef STEPX
  #undef STEPW
  #undef ACT
  {auto rr=__builtin_amdgcn_permlane32_swap(__float_as_uint(l_reg),__float_as_uint(l_reg),false,false);l_reg=__uint_as_float(rr[0])+__uint_as_float(rr[1]);}
  if(MODE==0)l_reg+=__builtin_amdgcn_exp2f(sink_l2-mhat);
  if(hi==0)wsf[32+r32]=l_reg;asm volatile("s_waitcnt lgkmcnt(0)":::"memory");
  float rli[16];
  #pragma unroll
  for(int r=0;r<16;++r)rli[r]=__builtin_amdgcn_rcpf(wsf[32+crow(r,hi)]);
  bf16*Ow=O+(rowbase+q0+wid*QBLK)*OP+ocol;
  { bf16*stg=(bf16*)(shm+LDS_OST)+wid*2048;
    #pragma unroll
    for(int r=0;r<16;++r){const int orow=crow(r,hi);
      #pragma unroll
      for(int d0=0;d0<2;++d0)stg[orow*64+d0*32+r32]=__float2bfloat16(o[d0][r]*rli[r]);}
    asm volatile("s_waitcnt lgkmcnt(0)":::"memory");
    #pragma unroll
    for(int i=0;i<4;++i){const int row=i*8+(lane>>3),ch=lane&7; const u32x4 v=*(const u32x4*)(stg+row*64+ch*8); ATTN_STORE16(Ow+(long)row*OP+ch*8,v);
      float ss=0.f;
      #pragma unroll
      for(int e=0;e<4;++e){const float lo=__builtin_bit_cast(float,v[e]<<16),hh=__builtin_bit_cast(float,v[e]&0xffff0000u); ss+=lo*lo+hh*hh;}
      ss+=__shfl_xor(ss,1); ss+=__shfl_xor(ss,2); ss+=__shfl_xor(ss,4);
      if(ch==0)__hip_atomic_fetch_add(ssq+(rowbase+q0+wid*QBLK+row)*2+MODE,ss,__ATOMIC_RELAXED,__HIP_MEMORY_SCOPE_AGENT); } }
  asm volatile("s_waitcnt lgkmcnt(0)\n\ts_barrier":::"memory");
  #undef CINIT
  #undef DMA_K
  #undef DMA_V
  #undef CMASK
  #undef START
  #undef RESC
  #undef ROT
}
constexpr int ATTN_LDS_BYTES=LDS_BYTES;
#undef SBAR
#undef WAIT_BAR
}

__device__ __forceinline__ void fox_cumsum(const float* Ft, float bias, int b, int h, char* lds) {
    typedef __attribute__((address_space(3))) float* lds_fptr; typedef __attribute__((address_space(3))) const char* lds_cptr;
    const lds_fptr cl = (lds_fptr)((lds_cptr)lds + attn_body::LDS_CL), wt = (lds_fptr)((lds_cptr)lds + attn_body::LDS_WT);
    int tid = threadIdx.x; asm volatile("" : "+v"(tid));
    const int lane = tid & 63, wave = tid >> 6;
    const f32x4* f = (const f32x4*)(Ft + (size_t)h * M + (size_t)b * SEQ + 8 * tid);
    const f32x4 a = f[0], c = f[1];
    float v[8] = {a[0], a[1], a[2], a[3], c[0], c[1], c[2], c[3]};
#pragma unroll
    for (int k = 0; k < 8; ++k) v[k] = log_sigmoid(v[k] + bias);
#pragma unroll
    for (int k = 1; k < 8; ++k) v[k] += v[k - 1];
    float inc = v[7];
#pragma unroll
    for (int o = 1; o < 64; o <<= 1) { const float t = __shfl_up(inc, o); if (lane >= o) inc += t; }
    if (lane == 63) wt[wave] = inc;
    __syncthreads();
    float base = inc - v[7];
#pragma unroll
    for (int w = 0; w < 8; ++w) if (w < wave) base += wt[w];
    *(__attribute__((address_space(3))) f32x4*)(cl + 8 * tid) = (f32x4){(v[0] + base) * LOG2E, (v[1] + base) * LOG2E, (v[2] + base) * LOG2E, (v[3] + base) * LOG2E};
    *(__attribute__((address_space(3))) f32x4*)(cl + 8 * tid + 4) = (f32x4){(v[4] + base) * LOG2E, (v[5] + base) * LOG2E, (v[6] + base) * LOG2E, (v[7] + base) * LOG2E};
    __syncthreads();
}
__device__ __forceinline__ void attn_phase(const Ptrs& P, char* lds) {
    unsigned char* ws = P.ws;
    const int G = gridDim.x, bx = blockIdx.x, vcu0 = (G % 8 == 0) ? (bx % 8) * (G / 8) + bx / 8 : bx;
    for (int v = vcu0; v < 256; v += G) {
        const int bh = v >> 2, s = v & 3, b = bh >> 4, h = bh & 15;
        fox_cumsum((const float*)(ws + WS_F), P.b_forget[h], b, h, lds);
        for (int i = 0; i < 4; ++i) {
            const int qb = (i == 0) ? s : (i == 1) ? 7 - s : (i == 2) ? 8 + s : 15 - s;
            attn_body::attn_unit<60, 1>(b, h, qb, (const attn_body::bf16*)(ws + WS_QB), (const attn_body::bf16*)(ws + WS_KB), (const attn_body::bf16*)(ws + WS_VB), 1024, h * 64,
                                        (attn_body::bf16*)(ws + WS_O), 1024 + h * 64, (float*)(ws + WS_CS), 0.f, 0.f, lds);
        }
        for (int i = 0; i < 4; ++i) {
            const int qb = (i == 0) ? s : (i == 1) ? 7 - s : (i == 2) ? 8 + s : 15 - s;
            attn_body::attn_unit<8, 0>(b, h, qb, (const attn_body::bf16*)(ws + WS_QA), (const attn_body::bf16*)(ws + WS_KA), (const attn_body::bf16*)(ws + WS_VA), 128, (h >> 3) * 64,
                                       (attn_body::bf16*)(ws + WS_O), h * 64, (float*)(ws + WS_CS), exp2f(-0.5f * (float)(h + 1)) * LOG2E, P.sinks[h] * LOG2E, lds);
        }
    }
}
#define LAS __attribute__((address_space(3)))
#define XB_TMO      128
#define XB_XCNT(j)  (256  + 64 * (j))
#define XB_XSUB(j)  (1280 + 64 * (j))
#define XB_XGEN(j)  (2304 + 64 * (j))
#define XB_TOP      3328
#define XB_TOPGEN   3392
#define XCD_BAR_WORDS 3456
#define XB_SPIN_CAP (1u << 18)

__device__ __forceinline__ unsigned xb_ld(unsigned* p)              { return __hip_atomic_load(p, __ATOMIC_RELAXED, __HIP_MEMORY_SCOPE_AGENT); }
__device__ __forceinline__ unsigned xb_add(unsigned* p, unsigned v) { return __hip_atomic_fetch_add(p, v, __ATOMIC_RELAXED, __HIP_MEMORY_SCOPE_AGENT); }
__device__ __forceinline__ unsigned xb_xcc_id() { return (unsigned)__builtin_amdgcn_s_getreg((3 << 11) | 20) & 0xFu; }
#define XB_SPIN(cond, bar) do { unsigned _sp = 0; while (cond) { __builtin_amdgcn_s_sleep(1); \
    if ((++_sp & 255u) == 0u) { if (xb_ld(&(bar)[XB_TMO])) break; if (_sp > XB_SPIN_CAP) { atomicAdd(&(bar)[XB_TMO], 1u); break; } } } } while (0)

struct XcdBarrier {
    unsigned* bar; unsigned x;
    volatile LAS unsigned* st;
};

__device__ __forceinline__ XcdBarrier xcd_barrier_post(unsigned* bar, volatile LAS unsigned* st) {
    XcdBarrier b; b.bar = bar; b.x = xb_xcc_id(); b.st = st;
    if (threadIdx.x == 0) (void)xb_add(&bar[XB_XCNT(b.x)], 1u);
    return b;
}
__device__ __forceinline__ void xcd_barrier_complete(unsigned* bar, unsigned x, unsigned& nloc, unsigned& nx) {
    const unsigned G = gridDim.x * gridDim.y * gridDim.z;
    unsigned sum, cnt, mine, sp = 0u;
    for (;;) {
        sum = 0u; cnt = 0u; mine = 0u;
#pragma unroll
        for (unsigned j = 0; j < 16; ++j) { const unsigned c = xb_ld(&bar[XB_XCNT(j)]); sum += c; cnt += (c > 0u) ? 1u : 0u; mine = (j == x) ? c : mine; }
        if (sum == G) break;
        __builtin_amdgcn_s_sleep(1);
        if ((++sp & 255u) == 0u) { if (xb_ld(&bar[XB_TMO])) break; if (sp > XB_SPIN_CAP) { atomicAdd(&bar[XB_TMO], 1u); break; } }
    }
    nloc = mine > 0u ? mine : 1u; nx = cnt > 0u ? cnt : 1u;
}

__device__ __forceinline__ void xcd_barrier(const XcdBarrier& b) {
    asm volatile("s_waitcnt vmcnt(0)" ::: "memory");
    __syncthreads();
    if (threadIdx.x == 0) {
        unsigned* bar = b.bar;
        __builtin_amdgcn_s_waitcnt(0);
        unsigned nloc = b.st[0], nx = b.st[1];
        if (nloc == 0u) { xcd_barrier_complete(bar, b.x, nloc, nx); b.st[0] = nloc; b.st[1] = nx; }
        const unsigned old = xb_add(&bar[XB_XSUB(b.x)], 1u);
        const unsigned gen = old / nloc;
        if (old + 1u == (gen + 1u) * nloc) {
            __builtin_amdgcn_fence(__ATOMIC_RELEASE, "agent");
            asm volatile("s_waitcnt vmcnt(0)" ::: "memory");
            const unsigned og = xb_add(&bar[XB_TOP], 1u);
            const unsigned tg = og / nx;
            if (og + 1u == (tg + 1u) * nx) xb_add(&bar[XB_TOPGEN], 1u);
            else XB_SPIN(xb_ld(&bar[XB_TOPGEN]) == tg, bar);
            __builtin_amdgcn_fence(__ATOMIC_ACQUIRE, "agent");
            xb_add(&bar[XB_XGEN(b.x)], 1u);
            asm volatile("s_waitcnt vmcnt(0)" ::: "memory");
        } else {
            XB_SPIN(xb_ld(&bar[XB_XGEN(b.x)]) == gen, bar);
            __builtin_amdgcn_fence(__ATOMIC_ACQUIRE, "agent");
            asm volatile("s_waitcnt vmcnt(0)" ::: "memory");
        }
    }
    __syncthreads();
}

constexpr int LDS_BYTES = 147456;
__global__ void __launch_bounds__(512, 2) mega_fwd(Ptrs P) {
    extern __shared__ __attribute__((aligned(16))) unsigned char lds[];
    cg::grid_group grid = cg::this_grid();
    if (P.use_cg) grid.sync();
    unsigned char* ws = P.ws;
    PG8_LAS unsigned char* ldsp = (PG8_LAS unsigned char*)lds;
    const int NGW = gridDim.x * 8;
    volatile LAS unsigned* bst = (volatile LAS unsigned*)(ldsp + 143360);
    if (threadIdx.x == 0) { bst[0] = 0u; bst[1] = 0u; }
    __syncthreads();
    const XcdBarrier bar = xcd_barrier_post((unsigned*)(ws + WS_CTL), bst);
#define GRID_SYNC() xcd_barrier(bar)
#define FRESH_IDS() int tid_; asm volatile("v_mov_b32 %0, %1" : "=v"(tid_) : "v"(threadIdx.x)); const int lane = tid_ & 63, gw = blockIdx.x * 8 + (tid_ >> 6)
    ph_prologue(P, (float*)lds);
    { FRESH_IDS(); pass_prenorm(P.x, P.pre_mix_g, (bf16_t*)(ws + WS_XN), (float*)(ws + WS_CS + 512 * 1024), gw, NGW, lane); }
    GRID_SYNC();
    { pg8::Gemm g{(const bf16_t*)(ws + WS_XN), (const bf16_t*)(ws + WS_WIN), M, DINP, DM}; pg8::StaticOrder S; S.init(M, DINP, (int)gridDim.x, (int)blockIdx.x);
      pg8::gemm_phase<pg8::EpiInProjT, pg8::StaticOrder, true, true>(ldsp, g, S, pg8::EpiInProjT{ws}); }
    if (gridDim.x == 256 && blockIdx.x >= 128) convert_items(P, (float*)lds, I_CUT, I_ALL, (blockIdx.x - 128) * 8 + (threadIdx.x >> 6), 128 * 8);
    GRID_SYNC();
    attn_phase(P, (char*)lds);
    GRID_SYNC();
    { pg8::Gemm g{(const bf16_t*)(ws + WS_O), (const bf16_t*)(ws + WS_WOUT), M, DM, DM}; pg8::StaticOrder S; S.init(M, DM, (int)gridDim.x, (int)blockIdx.x);
      PG8_LAS float* T = (PG8_LAS float*)(ldsp + 139264);
      { pg8::Unit u; const float* SS = (const float*)(ws + WS_CS);
        for (int i = 0; i < 2; ++i) if (S.next(i, u) && threadIdx.x < 256) { const int row = u.pm * 256 + (int)threadIdx.x;
            const float ra = 1.0f / sqrtf(SS[row * 2] * (1.0f / 1024.f) + EPS), rb = 1.0f / sqrtf(SS[row * 2 + 1] * (1.0f / 1024.f) + EPS);
            T[(i * 256 + (int)threadIdx.x) * 2] = ra / rb; T[(i * 256 + (int)threadIdx.x) * 2 + 1] = rb; } }
      __syncthreads();
      pg8::gemm_phase<pg8::EpiOutT, pg8::StaticOrder, true, true>(ldsp, g, S, pg8::EpiOutT{(bf16_t*)(ws + WS_MIX), DM, T}); }
    GRID_SYNC();
    { FRESH_IDS(); pass_postmix((bf16_t*)(ws + WS_XN), (const float*)(ws + WS_CS + 512 * 1024), P.pre_mix_g, (const bf16_t*)(ws + WS_MIX), P.post_mix_g, P.pre_ffn_g, (float*)(ws + WS_CS + 256 * 1024), gw, NGW, lane); }
    GRID_SYNC();
    { pg8::Gemm g{(const bf16_t*)(ws + WS_XN), (const bf16_t*)(ws + WS_WUP), M, NUP, DM}; pg8::StaticOrder S; S.init(M, NUP, (int)gridDim.x, (int)blockIdx.x);
      pg8::gemm_phase<pg8::EpiUpT, pg8::StaticOrder, true, true>(ldsp, g, S, pg8::EpiUpT{(bf16_t*)(ws + WS_ACT), P.conv_w, P.conv_b, (float*)(ws + WS_SIDE), (PG8_LAS float*)(ldsp + 131072)}); }
    GRID_SYNC();
    ph_convfix((const float*)(ws + WS_SIDE), P.conv_w, P.conv_b, (bf16_t*)(ws + WS_ACT));
    GRID_SYNC();
    { pg8::Gemm g{(const bf16_t*)(ws + WS_ACT), (const bf16_t*)(ws + WS_WDN), M, DM, DFF}; pg8::StaticOrder S; S.init(M, DM, (int)gridDim.x, (int)blockIdx.x);
      pg8::gemm_phase<pg8::EpiBf16T, pg8::StaticOrder, true, true>(ldsp, g, S, pg8::EpiBf16T{(bf16_t*)(ws + WS_Y), DM}); }
    GRID_SYNC();
    { FRESH_IDS(); pass_final((const bf16_t*)(ws + WS_XN), (const float*)(ws + WS_CS + 256 * 1024), P.pre_ffn_g, (const bf16_t*)(ws + WS_Y), P.post_ffn_g, P.out, gw, NGW, lane); }
}

extern "C" void kernel_launch(void* const* d_in, const int* in_sizes, int n_in, void* d_out, int out_size, void* d_ws, size_t ws_size, hipStream_t stream) {
    if (n_in != 15 || ws_size < WS_END || out_size != M * DM) { fprintf(stderr, "kernel_launch: unexpected sizes n_in %d ws %zu out %d\n", n_in, ws_size, out_size); return; }
    static int grid_blocks = 0;
    if (!grid_blocks) {
        int dev = 0, cus = 0, per_cu = 0;
        hipGetDevice(&dev);
        hipDeviceGetAttribute(&cus, hipDeviceAttributeMultiprocessorCount, dev);
        if (hipFuncSetAttribute((const void*)mega_fwd, hipFuncAttributeMaxDynamicSharedMemorySize, LDS_BYTES) != hipSuccess) fprintf(stderr, "kernel_launch: hipFuncSetAttribute failed\n");
        hipOccupancyMaxActiveBlocksPerMultiprocessor(&per_cu, (const void*)mega_fwd, 512, LDS_BYTES);
        if (per_cu < 1) { fprintf(stderr, "kernel_launch: occupancy query gave %d\n", per_cu); per_cu = 1; }
        grid_blocks = cus * per_cu;
        if (grid_blocks != 256) fprintf(stderr, "kernel_launch: expected 256 resident workgroups, got %d (the output projection assumes two units per workgroup)\n", grid_blocks);
        (void)hipGetLastError();
    }
    Ptrs P{};
    const float** pp = (const float**)&P;
    for (int i = 0; i < 15; ++i) pp[i] = (const float*)d_in[i];
    P.out = (float*)d_out; P.ws = (unsigned char*)d_ws;
    P.use_cg = 0; P.pad = 0;
    if (hipMemsetAsync((char*)d_ws + WS_CTL, 0, CTL_BYTES, stream) != hipSuccess) { fprintf(stderr, "kernel_launch: hipMemsetAsync failed\n"); return; }
    void* args[] = {&P};
    hipError_t e = hipLaunchCooperativeKernel((const void*)mega_fwd, dim3(grid_blocks), dim3(512), args, LDS_BYTES, stream);
    if (e != hipSuccess) fprintf(stderr, "cooperative launch failed: %s (grid %d)\n", hipGetErrorString(e), grid_blocks);
}
```

```cpp
#include <hip/hip_runtime.h>
#include <hip/hip_cooperative_groups.h>
namespace cg = cooperative_groups;
#include <cstdio>
#include <cstdint>

constexpr int NB = 4, SEQ = 4096, DM = 2048, M = NB * SEQ;
constexpr int HD = 64, NHA = 16, NKVA = 2, NHB = 16, WIN = 128, DFF = 5632, NUP = 2 * DFF;
constexpr int DIN = 4368, DINP = 4608;
constexpr float EPS = 1e-6f;
constexpr float LOG2E = 1.4426950408889634f;
constexpr float C2 = 0.125f * LOG2E;

constexpr size_t MiB = 1u << 20;
constexpr size_t WS_WIN = 0, WS_WOUT = 18 * MiB, WS_WUP = 26 * MiB, WS_WDN = 70 * MiB;
constexpr size_t WS_XN = 92 * MiB;
constexpr size_t WS_CS = 156 * MiB, WS_F = 157 * MiB, WS_SIDE = 158 * MiB;
constexpr size_t WS_QA = 170 * MiB, WS_KA = 202 * MiB, WS_VA = 206 * MiB, WS_QB = 210 * MiB, WS_KB = 242 * MiB, WS_VB = 274 * MiB, WS_O = 306 * MiB;
constexpr size_t WS_ACT = 170 * MiB;
constexpr size_t WS_MIX = 370 * MiB, WS_Y = 434 * MiB;
constexpr size_t WS_CTL = 169 * MiB + 768 * 1024, CTL_BYTES = 64 * 1024;
constexpr size_t WS_END = 498 * MiB;

typedef unsigned short bf16_t;
typedef unsigned v4u __attribute__((ext_vector_type(4)));
typedef float f32x4 __attribute__((ext_vector_type(4)));

__device__ __forceinline__ unsigned f2bf(float f) { unsigned u = __builtin_bit_cast(unsigned, f); return (u + 0x7fffu + ((u >> 16) & 1u)) >> 16; }
__device__ __forceinline__ unsigned pk2(float lo, float hi) { return f2bf(lo) | (f2bf(hi) << 16); }
__device__ __forceinline__ float bf2f(unsigned h) { return __builtin_bit_cast(float, h << 16); }
__device__ __forceinline__ float wave_sum(float v) {
#pragma unroll
    for (int o = 1; o < 64; o <<= 1) v += __shfl_xor(v, o);
    return v;
}
__device__ __forceinline__ float wave_max(float v) {
#pragma unroll
    for (int o = 1; o < 64; o <<= 1) v = fmaxf(v, __shfl_xor(v, o));
    return v;
}

__device__ __forceinline__ int rowmap(int n, int map) {
    if (map == 0) return n;
    if (n < DFF) return ((n >> 7) << 8) + (n & 127);
    const int g = n - DFF; return ((g >> 7) << 8) + 128 + (g & 127);
}
__device__ __forceinline__ void transpose_item(const float* W, int K, int N, int Npad, bf16_t* WT, int map, float* scr, int item, int lane, const float* ks0 = nullptr, const float* ks1 = nullptr) {
    const int nblk = Npad / 32, kb = item / nblk, nb = item % nblk, k0 = 128 * kb, n0 = 32 * nb;
    { const int n4 = lane & 7, n = n0 + 4 * n4;
      f32x4 w[16];
#pragma unroll
      for (int i = 0; i < 16; ++i) { const int kk = (lane >> 3) + 8 * i; w[i] = (n < N) ? *(const f32x4*)(W + (size_t)(k0 + kk) * N + n) : (f32x4){0.f, 0.f, 0.f, 0.f}; }
#pragma unroll
      for (int i = 0; i < 16; ++i) { const int kk = (lane >> 3) + 8 * i;
          if (ks0) w[i] = w[i] * ((k0 < 1024) ? ks0[k0 + kk] : ks1[k0 + kk - 1024]);
#pragma unroll
          for (int j = 0; j < 4; ++j) scr[kk * 33 + 4 * n4 + j] = w[i][j]; } }
    __builtin_amdgcn_s_waitcnt(0); asm volatile("" ::: "memory");
    const int c = lane & 15;
#pragma unroll
    for (int j = 0; j < 8; ++j) { const int n = (lane >> 4) + 4 * j; const float* s = scr + (8 * c) * 33 + n;
        v4u o; o.x = pk2(s[0 * 33], s[1 * 33]); o.y = pk2(s[2 * 33], s[3 * 33]); o.z = pk2(s[4 * 33], s[5 * 33]); o.w = pk2(s[6 * 33], s[7 * 33]);
        *(v4u*)(WT + (size_t)rowmap(n0 + n, map) * K + k0 + 8 * c) = o; }
    __builtin_amdgcn_s_waitcnt(0); asm volatile("" ::: "memory");
}
struct Ptrs {
    const float *x, *pre_mix_g, *w_in, *b_forget, *sinks, *grp_swa_g, *grp_fox_g, *w_out, *post_mix_g, *pre_ffn_g, *w_up, *conv_w, *conv_b, *w_down, *post_ffn_g;
    float* out; unsigned char* ws;
    int use_cg, pad;
};
constexpr int I_IN = (DM / 128) * (DINP / 32), I_OUT = (DM / 128) * (DM / 32), I_UP = (DM / 128) * (NUP / 32), I_DN = (DFF / 128) * (DM / 32);
constexpr int I_CUT = I_IN + I_OUT, I_ALL = I_IN + I_OUT + I_UP + I_DN;
__device__ __forceinline__ void convert_items(const Ptrs& P, float* scr_all, int lo, int hi, int gw, int NGW) {
    const int tid = threadIdx.x, lane = tid & 63, wave = tid >> 6;
    float* scr = scr_all + wave * 128 * 33;
    for (int it = lo + gw; it < hi; it += NGW) {
        int r = it;
        if (r < I_IN) { transpose_item(P.w_in, DM, DIN, DINP, (bf16_t*)(P.ws + WS_WIN), 0, scr, r, lane); continue; } r -= I_IN;
        if (r < I_OUT) { transpose_item(P.w_out, DM, DM, DM, (bf16_t*)(P.ws + WS_WOUT), 0, scr, r, lane, P.grp_swa_g, P.grp_fox_g); continue; } r -= I_OUT;
        if (r < I_UP) { transpose_item(P.w_up, DM, NUP, NUP, (bf16_t*)(P.ws + WS_WUP), 1, scr, r, lane); continue; } r -= I_UP;
        transpose_item(P.w_down, DFF, DM, DM, (bf16_t*)(P.ws + WS_WDN), 0, scr, r, lane);
    }
}
__device__ __forceinline__ void ph_prologue(const Ptrs& P, float* scr_all) {
    const int tid = threadIdx.x;
    const bool defer = (gridDim.x == 256);
    convert_items(P, scr_all, 0, defer ? I_CUT : I_ALL, blockIdx.x * 8 + (tid >> 6), gridDim.x * 8);
    for (int i = blockIdx.x * 512 + tid; i < M * 2; i += gridDim.x * 512) ((float*)(P.ws + WS_CS))[i] = 0.f;
}

__device__ __forceinline__ void row_load(const float* row, int lane, f32x4 (&v)[8]) {
#pragma unroll
    for (int j = 0; j < 8; ++j) v[j] = ((const f32x4*)row)[lane + 64 * j];
}
__device__ __forceinline__ void row_load_bf16(const bf16_t* row, int lane, f32x4 (&v)[8]) {
#pragma unroll
    for (int j = 0; j < 8; ++j) { const unsigned long long w = ((const unsigned long long*)row)[lane + 64 * j];
        v[j] = (f32x4){bf2f((unsigned)w & 0xffffu), bf2f(((unsigned)w >> 16)), bf2f((unsigned)(w >> 32) & 0xffffu), bf2f((unsigned)(w >> 48))}; }
}
__device__ __forceinline__ float row_sumsq(const f32x4 (&v)[8]) {
    float s = 0.f;
#pragma unroll
    for (int j = 0; j < 8; ++j) s += (v[j].x * v[j].x + v[j].y * v[j].y) + (v[j].z * v[j].z + v[j].w * v[j].w);
    return wave_sum(s);
}
__device__ __forceinline__ void row_store_bf16(bf16_t* orow, int lane, const f32x4 (&v)[8]) {
#pragma unroll
    for (int j = 0; j < 8; ++j) ((unsigned long long*)orow)[lane + 64 * j] = (unsigned long long)pk2(v[j].x, v[j].y) | ((unsigned long long)pk2(v[j].z, v[j].w) << 32);
}
__device__ __forceinline__ void pass_prenorm(const float* x, const float* g, bf16_t* xn, float* r0s, int gw, int NGW, int lane) {
    f32x4 gv[8]; row_load(g, lane, gv);
    for (int m = gw; m < M; m += NGW) {
        f32x4 v[8]; row_load(x + (size_t)m * DM, lane, v);
        const float r = 1.0f / sqrtf(row_sumsq(v) * (1.0f / DM) + EPS);
#pragma unroll
        for (int j = 0; j < 8; ++j) v[j] = v[j] * r * gv[j];
        row_store_bf16(xn + (size_t)m * DM, lane, v);
        if (lane == 0) r0s[m] = r;
    }
}
__device__ __forceinline__ void pass_postmix(bf16_t* xn, const float* r0s, const float* gpm, const bf16_t* mix, const float* gpost, const float* gpre, float* r2s, int gw, int NGW, int lane) {
    f32x4 ig[8]; row_load(gpm, lane, ig);
#pragma unroll
    for (int j = 0; j < 8; ++j) { ig[j][0] = __builtin_amdgcn_rcpf(ig[j][0]); ig[j][1] = __builtin_amdgcn_rcpf(ig[j][1]); ig[j][2] = __builtin_amdgcn_rcpf(ig[j][2]); ig[j][3] = __builtin_amdgcn_rcpf(ig[j][3]); }
    for (int m = gw; m < M; m += NGW) {
        f32x4 v[8], xv[8], gv[8]; row_load_bf16(mix + (size_t)m * DM, lane, v); row_load_bf16(xn + (size_t)m * DM, lane, xv); row_load(gpost, lane, gv);
        const float ir0 = __builtin_amdgcn_rcpf(r0s[m]);
        const float r = 1.0f / sqrtf(row_sumsq(v) * (1.0f / DM) + EPS);
#pragma unroll
        for (int j = 0; j < 8; ++j) v[j] = xv[j] * ig[j] * ir0 + v[j] * r * gv[j];
        const float r2 = 1.0f / sqrtf(row_sumsq(v) * (1.0f / DM) + EPS);
        row_load(gpre, lane, gv);
#pragma unroll
        for (int j = 0; j < 8; ++j) v[j] = v[j] * r2 * gv[j];
        row_store_bf16(xn + (size_t)m * DM, lane, v);
        if (lane == 0) r2s[m] = r2;
    }
}
__device__ __forceinline__ void pass_final(const bf16_t* xn, const float* r2s, const float* gpre, const bf16_t* y, const float* g, float* out, int gw, int NGW, int lane) {
    f32x4 ig[8]; row_load(gpre, lane, ig);
#pragma unroll
    for (int j = 0; j < 8; ++j) { ig[j][0] = __builtin_amdgcn_rcpf(ig[j][0]); ig[j][1] = __builtin_amdgcn_rcpf(ig[j][1]); ig[j][2] = __builtin_amdgcn_rcpf(ig[j][2]); ig[j][3] = __builtin_amdgcn_rcpf(ig[j][3]); }
    f32x4 gv[8]; row_load(g, lane, gv);
    for (int m = gw; m < M; m += NGW) {
        f32x4 v[8], xv[8]; row_load_bf16(xn + (size_t)m * DM, lane, xv); row_load_bf16(y + (size_t)m * DM, lane, v);
        const float ir2 = __builtin_amdgcn_rcpf(r2s[m]);
        const float r = 1.0f / sqrtf(row_sumsq(v) * (1.0f / DM) + EPS);
#pragma unroll
        for (int j = 0; j < 8; ++j) ((f32x4*)(out + (size_t)m * DM))[lane + 64 * j] = xv[j] * ig[j] * ir2 + v[j] * r * gv[j];
    }
}
__device__ __forceinline__ float log_sigmoid(float z) { return z >= 0.f ? -log1pf(expf(-z)) : z - log1pf(expf(z)); }
__device__ __forceinline__ float gelu_tanh(float x) {
    const float z = 0.7978845608028654f * (x + 0.044715f * x * x * x);
    return x / (1.0f + exp2f(-2.0f * LOG2E * z));
}
namespace pg8 {
#define PG8_LAS __attribute__((address_space(3)))
typedef unsigned short bf16_t;
typedef short bf16x8 __attribute__((ext_vector_type(8)));
typedef float f32x4 __attribute__((ext_vector_type(4)));
typedef unsigned u32x4 __attribute__((ext_vector_type(4)));
constexpr int BM = 256, BK = 64, HALF = 128, HTB = HALF * BK * 2  , STAGE_BYTES = 8 * HTB, NXCD = 8, WGM = 8;

__host__ __device__ __forceinline__ int lds_byte(int r, int c) { const int st = (r >> 4) * 2 + (c >> 5), rr = r & 15, cc = c & 31, ob = rr * 64 + cc * 2; return st * 1024 + (ob ^ (((ob >> 9) & 1) << 5)); }
__host__ __device__ __forceinline__ void stage_rc(int b, int& R, int& C) { const int st = b / 1024, sb = b % 1024, swz = sb ^ (((sb >> 9) & 1) << 5); R = (st >> 1) * 16 + swz / 64; C = (st & 1) * 32 + (swz % 64) / 2; }
__host__ __device__ __forceinline__ int perm32(int rho) { const int n = rho >> 4, i = rho & 15; return 8 * (i >> 2) + 4 * n + (i & 3); }

struct Unit { int pm, pn; };
struct Gemm { const bf16_t* A; const bf16_t* Bt; int M, N, K; };

struct StaticOrder {
    int nM, nN, nwg, G, c;
    __host__ __device__ void init(int M, int N, int G_, int c_) { nM = M / BM; nN = N / BM; nwg = nM * nN; G = G_; c = c_; }
    __host__ __device__ bool next(int i, Unit& u) const {
        const long L = (long)i * G + c; if (L >= nwg) return false;
        int wgid = (int)L; { const int q = nwg / NXCD, r = nwg % NXCD, xcd = wgid % NXCD, off = wgid / NXCD; wgid = (xcd < r ? xcd * (q + 1) : r * (q + 1) + (xcd - r) * q) + off; }
        const int nig = WGM * nN, gid = wgid / nig, fm = gid * WGM, gsz = (nM - fm) < WGM ? (nM - fm) : WGM;
        u.pm = fm + ((wgid % nig) % gsz); u.pn = (wgid % nig) / gsz; return true;
    }
    __device__ __forceinline__ void a_ready(const Unit&) const {}
    __device__ __forceinline__ void done(const Unit&) const {}
};

__device__ __forceinline__ unsigned cvt_pk_bf16(float lo, float hi) { unsigned r; asm volatile("v_cvt_pk_bf16_f32 %0, %1, %2" : "=v"(r) : "v"(lo), "v"(hi)); return r; }
typedef float f32x2 __attribute__((ext_vector_type(2)));
template <class Epi, class Sched, bool ALIGN_EPI = false, bool SP2 = false>
__device__ __forceinline__ void gemm_phase(PG8_LAS unsigned char* lds, const Gemm g, const Sched& S, const Epi& E) {
    int tid = threadIdx.x; asm volatile("" : "+v"(tid));
    const int wid = __builtin_amdgcn_readfirstlane(tid >> 6), lane = tid & 63, wr = wid >> 2, wc = wid & 3, fr = lane & 15, fq = lane >> 4;
    const int K = g.K, nt = K / BK;
    unsigned voffA[2], voffB[2];
#pragma unroll
    for (int i = 0; i < 2; ++i) { int R, C; stage_rc(tid * 16 + i * 8192, R, C); const int Rb = Epi::PERM ? ((R & ~31) + perm32(R & 31)) : R;
        voffA[i] = (unsigned)(R * K + C) * 2u; voffB[i] = (unsigned)(Rb * K + C) * 2u; }
    const size_t kstep = (size_t)(BK * 2);
    const size_t hstep = (size_t)HALF * K * 2;
    const size_t tstep = 2 * hstep;
    const unsigned ldsw = (unsigned)wid * 1024u;
    const int aoff = lds_byte(wr * 64 + fr, fq * 8), boff = lds_byte(wc * 32 + fr, fq * 8);
#define PG8_SA(b, h) (((b) * 2 + (h)) * HTB)
#define PG8_SB(b, h) ((4 + (b) * 2 + (h)) * HTB)
    const unsigned ldsb = (unsigned)(uintptr_t)lds + ldsw;
#define PG8_STAGE(bufoff, gbase, voff) do { _Pragma("unroll") for (int _i = 0; _i < 2; ++_i) { unsigned keep_; \
        asm volatile("s_mov_b32 %0, m0\n\ts_mov_b32 m0, %3\n\ts_nop 0\n\tglobal_load_lds_dwordx4 %1, %2\n\ts_mov_b32 m0, %0" : "=&s"(keep_) \
                     : "v"((voff)[_i]), "s"((const char*)(gbase)), "s"((unsigned)__builtin_amdgcn_readfirstlane(ldsb + (unsigned)((bufoff) + _i * 8192))) : "memory"); } } while (0)
#define PG8_LDA(dst, b, h) do { _Pragma("unroll") for (int m = 0; m < 4; ++m) _Pragma("unroll") for (int k = 0; k < 2; ++k) dst[m][k] = *(const PG8_LAS bf16x8*)(lds + PG8_SA(b, h) + aoff + m * 2048 + k * 1024); } while (0)
#define PG8_LDB(dst, b, h) do { _Pragma("unroll") for (int n = 0; n < 2; ++n) _Pragma("unroll") for (int k = 0; k < 2; ++k) dst[n][k] = *(const PG8_LAS bf16x8*)(lds + PG8_SB(b, h) + boff + n * 2048 + k * 1024); } while (0)
#define PG8_MMA(ai, bj, At, Bt) do { __builtin_amdgcn_s_setprio(1); _Pragma("unroll") for (int m = 0; m < 4; ++m) _Pragma("unroll") for (int n = 0; n < 2; ++n) _Pragma("unroll") for (int k = 0; k < 2; ++k) \
        acc[ai][bj][m][n] = __builtin_amdgcn_mfma_f32_16x16x32_bf16(Bt[n][k], At[m][k], acc[ai][bj][m][n], 0, 0, 0); __builtin_amdgcn_s_setprio(0); } while (0)
#define PG8_WAIT_V(n) asm volatile("s_waitcnt vmcnt(" #n ")" ::: "memory")
#define PG8_WAIT_L(n) asm volatile("s_waitcnt lgkmcnt(" #n ")" ::: "memory")
#define PG8_BAR __builtin_amdgcn_s_barrier()
#define PG8_SCHED __builtin_amdgcn_sched_barrier(0)
    Unit cur, nxt; int ui = 0;
    if (!S.next(0, cur)) return;
    f32x4 acc[2][2][4][2];
#pragma unroll
    for (int a = 0; a < 2; ++a)
#pragma unroll
        for (int b = 0; b < 2; ++b)
#pragma unroll
            for (int m = 0; m < 4; ++m)
#pragma unroll
                for (int n = 0; n < 2; ++n) acc[a][b][m][n] = (f32x4){0.f, 0.f, 0.f, 0.f};
    bf16x8 At[4][2], B0[2][2], B1[2][2];
    const char* cA = (const char*)g.A + (size_t)cur.pm * tstep; const char* cB = (const char*)g.Bt + (size_t)cur.pn * tstep;
    S.a_ready(cur);
    if constexpr (SP2) {
        PG8_STAGE(PG8_SB(0, 0), cB, voffB); PG8_STAGE(PG8_SB(0, 1), cB + hstep, voffB); PG8_STAGE(PG8_SA(0, 0), cA, voffA); PG8_STAGE(PG8_SA(0, 1), cA + hstep, voffA);
        if (wr == 1) PG8_BAR;
        PG8_WAIT_V(2); PG8_BAR;
        PG8_STAGE(PG8_SB(1, 0), cB + kstep, voffB); PG8_STAGE(PG8_SA(1, 0), cA + kstep, voffA); PG8_STAGE(PG8_SB(1, 1), cB + hstep + kstep, voffB);
        PG8_WAIT_V(6); PG8_BAR;
    } else {
        PG8_STAGE(PG8_SB(0, 0), cB, voffB); PG8_STAGE(PG8_SA(0, 0), cA, voffA); PG8_STAGE(PG8_SB(0, 1), cB + hstep, voffB); PG8_STAGE(PG8_SA(0, 1), cA + hstep, voffA);
        if (wr == 1) PG8_BAR;
        PG8_WAIT_V(4); PG8_BAR;
        PG8_STAGE(PG8_SB(1, 0), cB + kstep, voffB); PG8_STAGE(PG8_SA(1, 0), cA + kstep, voffA); PG8_STAGE(PG8_SB(1, 1), cB + hstep + kstep, voffB);
        PG8_WAIT_V(6); PG8_BAR;
    }
    for (;;) {
        const bool has_next = S.next(ui + 1, nxt);
        const char* nA = has_next ? (const char*)g.A + (size_t)nxt.pm * tstep : cA; const char* nB = has_next ? (const char*)g.Bt + (size_t)nxt.pn * tstep : cB;
        for (int t = 0; t < nt; t += 2) {
            if constexpr (Epi::MIDK) { if (t == nt / 2) E.midk(acc, ui, wr, fr); }
            const bool last = (t == nt - 2);
            const char* a1 = cA + (size_t)(t + 1) * kstep;
            const char* a2 = last ? nA : cA + (size_t)(t + 2) * kstep; const char* b2 = last ? nB : cB + (size_t)(t + 2) * kstep;
            const char* a3 = a2 + kstep; const char* b3 = b2 + kstep;
            if (last && has_next) S.a_ready(nxt);
            if constexpr (SP2) {
            PG8_LDB(B0, 0, 0); PG8_LDB(B1, 0, 1); PG8_SCHED; PG8_LDA(At, 0, 0); PG8_STAGE(PG8_SA(1, 1), a1 + hstep, voffA);
            PG8_WAIT_V(8); PG8_WAIT_L(0); PG8_BAR; PG8_MMA(0, 0, At, B0); PG8_MMA(0, 1, At, B1); PG8_BAR; PG8_SCHED;
            PG8_LDA(At, 0, 1); PG8_STAGE(PG8_SB(0, 0), b2, voffB); PG8_STAGE(PG8_SB(0, 1), b2 + hstep, voffB); PG8_STAGE(PG8_SA(0, 0), a2, voffA);
            PG8_WAIT_V(8); PG8_WAIT_L(0); PG8_BAR; PG8_MMA(1, 0, At, B0); PG8_MMA(1, 1, At, B1); PG8_BAR; PG8_SCHED;
            PG8_LDB(B0, 1, 0); PG8_LDB(B1, 1, 1); PG8_SCHED; PG8_LDA(At, 1, 0); PG8_STAGE(PG8_SA(0, 1), a2 + hstep, voffA);
            PG8_WAIT_V(8); PG8_WAIT_L(0); PG8_BAR; PG8_MMA(0, 0, At, B0); PG8_MMA(0, 1, At, B1); PG8_BAR; PG8_SCHED;
            PG8_LDA(At, 1, 1); PG8_STAGE(PG8_SB(1, 0), b3, voffB); PG8_STAGE(PG8_SB(1, 1), b3 + hstep, voffB); PG8_STAGE(PG8_SA(1, 0), a3, voffA);
            PG8_WAIT_V(8); PG8_WAIT_L(0); PG8_BAR; PG8_MMA(1, 0, At, B0); PG8_MMA(1, 1, At, B1); PG8_BAR; PG8_SCHED;
            } else {
            PG8_LDB(B0, 0, 0); PG8_SCHED; PG8_LDA(At, 0, 0); PG8_STAGE(PG8_SA(1, 1), a1 + hstep, voffA);
            PG8_WAIT_L(8); PG8_BAR; PG8_WAIT_L(0); PG8_MMA(0, 0, At, B0); PG8_BAR; PG8_SCHED;
            PG8_LDB(B1, 0, 1); PG8_STAGE(PG8_SB(0, 0), b2, voffB);
            PG8_BAR; PG8_WAIT_L(0); PG8_MMA(0, 1, At, B1); PG8_BAR;
            PG8_LDA(At, 0, 1); PG8_STAGE(PG8_SA(0, 0), a2, voffA);
            PG8_BAR; PG8_WAIT_L(0); PG8_MMA(1, 0, At, B0); PG8_BAR; PG8_SCHED;
            PG8_STAGE(PG8_SB(0, 1), b2 + hstep, voffB);
            PG8_WAIT_V(6); PG8_BAR; PG8_MMA(1, 1, At, B1); PG8_BAR;
            PG8_LDB(B0, 1, 0); PG8_SCHED; PG8_LDA(At, 1, 0); PG8_STAGE(PG8_SA(0, 1), a2 + hstep, voffA);
            PG8_WAIT_L(8); PG8_BAR; PG8_WAIT_L(0); PG8_MMA(0, 0, At, B0); PG8_BAR; PG8_SCHED;
            PG8_LDB(B1, 1, 1); PG8_STAGE(PG8_SB(1, 0), b3, voffB);
            PG8_BAR; PG8_WAIT_L(0); PG8_MMA(0, 1, At, B1); PG8_BAR;
            PG8_LDA(At, 1, 1); PG8_STAGE(PG8_SA(1, 0), a3, voffA);
            PG8_BAR; PG8_WAIT_L(0); PG8_MMA(1, 0, At, B0); PG8_BAR; PG8_SCHED;
            PG8_STAGE(PG8_SB(1, 1), b3 + hstep, voffB);
            PG8_WAIT_V(6); PG8_BAR; PG8_MMA(1, 1, At, B1); PG8_BAR;
            }
        }
        if constexpr (ALIGN_EPI) { if (wr == 0) PG8_BAR; }
        if constexpr (Epi::MIDK) { E.epi(acc, cur, ui, wr, wc, fr, fq); S.done(cur); }
        else if constexpr (!Epi::AFTER_DRAIN) { E(acc, cur, wr, wc, fr, fq); S.done(cur); }
        if (!has_next) break;
#pragma unroll
        for (int a = 0; a < 2; ++a)
#pragma unroll
            for (int b = 0; b < 2; ++b)
#pragma unroll
                for (int m = 0; m < 4; ++m)
#pragma unroll
                    for (int n = 0; n < 2; ++n) acc[a][b][m][n] = (f32x4){0.f, 0.f, 0.f, 0.f};
        cur = nxt; cA = nA; cB = nB; ++ui;
        if constexpr (ALIGN_EPI) { if (wr == 1) PG8_BAR; }
    }
    PG8_WAIT_V(0);
    if constexpr (!ALIGN_EPI) { if (wr == 0) PG8_BAR; }
    PG8_BAR;
    if constexpr (Epi::AFTER_DRAIN) { E.fused(acc, cur, wr, wc, fr, fq, lds, wid, lane); S.done(cur); }
#undef PG8_SA
#undef PG8_SB
#undef PG8_STAGE
#undef PG8_LDA
#undef PG8_LDB
#undef PG8_MMA
#undef PG8_WAIT_V
#undef PG8_WAIT_L
#undef PG8_BAR
#undef PG8_SCHED
}
}

namespace pg8 {
struct EpiInProjT {
    static constexpr bool PERM = true, AFTER_DRAIN = false, MIDK = false;
    unsigned char* ws;
    __device__ __forceinline__ void operator()(const f32x4 (&acc)[2][2][4][2], const Unit& u, int wr, int wc, int fr, int fq) const {
        const int row0 = u.pm * BM + wr * 64 + fr, pn = u.pn, cin = wc * 32 + 8 * fq;
        if (pn == 17) {
            if (wc == 0 && fq < 2) { float* F = (float*)(ws + WS_F);
#pragma unroll
                for (int ai = 0; ai < 2; ++ai)
#pragma unroll
                    for (int m = 0; m < 4; ++m)
#pragma unroll
                        for (int n = 0; n < 2; ++n)
#pragma unroll
                            for (int j = 0; j < 4; ++j) F[(size_t)(8 * fq + 4 * n + j) * M + row0 + ai * HALF + m * 16] = acc[ai][0][m][n][j]; }
            return;
        }
        bf16_t *b0, *b1; int ldc; float sc = 1.f;
        if (pn < 4) { b0 = (bf16_t*)(ws + WS_QA) + pn * 256 + cin; b1 = b0 + HALF; ldc = 1024; sc = C2; }
        else if (pn == 4) { b0 = (bf16_t*)(ws + WS_KA) + cin; b1 = (bf16_t*)(ws + WS_VA) + cin; ldc = 128; }
        else if (pn < 9) { b0 = (bf16_t*)(ws + WS_QB) + (pn - 5) * 256 + cin; b1 = b0 + HALF; ldc = 1024; sc = C2; }
        else if (pn < 13) { b0 = (bf16_t*)(ws + WS_KB) + (pn - 9) * 256 + cin; b1 = b0 + HALF; ldc = 1024; }
        else { b0 = (bf16_t*)(ws + WS_VB) + (pn - 13) * 256 + cin; b1 = b0 + HALF; ldc = 1024; }
#pragma unroll
        for (int ai = 0; ai < 2; ++ai)
#pragma unroll
            for (int m = 0; m < 4; ++m) { const size_t ro = (size_t)(row0 + ai * HALF + m * 16) * ldc;
#pragma unroll
                for (int bj = 0; bj < 2; ++bj) { const f32x4 v0 = acc[ai][bj][m][0] * sc, v1 = acc[ai][bj][m][1] * sc;
                    u32x4 w; w.x = cvt_pk_bf16(v0[0], v0[1]); w.y = cvt_pk_bf16(v0[2], v0[3]); w.z = cvt_pk_bf16(v1[0], v1[1]); w.w = cvt_pk_bf16(v1[2], v1[3]);
                    *(u32x4*)((bj ? b1 : b0) + ro) = w; } }
    }
};
struct EpiBf16T {
    static constexpr bool PERM = true, AFTER_DRAIN = false, MIDK = false;
    bf16_t* C; int ldc;
    __device__ __forceinline__ void operator()(const f32x4 (&acc)[2][2][4][2], const Unit& u, int wr, int wc, int fr, int fq) const {
        const int row0 = u.pm * BM + wr * 64 + fr, col0 = u.pn * BM + wc * 32 + 8 * fq;
#pragma unroll
        for (int ai = 0; ai < 2; ++ai)
#pragma unroll
            for (int m = 0; m < 4; ++m) { bf16_t* rp = C + (size_t)(row0 + ai * HALF + m * 16) * ldc + col0;
#pragma unroll
                for (int bj = 0; bj < 2; ++bj) { const f32x4 v0 = acc[ai][bj][m][0], v1 = acc[ai][bj][m][1];
                    u32x4 w; w.x = cvt_pk_bf16(v0[0], v0[1]); w.y = cvt_pk_bf16(v0[2], v0[3]); w.z = cvt_pk_bf16(v1[0], v1[1]); w.w = cvt_pk_bf16(v1[2], v1[3]);
                    *(u32x4*)(rp + bj * HALF) = w; } }
    }
};
struct EpiOutT {
    static constexpr bool PERM = true, AFTER_DRAIN = false, MIDK = true;
    bf16_t* C; int ldc; const PG8_LAS float* T;
    __device__ __forceinline__ void midk(f32x4 (&acc)[2][2][4][2], int ui, int wr, int fr) const {
#pragma unroll
        for (int ai = 0; ai < 2; ++ai)
#pragma unroll
            for (int m = 0; m < 4; ++m) { const float r = T[((ui & 1) * 256 + ai * HALF + wr * 64 + m * 16 + fr) * 2];
#pragma unroll
                for (int bj = 0; bj < 2; ++bj)
#pragma unroll
                    for (int n = 0; n < 2; ++n) acc[ai][bj][m][n] *= r; }
    }
    __device__ __forceinline__ void epi(const f32x4 (&acc)[2][2][4][2], const Unit& u, int ui, int wr, int wc, int fr, int fq) const {
        const int row0 = u.pm * BM + wr * 64 + fr, col0 = u.pn * BM + wc * 32 + 8 * fq;
#pragma unroll
        for (int ai = 0; ai < 2; ++ai)
#pragma unroll
            for (int m = 0; m < 4; ++m) { bf16_t* rp = C + (size_t)(row0 + ai * HALF + m * 16) * ldc + col0; const float r = T[((ui & 1) * 256 + ai * HALF + wr * 64 + m * 16 + fr) * 2 + 1];
#pragma unroll
                for (int bj = 0; bj < 2; ++bj) { const f32x4 v0 = acc[ai][bj][m][0] * r, v1 = acc[ai][bj][m][1] * r;
                    u32x4 w; w.x = cvt_pk_bf16(v0[0], v0[1]); w.y = cvt_pk_bf16(v0[2], v0[3]); w.z = cvt_pk_bf16(v1[0], v1[1]); w.w = cvt_pk_bf16(v1[2], v1[3]);
                    *(u32x4*)(rp + bj * HALF) = w; } }
    }
};
}

namespace pg8 {
__device__ __forceinline__ float dpp_ror1(float x) { return __builtin_bit_cast(float, __builtin_amdgcn_mov_dpp(__builtin_bit_cast(int, x), 0x121, 0xf, 0xf, true)); }
__device__ __forceinline__ float dpp_ror2(float x) { return __builtin_bit_cast(float, __builtin_amdgcn_mov_dpp(__builtin_bit_cast(int, x), 0x122, 0xf, 0xf, true)); }
__device__ __forceinline__ float gelu_tanh_fast(float x) {
    const float e = __builtin_amdgcn_exp2f(-2.3022082f * x * (1.0f + 0.044715f * x * x));
    return x * __builtin_amdgcn_rcpf(1.0f + e);
}
__device__ __forceinline__ f32x4 geglu4(f32x4 g, f32x4 v) {
    const f32x4 t = (g * g) * 0.044715f + 1.0f, a = (g * -2.3022082f) * t;
    f32x4 e; e[0] = __builtin_amdgcn_exp2f(a[0]); e[1] = __builtin_amdgcn_exp2f(a[1]); e[2] = __builtin_amdgcn_exp2f(a[2]); e[3] = __builtin_amdgcn_exp2f(a[3]);
    e = e + 1.0f;
    f32x4 r; r[0] = __builtin_amdgcn_rcpf(e[0]); r[1] = __builtin_amdgcn_rcpf(e[1]); r[2] = __builtin_amdgcn_rcpf(e[2]); r[3] = __builtin_amdgcn_rcpf(e[3]);
    return (g * v) * r;
}
constexpr size_t SIDE_HEAD = 0, SIDE_TAIL = 6 * MiB;
struct EpiUpT {
    static constexpr bool PERM = true, AFTER_DRAIN = false, MIDK = false;
    bf16_t* act; const float* cw; const float* cb; float* side; PG8_LAS float* X;
    __device__ __forceinline__ void operator()(const f32x4 (&acc)[2][2][4][2], const Unit& u, int wr, int wc, int fr, int fq) const {
        const int cin = wc * 32 + 8 * fq;
        f32x4 Wt[2][2][4];
#define EPIUP_LOADW(n_) do { _Pragma("unroll") for (int bj_ = 0; bj_ < 2; ++bj_) { const int col_ = bj_ * DFF + HALF * u.pn + cin + 4 * (n_); \
            if ((n_) == 0) Wt[n_][bj_][0] = *(const f32x4*)(cw + col_); Wt[n_][bj_][1] = *(const f32x4*)(cw + NUP + col_); Wt[n_][bj_][2] = *(const f32x4*)(cw + 2 * NUP + col_); } } while (0)
#define EPIUP_LOADB(n_) do { _Pragma("unroll") for (int bj_ = 0; bj_ < 2; ++bj_) { Wt[n_][bj_][3] = *(const f32x4*)(cb + bj_ * DFF + HALF * u.pn + cin + 4 * (n_)); if ((n_) == 1) Wt[n_][bj_][0] = *(const f32x4*)(cw + bj_ * DFF + HALF * u.pn + cin + 4 * (n_)); } } while (0)
        EPIUP_LOADW(0); EPIUP_LOADB(0); EPIUP_LOADW(1);
        if (fr >= 14) {
#pragma unroll
            for (int ai = 0; ai < 2; ++ai)
#pragma unroll
                for (int bj = 0; bj < 2; ++bj)
#pragma unroll
                    for (int n = 0; n < 2; ++n) *(PG8_LAS f32x4*)(X + ((2 * ai + wr) * 2 + (fr - 14)) * 256 + bj * HALF + cin + 4 * n) = acc[ai][bj][3][n];
            if (wr == 1) {
#pragma unroll
                for (int bj = 0; bj < 2; ++bj)
#pragma unroll
                    for (int n = 0; n < 2; ++n) *(f32x4*)(side + SIDE_TAIL / 4 + ((size_t)u.pm * 2 + (fr - 14)) * NUP + u.pn * BM + bj * HALF + cin + 4 * n) = acc[1][bj][3][n];
            }
        }
        if (fr < 2 && wr == 0) {
#pragma unroll
            for (int bj = 0; bj < 2; ++bj)
#pragma unroll
                for (int n = 0; n < 2; ++n) *(f32x4*)(side + SIDE_HEAD / 4 + ((size_t)u.pm * 2 + fr) * NUP + u.pn * BM + bj * HALF + cin + 4 * n) = acc[0][bj][0][n];
        }
        asm volatile("s_waitcnt lgkmcnt(0)" ::: "memory"); __builtin_amdgcn_s_barrier(); asm volatile("" ::: "memory");
#pragma unroll
        for (int ai = 0; ai < 2; ++ai) {
            const int b4 = 2 * ai + wr;
            typedef unsigned u32x2v __attribute__((ext_vector_type(2)));
            u32x2v st[4];
#pragma unroll
            for (int n = 0; n < 2; ++n) {
                f32x4 p1[2], p2[2];
#pragma unroll
                for (int bj = 0; bj < 2; ++bj) {
                    f32x4 h62 = (f32x4){0.f, 0.f, 0.f, 0.f}, h63 = h62;
                    if (b4 > 0) { h62 = *(const PG8_LAS f32x4*)(X + ((b4 - 1) * 2 + 0) * 256 + bj * HALF + cin + 4 * n); h63 = *(const PG8_LAS f32x4*)(X + ((b4 - 1) * 2 + 1) * 256 + bj * HALF + cin + 4 * n); }
                    p1[bj] = h63; p2[bj] = (fr == 1) ? h63 : h62;
                }
#pragma unroll
                for (int m = 0; m < 4; ++m) {
                    f32x4 y[2];
#pragma unroll
                    for (int bj = 0; bj < 2; ++bj) {
                        const f32x4 v = acc[ai][bj][m][n];
                        f32x4 r1, r2;
#pragma unroll
                        for (int j = 0; j < 4; ++j) { r1[j] = dpp_ror1(v[j]); r2[j] = dpp_ror2(v[j]); }
                        const f32x4 q1 = (fr >= 1) ? r1 : p1[bj], q2 = (fr >= 2) ? r2 : p2[bj];
                        y[bj] = (Wt[n][bj][2] * v + Wt[n][bj][1] * q1) + (Wt[n][bj][0] * q2 + Wt[n][bj][3]);
                        p1[bj] = r1; p2[bj] = r2;
                    }
                    const f32x4 o4 = geglu4(y[0], y[1]); u32x2v w; w.x = cvt_pk_bf16(o4[0], o4[1]); w.y = cvt_pk_bf16(o4[2], o4[3]);
                    if (n == 0) st[m] = w;
                    else *(u32x4*)(act + (size_t)(u.pm * BM + ai * HALF + wr * 64 + m * 16 + fr) * DFF + HALF * u.pn + cin) = (u32x4){st[m].x, st[m].y, w.x, w.y};
                    __builtin_amdgcn_sched_barrier(0);
                }
                if (ai == 0 && n == 0) { EPIUP_LOADB(1); __builtin_amdgcn_sched_barrier(0); }
            }
            asm volatile("" ::: "memory"); __builtin_amdgcn_sched_barrier(0);
        }
#undef EPIUP_LOADW
#undef EPIUP_LOADB
    }
};
}
__device__ __forceinline__ void ph_convfix(const float* side, const float* cw, const float* cb, bf16_t* act) {
    const float* head = side + pg8::SIDE_HEAD / 4; const float* tail = side + pg8::SIDE_TAIL / 4;
    for (int idx = blockIdx.x * 512 + threadIdx.x; idx < 64 * 2 * DFF; idx += gridDim.x * 512) {
        const int pm = idx / (2 * DFF), r = (idx / DFF) & 1, n = idx % DFF;
        if ((pm & 15) == 0) continue;
        const int pg = ((n >> 7) << 8) + (n & 127);
        float y[2];
#pragma unroll
        for (int h = 0; h < 2; ++h) { const int pc = pg + 128 * h, col = h * DFF + n;
            const float H0 = head[((size_t)pm * 2 + 0) * NUP + pc], H1 = head[((size_t)pm * 2 + 1) * NUP + pc];
            const float T0 = tail[((size_t)(pm - 1) * 2 + 0) * NUP + pc], T1 = tail[((size_t)(pm - 1) * 2 + 1) * NUP + pc];
            const float w0 = cw[col], w1 = cw[NUP + col], w2 = cw[2 * NUP + col];
            y[h] = cb[col] + (r == 0 ? (w2 * H0 + w1 * T1 + w0 * T0) : (w2 * H1 + w1 * H0 + w0 * T1)); }
        act[(size_t)(256 * pm + r) * DFF + n] = (bf16_t)f2bf(gelu_tanh(y[0]) * y[1]);
    }
}
#include <hip/hip_bf16.h>
#include <cmath>
namespace attn_body {
using bf16=__hip_bfloat16;
using bf16x8=__attribute__((ext_vector_type(8)))short;
using s16x4=__attribute__((ext_vector_type(4)))short;
using f32x16=__attribute__((ext_vector_type(16)))float;
using u32x4=__attribute__((ext_vector_type(4)))unsigned;
using f32x4v=__attribute__((ext_vector_type(4)))float;
constexpr int BATCH=4,NHEAD=16,SEQ=4096,D=64,QP=1024,OP=2048;
constexpr int NW=8,QBLK=32,QB=QBLK*NW,KVBLK=64,NQB=SEQ/QB;
constexpr int ATTN_UNIT_ROWS=QB;
__device__ __forceinline__ int crow(int r,int hi){return (r&3)+8*(r>>2)+4*hi;}
#define SBAR() __builtin_amdgcn_sched_barrier(0)
template<bool WIN> __device__ __forceinline__ void amask(f32x16&p0,f32x16&p1,int koff,int qrel,int hi){
  const float NEG=-INFINITY; int d=qrel-(koff+4*hi); asm volatile("":"+v"(d));
  #pragma unroll
  for(int r=0;r<16;++r){const int kc=(r&3)+8*(r>>2);
    if(kc>d||(WIN&&kc<=d-128))p0[r]=NEG; if(kc+32>d||(WIN&&kc+32<=d-128))p1[r]=NEG;}
}

constexpr int NSLOT=3, SLOTB=8192;
constexpr int LDS_K=0, LDS_V=NSLOT*SLOTB, LDS_WS=2*NSLOT*SLOTB, LDS_OST=LDS_WS+NW*64*4, LDS_CL=LDS_OST+NW*4096+2048, LDS_CL2=LDS_CL+SEQ*4, LDS_WT=LDS_CL2+384*4, LDS_BYTES=LDS_WT+64;
constexpr float C2=0.125f*1.4426950408889634f;
__device__ __forceinline__ void glds16(const void*gsrc,unsigned lds_dst){unsigned keep;
  asm volatile("s_mov_b32 %0, m0\n\ts_mov_b32 m0, %2\n\ts_nop 0\n\tglobal_load_lds_dwordx4 %1, off\n\ts_mov_b32 m0, %0":"=&s"(keep):"v"(gsrc),"s"(lds_dst):"memory");}
__device__ __forceinline__ float max3f(float a,float b,float c){float r;asm("v_max3_f32 %0, %1, %2, %3":"=v"(r):"v"(a),"v"(b),"v"(c));return r;}
__device__ __forceinline__ float max2f(float a,float b){float r;asm("v_max_f32_e32 %0, %1, %2":"=v"(r):"v"(a),"v"(b));return r;}
__device__ __forceinline__ float fadd_s(float a,float b){float r;asm("v_add_f32_e32 %0, %1, %2":"=v"(r):"v"(a),"v"(b));return r;}
__device__ __forceinline__ float fsub_s(float a,float b){float r;asm("v_sub_f32_e32 %0, %1, %2":"=v"(r):"v"(a),"v"(b));return r;}
typedef float f32x2_t __attribute__((ext_vector_type(2))); typedef __bf16 bf16x2_t __attribute__((ext_vector_type(2)));
__device__ __forceinline__ unsigned cvtpk_s(float lo,float hi){f32x2_t v={lo,hi};bf16x2_t b=__builtin_convertvector(v,bf16x2_t);return __builtin_bit_cast(unsigned,b);}
#define WAIT_BAR(N) asm volatile("s_waitcnt vmcnt(" #N ") lgkmcnt(0)\n\ts_barrier":::"memory")

__device__ __forceinline__ void qkt(f32x16&p0,f32x16&p1,const char*Kslot,const bf16x8*qr,int r32,int hi){
  const char*kb=Kslot+hi*1024+r32*16;
  #pragma unroll
  for(int d0=0;d0<4;++d0){
    const bf16x8 b0=*reinterpret_cast<const bf16x8*>(kb+d0*2048);
    const bf16x8 b1=*reinterpret_cast<const bf16x8*>(kb+d0*2048+512);
    if(d0==0){p0=__builtin_amdgcn_mfma_f32_32x32x16_bf16(b0,qr[0],p0,0,0,0);p1=__builtin_amdgcn_mfma_f32_32x32x16_bf16(b1,qr[0],p1,0,0,0);}
    else{p0=__builtin_amdgcn_mfma_f32_32x32x16_bf16(b0,qr[d0],p0,0,0,0);p1=__builtin_amdgcn_mfma_f32_32x32x16_bf16(b1,qr[d0],p1,0,0,0);}}
}
typedef __attribute__((address_space(3))) const char* lds_cptr;
typedef short v4i16_t __attribute__((ext_vector_type(4)));
__device__ __forceinline__ void kload8(bf16x8*kf,lds_cptr kp){
  kf[0]=*(const __attribute__((address_space(3))) bf16x8*)(kp);      kf[1]=*(const __attribute__((address_space(3))) bf16x8*)(kp+512);
  kf[2]=*(const __attribute__((address_space(3))) bf16x8*)(kp+2048); kf[3]=*(const __attribute__((address_space(3))) bf16x8*)(kp+2560);
  kf[4]=*(const __attribute__((address_space(3))) bf16x8*)(kp+4096); kf[5]=*(const __attribute__((address_space(3))) bf16x8*)(kp+4608);
  kf[6]=*(const __attribute__((address_space(3))) bf16x8*)(kp+6144); kf[7]=*(const __attribute__((address_space(3))) bf16x8*)(kp+6656);
}
__device__ __forceinline__ void kload2(bf16x8*kf,lds_cptr kp,int j){ kf[2*j]=*(const __attribute__((address_space(3))) bf16x8*)(kp+j*2048); kf[2*j+1]=*(const __attribute__((address_space(3))) bf16x8*)(kp+j*2048+512); }
__device__ __forceinline__ s16x4 vtr(lds_cptr p){ return __builtin_bit_cast(s16x4,__builtin_amdgcn_ds_read_tr16_b64_v4i16((__attribute__((address_space(3))) v4i16_t*)p)); }
__device__ __forceinline__ float rowmax(const f32x16&p0,const f32x16&p1){
  float a=max3f(p0[0],p0[1],p1[0]),b=max3f(p0[2],p0[3],p1[1]);a=max3f(a,p1[2],p1[3]);
  #pragma unroll
  for(int r=4;r<16;r+=4){a=max3f(a,p0[r],p0[r+1]);b=max3f(b,p0[r+2],p0[r+3]);a=max3f(a,p1[r],p1[r+1]);b=max3f(b,p1[r+2],p1[r+3]);}
  const float m=max2f(a,b);
  auto rr=__builtin_amdgcn_permlane32_swap(__float_as_uint(m),__float_as_uint(m),false,false);
  return max2f(__uint_as_float(rr[0]),__uint_as_float(rr[1]));
}
__device__ __forceinline__ void pv(f32x16*o,int vb,bf16x8 pa0,bf16x8 pa1,bf16x8 pa2,bf16x8 pa3){
  #pragma unroll
  for(int d0=0;d0<2;++d0){s16x4 lo[4],hi[4];
    #pragma unroll
    for(int ks=0;ks<4;++ks){
      asm volatile("ds_read_b64_tr_b16 %0,%1 offset:%c2":"=&v"(lo[ks]):"v"(vb),"i"(d0*4096+ks*1024):"memory");
      asm volatile("ds_read_b64_tr_b16 %0,%1 offset:%c2":"=&v"(hi[ks]):"v"(vb),"i"(d0*4096+ks*1024+512):"memory");}
    asm volatile("s_waitcnt lgkmcnt(0)":::"memory");SBAR();
    #define PK(k) (bf16x8){lo[k][0],lo[k][1],lo[k][2],lo[k][3],hi[k][0],hi[k][1],hi[k][2],hi[k][3]}
    o[d0]=__builtin_amdgcn_mfma_f32_32x32x16_bf16(pa0,PK(0),o[d0],0,0,0);
    o[d0]=__builtin_amdgcn_mfma_f32_32x32x16_bf16(pa1,PK(1),o[d0],0,0,0);
    o[d0]=__builtin_amdgcn_mfma_f32_32x32x16_bf16(pa2,PK(2),o[d0],0,0,0);
    o[d0]=__builtin_amdgcn_mfma_f32_32x32x16_bf16(pa3,PK(3),o[d0],0,0,0);
    #undef PK
  }
}

#ifndef ATTN_STORE16
#define ATTN_STORE16(p,v) (*(u32x4*)(p)=(v))
#endif
template<int THRL,int MODE> __device__ __forceinline__ void attn_unit(int b,int h,int qb,const bf16*Q,const bf16*__restrict__ K,const bf16*__restrict__ V,int KP,int kvcol,bf16*O,int ocol,float*ssq,float slope_l2,float sink_l2,char*shm){
  int tid=threadIdx.x; asm volatile("":"+v"(tid));
  const int lane=tid&63,r32=lane&31,hi=lane>>5; const int wid=__builtin_amdgcn_readfirstlane(tid>>6);
  const long rowbase=(long)b*SEQ; const int q0=qb*QB;
  const int t0=(MODE==0)?((qb>0)?4*qb-2:0):0;
  const bf16*Qw=Q+(rowbase+q0+wid*QBLK)*QP+h*D;
  const bf16*Kh=K+(rowbase+(long)t0*KVBLK)*KP+kvcol,*Vh=V+(rowbase+(long)t0*KVBLK)*KP+kvcol;
  const unsigned lds0=(unsigned)(uintptr_t)shm;
  float*wsf=(float*)(shm+LDS_WS)+wid*64;
  const bf16*ksrc=Kh+(long)lane*KP+wid*8;
  const bf16*vsrc=Vh+(long)(16*(wid&3)+(lane>>2))*KP+(wid>>2)*32+(lane&3)*8;
  const unsigned kdst=lds0+LDS_K+wid*1024, vdst=lds0+LDS_V+wid*1024;
  #define DMA_K(t,slot) glds16(ksrc+(long)(t)*KVBLK*KP,(unsigned)__builtin_amdgcn_readfirstlane(kdst+(slot)))
  #define DMA_V(t,slot) glds16(vsrc+(long)(t)*KVBLK*KP,(unsigned)__builtin_amdgcn_readfirstlane(vdst+(slot)))
  const int vb0=(int)(lds0+LDS_V)+((lane>>4)&1)*32+(lane&3)*8+(4*hi+((lane&15)>>2))*64;
  const char*Kbase=shm+LDS_K; bf16x8 kf[8];
  const lds_cptr shm3=(lds_cptr)shm; const lds_cptr kp0=shm3+LDS_K+hi*1024+r32*16; const lds_cptr vp0=shm3+LDS_V+((lane>>4)&1)*32+(lane&3)*8+(4*hi+((lane&15)>>2))*64;
  const int NT=(MODE==0)?((qb>0)?6:4):(q0+QB)/KVBLK;
  typedef __attribute__((address_space(3))) float* lds_fptr;
  const lds_fptr cl=(lds_fptr)((lds_cptr)shm+((MODE==1)?LDS_CL:LDS_CL2));
  if(MODE==0){ if(tid<384)cl[tid]=-slope_l2*(float)tid; }
  DMA_K(0,0);DMA_V(0,0);DMA_K(1,SLOTB);
  bf16x8 qr[4];
  #pragma unroll
  for(int d0=0;d0<4;++d0)qr[d0]=*reinterpret_cast<const bf16x8*>(&Qw[(long)r32*QP+d0*16+hi*8]);
  float mhat=0.f,l_reg=0.f;f32x16 o[2];o[0]=f32x16{};o[1]=f32x16{};
  const int qrel=wid*QBLK+r32;
  asm volatile("s_waitcnt lgkmcnt(0)\n\ts_barrier":::"memory");
  const float ct=cl[q0-t0*KVBLK+qrel];
  float nm=ct;
  #define CINIT(I0,I1,t) do{ const lds_fptr cp_=cl+64*(t)+4*hi; _Pragma("unroll") for(int g_=0;g_<4;++g_){ \
      const f32x4v a_=*(const __attribute__((address_space(3))) f32x4v*)(cp_+8*g_), b_=*(const __attribute__((address_space(3))) f32x4v*)(cp_+8*g_+32); \
      _Pragma("unroll") for(int j_=0;j_<4;++j_){ I0[4*g_+j_]=nm-a_[j_]; I1[4*g_+j_]=nm-b_[j_]; } SBAR(); } }while(0)
  #define CMASK(P0,P1,t) do{int ko_=64*((t)-(NT-4)); if(MODE==0||ko_>=0)amask<MODE==0>(P0,P1,ko_,qrel,hi);}while(0)
  bool resc=false;
  #define START(P0,P1) do{ const float rm=rowmax(P0,P1); resc=false; \
    { const float dl=__builtin_fmaxf(rm,-1000.f); mhat=fadd_s(mhat,dl); \
      _Pragma("unroll") for(int r=0;r<16;++r){P0[r]=fsub_s(P0[r],dl);P1[r]=fsub_s(P1[r],dl);} \
      nm=ct-mhat; } \
    _Pragma("unroll") for(int r=0;r<16;++r)P0[r]=__builtin_amdgcn_exp2f(P0[r]); }while(0)
  #define RESC() do{ if(resc){ asm volatile("s_waitcnt lgkmcnt(0)":::"memory"); \
      _Pragma("unroll") for(int d_=0;d_<2;++d_) _Pragma("unroll") for(int r=0;r<16;++r)o[d_][r]*=wsf[crow(r,hi)]; } }while(0)
  f32x16 pA0,pA1,pB0,pB1;
  int sl_prev=0,sl_cur=0,sl_next=SLOTB;
  #define ROT() do{sl_prev=sl_cur;sl_cur=sl_next;sl_next=(sl_next==(NSLOT-1)*SLOTB)?0:sl_next+SLOTB;}while(0)
  DMA_K(2,2*SLOTB);
  WAIT_BAR(3);
  CINIT(pA0,pA1,0); qkt(pA0,pA1,Kbase,qr,r32,hi);asm volatile("s_nop 15\n\ts_nop 7":"+v"(pA0),"+v"(pA1));CMASK(pA0,pA1,0);
  START(pA0,pA1);
  _Pragma("unroll") for(int r=0;r<16;++r)pA1[r]=__builtin_amdgcn_exp2f(pA1[r]);
  WAIT_BAR(0);
  DMA_K(3,0);DMA_V(1,SLOTB);
  ROT();
  kload8(kf,kp0+sl_cur);
  WAIT_BAR(2);
  s16x4 vlo[8],vhi[8]; u32x4 pw0,pw1,pw2,pw3;
  #define PKW(P,B) cvtpk_s(P[B],P[B+1])
  #define PAF(k) __builtin_bit_cast(bf16x8,pw##k)
  #define VFR(i) (bf16x8){vlo[i][0],vlo[i][1],vlo[i][2],vlo[i][3],vhi[i][0],vhi[i][1],vhi[i][2],vhi[i][3]}
  #define PIN(x) asm volatile("":"+v"(x))
  #define MX3(a,b,c) __builtin_fmaxf(__builtin_fmaxf((a),(b)),(c))
  #define GAPA(MF,A0,A1,A2,A3,W0,W1,PW) do{ MF; sacc+=A0; sacc+=A1; sacc+=A2; sacc+=A3; PIN(sacc); W0; W1; PIN(PW); SBAR(); }while(0)
  #define EX(v) __builtin_amdgcn_exp2f(v)
  #define GAPB(MF,X,B) do{ MF; X[B]=EX(X[B]); X[B+1]=EX(X[B+1]); X[B+2]=EX(X[B+2]); X[B+3]=EX(X[B+3]); PIN(X); SBAR(); }while(0)
  #define VRD(i) do{ vlo[i]=vtr(vp_+(((i)>>2)*4096+((i)&3)*1024)); vhi[i]=vtr(vp_+(((i)>>2)*4096+((i)&3)*1024+512)); }while(0)
  #define KRD(G,j) do{ if(G){ kload2(kf,kp0+sl_next,j); SBAR(); } }while(0)
  #define STEP(C0,C1,P0,P1,t,GK,GV,GL) do{ SBAR(); CINIT(C0,C1,t); SBAR(); \
    const lds_cptr vp_=vp0+sl_prev; \
    VRD(0); SBAR(); float sacc=(P0[0]+P0[1]); \
    GAPA(C0=__builtin_amdgcn_mfma_f32_32x32x16_bf16(kf[0],qr[0],C0,0,0,0), P0[2],P0[3],P0[4],P0[5],     pw0[0]=PKW(P0,0), pw0[1]=PKW(P0,2), pw0); \
    VRD(4); SBAR(); GAPA(C1=__builtin_amdgcn_mfma_f32_32x32x16_bf16(kf[1],qr[0],C1,0,0,0), P0[6],P0[7],P0[8],P0[9],     pw0[2]=PKW(P0,4), pw0[3]=PKW(P0,6), pw0); \
    VRD(1); SBAR(); GAPA(C0=__builtin_amdgcn_mfma_f32_32x32x16_bf16(kf[2],qr[1],C0,0,0,0),   P0[10],P0[11],P0[12],P0[13], pw1[0]=PKW(P0,8), pw1[1]=PKW(P0,10), pw1); \
    VRD(5); SBAR(); GAPA(C1=__builtin_amdgcn_mfma_f32_32x32x16_bf16(kf[3],qr[1],C1,0,0,0),   P0[14],P0[15],P1[0],P1[1],   pw1[2]=PKW(P0,12),pw1[3]=PKW(P0,14), pw1); \
    VRD(2); SBAR(); GAPA(C0=__builtin_amdgcn_mfma_f32_32x32x16_bf16(kf[4],qr[2],C0,0,0,0),   P1[2],P1[3],P1[4],P1[5],     pw2[0]=PKW(P1,0), pw2[1]=PKW(P1,2), pw2); \
    VRD(6); SBAR(); GAPA(C1=__builtin_amdgcn_mfma_f32_32x32x16_bf16(kf[5],qr[2],C1,0,0,0),   P1[6],P1[7],P1[8],P1[9],     pw2[2]=PKW(P1,4), pw2[3]=PKW(P1,6), pw2); \
    VRD(3); SBAR(); GAPA(C0=__builtin_amdgcn_mfma_f32_32x32x16_bf16(kf[6],qr[3],C0,0,0,0),   P1[10],P1[11],P1[12],P1[13], pw3[0]=PKW(P1,8), pw3[1]=PKW(P1,10), pw3); \
    VRD(7); SBAR(); GAPA(C1=__builtin_amdgcn_mfma_f32_32x32x16_bf16(kf[7],qr[3],C1,0,0,0),   P1[14],P1[15],0.f,0.f,       pw3[2]=PKW(P1,12),pw3[3]=PKW(P1,14), pw3); \
    l_reg+=sacc; \
    if(GK){DMA_K((t)+3,sl_cur);} if(GV){DMA_V((t)+1,sl_next);} \
    CMASK(C0,C1,t); \
    { float a=MX3(C0[0],C0[1],C1[0]),b=MX3(C0[2],C0[3],C1[1]); a=MX3(a,C1[2],C1[3]); \
      _Pragma("unroll") for(int r=4;r<16;r+=4){a=MX3(a,C0[r],C0[r+1]);b=MX3(b,C0[r+2],C0[r+3]);a=MX3(a,C1[r],C1[r+1]);b=MX3(b,C1[r+2],C1[r+3]);} \
      float rm=__builtin_fmaxf(a,b); { auto rr=__builtin_amdgcn_permlane32_swap(__float_as_uint(rm),__float_as_uint(rm),false,false); rm=__builtin_fmaxf(__uint_as_float(rr[0]),__uint_as_float(rr[1])); } \
      resc=false; \
      if(__builtin_expect(__any(rm>(float)THRL),0)){ const float dl=__builtin_fmaxf(rm,0.f); mhat+=dl; \
        _Pragma("unroll") for(int r=0;r<16;++r){C0[r]-=dl;C1[r]-=dl;} \
        nm=ct-mhat; \
        const float f=__builtin_amdgcn_exp2f(-dl); l_reg*=f; if(hi==0)wsf[r32]=f; resc=true; } } \
    SBAR(); \
    GAPB(o[0]=__builtin_amdgcn_mfma_f32_32x32x16_bf16(PAF(0),VFR(0),o[0],0,0,0), C0,0); \
    GAPB(o[1]=__builtin_amdgcn_mfma_f32_32x32x16_bf16(PAF(0),VFR(4),o[1],0,0,0), C0,4); \
    KRD(GL,0); GAPB(o[0]=__builtin_amdgcn_mfma_f32_32x32x16_bf16(PAF(1),VFR(1),o[0],0,0,0), C0,8); \
    KRD(GL,1); GAPB(o[1]=__builtin_amdgcn_mfma_f32_32x32x16_bf16(PAF(1),VFR(5),o[1],0,0,0), C0,12); \
    KRD(GL,2); GAPB(o[0]=__builtin_amdgcn_mfma_f32_32x32x16_bf16(PAF(2),VFR(2),o[0],0,0,0), C1,0); \
    KRD(GL,3); GAPB(o[1]=__builtin_amdgcn_mfma_f32_32x32x16_bf16(PAF(2),VFR(6),o[1],0,0,0), C1,4); \
    GAPB(o[0]=__builtin_amdgcn_mfma_f32_32x32x16_bf16(PAF(3),VFR(3),o[0],0,0,0), C1,8); \
    GAPB(o[1]=__builtin_amdgcn_mfma_f32_32x32x16_bf16(PAF(3),VFR(7),o[1],0,0,0), C1,12); \
    }while(0)
  #define ACT(tt) ((64*((tt)-(NT-4))+63>=32*wid-127)&&(64*((tt)-(NT-4))<=32*wid+31))
  #define STEPW(C0,C1,P0,P1,t,GK,GV,GL) do{ SBAR(); \
    const bool aq_=ACT(t), ap_=ACT((t)-1); \
    const lds_cptr vp_=vp0+sl_prev; \
    if(ap_){ VRD(0);VRD(4);VRD(1);VRD(5);VRD(2);VRD(6);VRD(3);VRD(7); \
      float sacc=(P0[0]+P0[1]); _Pragma("unroll") for(int r=2;r<16;++r)sacc+=P0[r]; _Pragma("unroll") for(int r=0;r<16;++r)sacc+=P1[r]; l_reg+=sacc; \
      pw0=(u32x4){PKW(P0,0),PKW(P0,2),PKW(P0,4),PKW(P0,6)};pw1=(u32x4){PKW(P0,8),PKW(P0,10),PKW(P0,12),PKW(P0,14)};pw2=(u32x4){PKW(P1,0),PKW(P1,2),PKW(P1,4),PKW(P1,6)};pw3=(u32x4){PKW(P1,8),PKW(P1,10),PKW(P1,12),PKW(P1,14)}; } \
    SBAR(); \
    if(aq_){ CINIT(C0,C1,t); \
      C0=__builtin_amdgcn_mfma_f32_32x32x16_bf16(kf[0],qr[0],C0,0,0,0); C1=__builtin_amdgcn_mfma_f32_32x32x16_bf16(kf[1],qr[0],C1,0,0,0); \
      C0=__builtin_amdgcn_mfma_f32_32x32x16_bf16(kf[2],qr[1],C0,0,0,0); C1=__builtin_amdgcn_mfma_f32_32x32x16_bf16(kf[3],qr[1],C1,0,0,0); \
      C0=__builtin_amdgcn_mfma_f32_32x32x16_bf16(kf[4],qr[2],C0,0,0,0); C1=__builtin_amdgcn_mfma_f32_32x32x16_bf16(kf[5],qr[2],C1,0,0,0); \
      C0=__builtin_amdgcn_mfma_f32_32x32x16_bf16(kf[6],qr[3],C0,0,0,0); C1=__builtin_amdgcn_mfma_f32_32x32x16_bf16(kf[7],qr[3],C1,0,0,0); } \
    if(GK){DMA_K((t)+3,sl_cur);} if(GV){DMA_V((t)+1,sl_next);} \
    resc=false; \
    if(aq_){ CMASK(C0,C1,t); \
      float a=MX3(C0[0],C0[1],C1[0]),b=MX3(C0[2],C0[3],C1[1]); a=MX3(a,C1[2],C1[3]); \
      _Pragma("unroll") for(int r=4;r<16;r+=4){a=MX3(a,C0[r],C0[r+1]);b=MX3(b,C0[r+2],C0[r+3]);a=MX3(a,C1[r],C1[r+1]);b=MX3(b,C1[r+2],C1[r+3]);} \
      float rm=__builtin_fmaxf(a,b); { auto rr=__builtin_amdgcn_permlane32_swap(__float_as_uint(rm),__float_as_uint(rm),false,false); rm=__builtin_fmaxf(__uint_as_float(rr[0]),__uint_as_float(rr[1])); } \
      if(__builtin_expect(__any(rm>(float)THRL),0)){ const float dl=__builtin_fmaxf(rm,0.f); mhat+=dl; \
        _Pragma("unroll") for(int r=0;r<16;++r){C0[r]-=dl;C1[r]-=dl;} \
        nm=ct-mhat; \
        const float f=__builtin_amdgcn_exp2f(-dl); l_reg*=f; if(hi==0)wsf[r32]=f; resc=true; } } \
    SBAR(); \
    if(ap_){ \
      o[0]=__builtin_amdgcn_mfma_f32_32x32x16_bf16(PAF(0),VFR(0),o[0],0,0,0); o[1]=__builtin_amdgcn_mfma_f32_32x32x16_bf16(PAF(0),VFR(4),o[1],0,0,0); \
      o[0]=__builtin_amdgcn_mfma_f32_32x32x16_bf16(PAF(1),VFR(1),o[0],0,0,0); o[1]=__builtin_amdgcn_mfma_f32_32x32x16_bf16(PAF(1),VFR(5),o[1],0,0,0); \
      o[0]=__builtin_amdgcn_mfma_f32_32x32x16_bf16(PAF(2),VFR(2),o[0],0,0,0); o[1]=__builtin_amdgcn_mfma_f32_32x32x16_bf16(PAF(2),VFR(6),o[1],0,0,0); \
      o[0]=__builtin_amdgcn_mfma_f32_32x32x16_bf16(PAF(3),VFR(3),o[0],0,0,0); o[1]=__builtin_amdgcn_mfma_f32_32x32x16_bf16(PAF(3),VFR(7),o[1],0,0,0); } \
    if((GL)&&ACT((t)+1)){ kload2(kf,kp0+sl_next,0); kload2(kf,kp0+sl_next,1); kload2(kf,kp0+sl_next,2); kload2(kf,kp0+sl_next,3); } \
    if(aq_){ _Pragma("unroll") for(int r=0;r<16;++r){C0[r]=EX(C0[r]);C1[r]=EX(C1[r]);} } else { C0=f32x16{}; C1=f32x16{}; } \
    SBAR(); \
    }while(0)
  #define STEPX(C0,C1,P0,P1,t,GK,GV,GL) do{ if(MODE==0){ STEPW(C0,C1,P0,P1,t,GK,GV,GL); } else { STEP(C0,C1,P0,P1,t,GK,GV,GL); } }while(0)
  int t=1;
  #undef CMASK
  #define CMASK(P0,P1,t) do{}while(0)
  for(;t+5<NT;t+=2){
    STEP(pB0,pB1,pA0,pA1,t,true,true,true);     WAIT_BAR(2); RESC(); ROT();
    STEP(pA0,pA1,pB0,pB1,t+1,true,true,true);   WAIT_BAR(2); RESC(); ROT();
  }
  #undef CMASK
  #define CMASK(P0,P1,t) do{int ko_=64*((t)-(NT-4)); if(MODE==0||ko_>=0)amask<MODE==0>(P0,P1,ko_,qrel,hi);}while(0)
  #define ENDW(tt) do{ if((tt)+3<NT){WAIT_BAR(2);} else if((tt)+2<NT){WAIT_BAR(1);} else {WAIT_BAR(0);} }while(0)
  for(;t+1<NT;t+=2){
    STEPX(pB0,pB1,pA0,pA1,t,(t+3<NT),(t+1<NT),(t+1<NT));       ENDW(t);   RESC(); ROT();
    STEPX(pA0,pA1,pB0,pB1,t+1,(t+4<NT),(t+2<NT),(t+2<NT));     ENDW(t+1); RESC(); ROT();
  }
  STEPX(pB0,pB1,pA0,pA1,NT-1,false,false,false); RESC();
  if(MODE==1||ACT(NT-1))
  { float sacc=pB0[0]+pB0[1]; _Pragma("unroll") for(int r=2;r<16;++r)sacc+=pB0[r]; _Pragma("unroll") for(int r=0;r<16;++r)sacc+=pB1[r]; l_reg+=sacc;
    pw0=(u32x4){PKW(pB0,0),PKW(pB0,2),PKW(pB0,4),PKW(pB0,6)};pw1=(u32x4){PKW(pB0,8),PKW(pB0,10),PKW(pB0,12),PKW(pB0,14)};pw2=(u32x4){PKW(pB1,0),PKW(pB1,2),PKW(pB1,4),PKW(pB1,6)};pw3=(u32x4){PKW(pB1,8),PKW(pB1,10),PKW(pB1,12),PKW(pB1,14)};
    SBAR(); pv(o,vb0+sl_cur,PAF(0),PAF(1),PAF(2),PAF(3)); }
  #undef PKW
  #undef PAF
  #undef VFR
  #undef PIN
  #undef MX3
  #undef GAPA
  #undef GAPB
  #undef EX
  #undef VRD
  #undef KRD
  #undef STEP
  #undef ENDW
  #undef STEPX
  #undef STEPW
  #undef ACT
  {auto rr=__builtin_amdgcn_permlane32_swap(__float_as_uint(l_reg),__float_as_uint(l_reg),false,false);l_reg=__uint_as_float(rr[0])+__uint_as_float(rr[1]);}
  if(MODE==0)l_reg+=__builtin_amdgcn_exp2f(sink_l2-mhat);
  if(hi==0)wsf[32+r32]=l_reg;asm volatile("s_waitcnt lgkmcnt(0)":::"memory");
  float rli[16];
  #pragma unroll
  for(int r=0;r<16;++r)rli[r]=__builtin_amdgcn_rcpf(wsf[32+crow(r,hi)]);
  bf16*Ow=O+(rowbase+q0+wid*QBLK)*OP+ocol;
  { bf16*stg=(bf16*)(shm+LDS_OST)+wid*2048;
    #pragma unroll
    for(int r=0;r<16;++r){const int orow=crow(r,hi);
      #pragma unroll
      for(int d0=0;d0<2;++d0)stg[orow*64+d0*32+r32]=__float2bfloat16(o[d0][r]*rli[r]);}
    asm volatile("s_waitcnt lgkmcnt(0)":::"memory");
    #pragma unroll
    for(int i=0;i<4;++i){const int row=i*8+(lane>>3),ch=lane&7; const u32x4 v=*(const u32x4*)(stg+row*64+ch*8); ATTN_STORE16(Ow+(long)row*OP+ch*8,v);
      float ss=0.f;
      #pragma unroll
      for(int e=0;e<4;++e){const float lo=__builtin_bit_cast(float,v[e]<<16),hh=__builtin_bit_cast(float,v[e]&0xffff0000u); ss+=lo*lo+hh*hh;}
      ss+=__shfl_xor(ss,1); ss+=__shfl_xor(ss,2); ss+=__shfl_xor(ss,4);
      if(ch==0)__hip_atomic_fetch_add(ssq+(rowbase+q0+wid*QBLK+row)*2+MODE,ss,__ATOMIC_RELAXED,__HIP_MEMORY_SCOPE_AGENT); } }
  asm volatile("s_waitcnt lgkmcnt(0)\n\ts_barrier":::"memory");
  #undef CINIT
  #undef DMA_K
  #undef DMA_V
  #undef CMASK
  #undef START
  #undef RESC
  #undef ROT
}
constexpr int ATTN_LDS_BYTES=LDS_BYTES;
#undef SBAR
#undef WAIT_BAR
}

__device__ __forceinline__ void fox_cumsum(const float* Ft, float bias, int b, int h, char* lds) {
    typedef __attribute__((address_space(3))) float* lds_fptr; typedef __attribute__((address_space(3))) const char* lds_cptr;
    const lds_fptr cl = (lds_fptr)((lds_cptr)lds + attn_body::LDS_CL), wt = (lds_fptr)((lds_cptr)lds + attn_body::LDS_WT);
    int tid = threadIdx.x; asm volatile("" : "+v"(tid));
    const int lane = tid & 63, wave = tid >> 6;
    const f32x4* f = (const f32x4*)(Ft + (size_t)h * M + (size_t)b * SEQ + 8 * tid);
    const f32x4 a = f[0], c = f[1];
    float v[8] = {a[0], a[1], a[2], a[3], c[0], c[1], c[2], c[3]};
#pragma unroll
    for (int k = 0; k < 8; ++k) v[k] = log_sigmoid(v[k] + bias);
#pragma unroll
    for (int k = 1; k < 8; ++k) v[k] += v[k - 1];
    float inc = v[7];
#pragma unroll
    for (int o = 1; o < 64; o <<= 1) { const float t = __shfl_up(inc, o); if (lane >= o) inc += t; }
    if (lane == 63) wt[wave] = inc;
    __syncthreads();
    float base = inc - v[7];
#pragma unroll
    for (int w = 0; w < 8; ++w) if (w < wave) base += wt[w];
    *(__attribute__((address_space(3))) f32x4*)(cl + 8 * tid) = (f32x4){(v[0] + base) * LOG2E, (v[1] + base) * LOG2E, (v[2] + base) * LOG2E, (v[3] + base) * LOG2E};
    *(__attribute__((address_space(3))) f32x4*)(cl + 8 * tid + 4) = (f32x4){(v[4] + base) * LOG2E, (v[5] + base) * LOG2E, (v[6] + base) * LOG2E, (v[7] + base) * LOG2E};
    __syncthreads();
}
__device__ __forceinline__ void attn_phase(const Ptrs& P, char* lds) {
    unsigned char* ws = P.ws;
    const int G = gridDim.x, bx = blockIdx.x, vcu0 = (G % 8 == 0) ? (bx % 8) * (G / 8) + bx / 8 : bx;
    for (int v = vcu0; v < 256; v += G) {
        const int bh = v >> 2, s = v & 3, b = bh >> 4, h = bh & 15;
        fox_cumsum((const float*)(ws + WS_F), P.b_forget[h], b, h, lds);
        for (int i = 0; i < 4; ++i) {
            const int qb = (i == 0) ? s : (i == 1) ? 7 - s : (i == 2) ? 8 + s : 15 - s;
            attn_body::attn_unit<60, 1>(b, h, qb, (const attn_body::bf16*)(ws + WS_QB), (const attn_body::bf16*)(ws + WS_KB), (const attn_body::bf16*)(ws + WS_VB), 1024, h * 64,
                                        (attn_body::bf16*)(ws + WS_O), 1024 + h * 64, (float*)(ws + WS_CS), 0.f, 0.f, lds);
        }
        for (int i = 0; i < 4; ++i) {
            const int qb = (i == 0) ? s : (i == 1) ? 7 - s : (i == 2) ? 8 + s : 15 - s;
            attn_body::attn_unit<8, 0>(b, h, qb, (const attn_body::bf16*)(ws + WS_QA), (const attn_body::bf16*)(ws + WS_KA), (const attn_body::bf16*)(ws + WS_VA), 128, (h >> 3) * 64,
                                       (attn_body::bf16*)(ws + WS_O), h * 64, (float*)(ws + WS_CS), exp2f(-0.5f * (float)(h + 1)) * LOG2E, P.sinks[h] * LOG2E, lds);
        }
    }
}
#define LAS __attribute__((address_space(3)))
#define XB_TMO      128
#define XB_XCNT(j)  (256  + 64 * (j))
#define XB_XSUB(j)  (1280 + 64 * (j))
#define XB_XGEN(j)  (2304 + 64 * (j))
#define XB_TOP      3328
#define XB_TOPGEN   3392
#define XCD_BAR_WORDS 3456
#define XB_SPIN_CAP (1u << 18)

__device__ __forceinline__ unsigned xb_ld(unsigned* p)              { return __hip_atomic_load(p, __ATOMIC_RELAXED, __HIP_MEMORY_SCOPE_AGENT); }
__device__ __forceinline__ unsigned xb_add(unsigned* p, unsigned v) { return __hip_atomic_fetch_add(p, v, __ATOMIC_RELAXED, __HIP_MEMORY_SCOPE_AGENT); }
__device__ __forceinline__ unsigned xb_xcc_id() { return (unsigned)__builtin_amdgcn_s_getreg((3 << 11) | 20) & 0xFu; }
#define XB_SPIN(cond, bar) do { unsigned _sp = 0; while (cond) { __builtin_amdgcn_s_sleep(1); \
    if ((++_sp & 255u) == 0u) { if (xb_ld(&(bar)[XB_TMO])) break; if (_sp > XB_SPIN_CAP) { atomicAdd(&(bar)[XB_TMO], 1u); break; } } } } while (0)

struct XcdBarrier {
    unsigned* bar; unsigned x;
    volatile LAS unsigned* st;
};

__device__ __forceinline__ XcdBarrier xcd_barrier_post(unsigned* bar, volatile LAS unsigned* st) {
    XcdBarrier b; b.bar = bar; b.x = xb_xcc_id(); b.st = st;
    if (threadIdx.x == 0) (void)xb_add(&bar[XB_XCNT(b.x)], 1u);
    return b;
}
__device__ __forceinline__ void xcd_barrier_complete(unsigned* bar, unsigned x, unsigned& nloc, unsigned& nx) {
    const unsigned G = gridDim.x * gridDim.y * gridDim.z;
    unsigned sum, cnt, mine, sp = 0u;
    for (;;) {
        sum = 0u; cnt = 0u; mine = 0u;
#pragma unroll
        for (unsigned j = 0; j < 16; ++j) { const unsigned c = xb_ld(&bar[XB_XCNT(j)]); sum += c; cnt += (c > 0u) ? 1u : 0u; mine = (j == x) ? c : mine; }
        if (sum == G) break;
        __builtin_amdgcn_s_sleep(1);
        if ((++sp & 255u) == 0u) { if (xb_ld(&bar[XB_TMO])) break; if (sp > XB_SPIN_CAP) { atomicAdd(&bar[XB_TMO], 1u); break; } }
    }
    nloc = mine > 0u ? mine : 1u; nx = cnt > 0u ? cnt : 1u;
}

__device__ __forceinline__ void xcd_barrier(const XcdBarrier& b) {
    asm volatile("s_waitcnt vmcnt(0)" ::: "memory");
    __syncthreads();
    if (threadIdx.x == 0) {
        unsigned* bar = b.bar;
        __builtin_amdgcn_s_waitcnt(0);
        unsigned nloc = b.st[0], nx = b.st[1];
        if (nloc == 0u) { xcd_barrier_complete(bar, b.x, nloc, nx); b.st[0] = nloc; b.st[1] = nx; }
        const unsigned old = xb_add(&bar[XB_XSUB(b.x)], 1u);
        const unsigned gen = old / nloc;
        if (old + 1u == (gen + 1u) * nloc) {
            __builtin_amdgcn_fence(__ATOMIC_RELEASE, "agent");
            asm volatile("s_waitcnt vmcnt(0)" ::: "memory");
            const unsigned og = xb_add(&bar[XB_TOP], 1u);
            const unsigned tg = og / nx;
            if (og + 1u == (tg + 1u) * nx) xb_add(&bar[XB_TOPGEN], 1u);
            else XB_SPIN(xb_ld(&bar[XB_TOPGEN]) == tg, bar);
            __builtin_amdgcn_fence(__ATOMIC_ACQUIRE, "agent");
            xb_add(&bar[XB_XGEN(b.x)], 1u);
            asm volatile("s_waitcnt vmcnt(0)" ::: "memory");
        } else {
            XB_SPIN(xb_ld(&bar[XB_XGEN(b.x)]) == gen, bar);
            __builtin_amdgcn_fence(__ATOMIC_ACQUIRE, "agent");
            asm volatile("s_waitcnt vmcnt(0)" ::: "memory");
        }
    }
    __syncthreads();
}

constexpr int LDS_BYTES = 147456;
__global__ void __launch_bounds__(512, 2) mega_fwd(Ptrs P) {
    extern __shared__ __attribute__((aligned(16))) unsigned char lds[];
    cg::grid_group grid = cg::this_grid();
    if (P.use_cg) grid.sync();
    unsigned char* ws = P.ws;
    PG8_LAS unsigned char* ldsp = (PG8_LAS unsigned char*)lds;
    const int NGW = gridDim.x * 8;
    volatile LAS unsigned* bst = (volatile LAS unsigned*)(ldsp + 143360);
    if (threadIdx.x == 0) { bst[0] = 0u; bst[1] = 0u; }
    __syncthreads();
    const XcdBarrier bar = xcd_barrier_post((unsigned*)(ws + WS_CTL), bst);
#define GRID_SYNC() xcd_barrier(bar)
#define FRESH_IDS() int tid_; asm volatile("v_mov_b32 %0, %1" : "=v"(tid_) : "v"(threadIdx.x)); const int lane = tid_ & 63, gw = blockIdx.x * 8 + (tid_ >> 6)
    ph_prologue(P, (float*)lds);
    { FRESH_IDS(); pass_prenorm(P.x, P.pre_mix_g, (bf16_t*)(ws + WS_XN), (float*)(ws + WS_CS + 512 * 1024), gw, NGW, lane); }
    GRID_SYNC();
    { pg8::Gemm g{(const bf16_t*)(ws + WS_XN), (const bf16_t*)(ws + WS_WIN), M, DINP, DM}; pg8::StaticOrder S; S.init(M, DINP, (int)gridDim.x, (int)blockIdx.x);
      pg8::gemm_phase<pg8::EpiInProjT, pg8::StaticOrder, true, true>(ldsp, g, S, pg8::EpiInProjT{ws}); }
    if (gridDim.x == 256 && blockIdx.x >= 128) convert_items(P, (float*)lds, I_CUT, I_ALL, (blockIdx.x - 128) * 8 + (threadIdx.x >> 6), 128 * 8);
    GRID_SYNC();
    attn_phase(P, (char*)lds);
    GRID_SYNC();
    { pg8::Gemm g{(const bf16_t*)(ws + WS_O), (const bf16_t*)(ws + WS_WOUT), M, DM, DM}; pg8::StaticOrder S; S.init(M, DM, (int)gridDim.x, (int)blockIdx.x);
      PG8_LAS float* T = (PG8_LAS float*)(ldsp + 139264);
      { pg8::Unit u; const float* SS = (const float*)(ws + WS_CS);
        for (int i = 0; i < 2; ++i) if (S.next(i, u) && threadIdx.x < 256) { const int row = u.pm * 256 + (int)threadIdx.x;
            const float ra = 1.0f / sqrtf(SS[row * 2] * (1.0f / 1024.f) + EPS), rb = 1.0f / sqrtf(SS[row * 2 + 1] * (1.0f / 1024.f) + EPS);
            T[(i * 256 + (int)threadIdx.x) * 2] = ra / rb; T[(i * 256 + (int)threadIdx.x) * 2 + 1] = rb; } }
      __syncthreads();
      pg8::gemm_phase<pg8::EpiOutT, pg8::StaticOrder, true, true>(ldsp, g, S, pg8::EpiOutT{(bf16_t*)(ws + WS_MIX), DM, T}); }
    GRID_SYNC();
    { FRESH_IDS(); pass_postmix((bf16_t*)(ws + WS_XN), (const float*)(ws + WS_CS + 512 * 1024), P.pre_mix_g, (const bf16_t*)(ws + WS_MIX), P.post_mix_g, P.pre_ffn_g, (float*)(ws + WS_CS + 256 * 1024), gw, NGW, lane); }
    GRID_SYNC();
    { pg8::Gemm g{(const bf16_t*)(ws + WS_XN), (const bf16_t*)(ws + WS_WUP), M, NUP, DM}; pg8::StaticOrder S; S.init(M, NUP, (int)gridDim.x, (int)blockIdx.x);
      pg8::gemm_phase<pg8::EpiUpT, pg8::StaticOrder, true, true>(ldsp, g, S, pg8::EpiUpT{(bf16_t*)(ws + WS_ACT), P.conv_w, P.conv_b, (float*)(ws + WS_SIDE), (PG8_LAS float*)(ldsp + 131072)}); }
    GRID_SYNC();
    ph_convfix((const float*)(ws + WS_SIDE), P.conv_w, P.conv_b, (bf16_t*)(ws + WS_ACT));
    GRID_SYNC();
    { pg8::Gemm g{(const bf16_t*)(ws + WS_ACT), (const bf16_t*)(ws + WS_WDN), M, DM, DFF}; pg8::StaticOrder S; S.init(M, DM, (int)gridDim.x, (int)blockIdx.x);
      pg8::gemm_phase<pg8::EpiBf16T, pg8::StaticOrder, true, true>(ldsp, g, S, pg8::EpiBf16T{(bf16_t*)(ws + WS_Y), DM}); }
    GRID_SYNC();
    { FRESH_IDS(); pass_final((const bf16_t*)(ws + WS_XN), (const float*)(ws + WS_CS + 256 * 1024), P.pre_ffn_g, (const bf16_t*)(ws + WS_Y), P.post_ffn_g, P.out, gw, NGW, lane); }
}

extern "C" void kernel_launch(void* const* d_in, const int* in_sizes, int n_in, void* d_out, int out_size, void* d_ws, size_t ws_size, hipStream_t stream) {
    if (n_in != 15 || ws_size < WS_END || out_size != M * DM) { fprintf(stderr, "kernel_launch: unexpected sizes n_in %d ws %zu out %d\n", n_in, ws_size, out_size); return; }
    static int grid_blocks = 0;
    if (!grid_blocks) {
        int dev = 0, cus = 0, per_cu = 0;
        hipGetDevice(&dev);
        hipDeviceGetAttribute(&cus, hipDeviceAttributeMultiprocessorCount, dev);
        if (hipFuncSetAttribute((const void*)mega_fwd, hipFuncAttributeMaxDynamicSharedMemorySize, LDS_BYTES) != hipSuccess) fprintf(stderr, "kernel_launch: hipFuncSetAttribute failed\n");
        hipOccupancyMaxActiveBlocksPerMultiprocessor(&per_cu, (const void*)mega_fwd, 512, LDS_BYTES);
        if (per_cu < 1) { fprintf(stderr, "kernel_launch: occupancy query gave %d\n", per_cu); per_cu = 1; }
        grid_blocks = cus * per_cu;
        if (grid_blocks != 256) fprintf(stderr, "kernel_launch: expected 256 resident workgroups, got %d (the output projection assumes two units per workgroup)\n", grid_blocks);
        (void)hipGetLastError();
    }
    Ptrs P{};
    const float** pp = (const float**)&P;
    for (int i = 0; i < 15; ++i) pp[i] = (const float*)d_in[i];
    P.out = (float*)d_out; P.ws = (unsigned char*)d_ws;
    P.use_cg = 0; P.pad = 0;
    if (hipMemsetAsync((char*)d_ws + WS_CTL, 0, CTL_BYTES, stream) != hipSuccess) { fprintf(stderr, "kernel_launch: hipMemsetAsync failed\n"); return; }
    void* args[] = {&P};
    hipError_t e = hipLaunchCooperativeKernel((const void*)mega_fwd, dim3(grid_blocks), dim3(512), args, LDS_BYTES, stream);
    if (e != hipSuccess) fprintf(stderr, "cooperative launch failed: %s (grid %d)\n", hipGetErrorString(e), grid_blocks);
}
```

```cpp
#include <hip/hip_runtime.h>
#include <hip/hip_cooperative_groups.h>
namespace cg = cooperative_groups;
#include <cstdio>
#include <cstdint>

constexpr int NB = 4, SEQ = 4096, DM = 2048, M = NB * SEQ;
constexpr int HD = 64, NHA = 16, NKVA = 2, NHB = 16, WIN = 128, DFF = 5632, NUP = 2 * DFF;
constexpr int DIN = 4368, DINP = 4608;
constexpr float EPS = 1e-6f;
constexpr float LOG2E = 1.4426950408889634f;
constexpr float C2 = 0.125f * LOG2E;

constexpr size_t MiB = 1u << 20;
constexpr size_t WS_WIN = 0, WS_WOUT = 18 * MiB, WS_WUP = 26 * MiB, WS_WDN = 70 * MiB;
constexpr size_t WS_XN = 92 * MiB;
constexpr size_t WS_CS = 156 * MiB, WS_F = 157 * MiB, WS_SIDE = 158 * MiB;
constexpr size_t WS_QA = 170 * MiB, WS_KA = 202 * MiB, WS_VA = 206 * MiB, WS_QB = 210 * MiB, WS_KB = 242 * MiB, WS_VB = 274 * MiB, WS_O = 306 * MiB;
constexpr size_t WS_ACT = 170 * MiB;
constexpr size_t WS_MIX = 370 * MiB, WS_Y = 434 * MiB;
constexpr size_t WS_CTL = 169 * MiB + 768 * 1024, CTL_BYTES = 64 * 1024;
constexpr size_t WS_END = 498 * MiB;

typedef unsigned short bf16_t;
typedef unsigned v4u __attribute__((ext_vector_type(4)));
typedef float f32x4 __attribute__((ext_vector_type(4)));

__device__ __forceinline__ unsigned f2bf(float f) { unsigned u = __builtin_bit_cast(unsigned, f); return (u + 0x7fffu + ((u >> 16) & 1u)) >> 16; }
__device__ __forceinline__ unsigned pk2(float lo, float hi) { return f2bf(lo) | (f2bf(hi) << 16); }
__device__ __forceinline__ float bf2f(unsigned h) { return __builtin_bit_cast(float, h << 16); }
__device__ __forceinline__ float wave_sum(float v) {
#pragma unroll
    for (int o = 1; o < 64; o <<= 1) v += __shfl_xor(v, o);
    return v;
}
__device__ __forceinline__ float wave_max(float v) {
#pragma unroll
    for (int o = 1; o < 64; o <<= 1) v = fmaxf(v, __shfl_xor(v, o));
    return v;
}

__device__ __forceinline__ int rowmap(int n, int map) {
    if (map == 0) return n;
    if (n < DFF) return ((n >> 7) << 8) + (n & 127);
    const int g = n - DFF; return ((g >> 7) << 8) + 128 + (g & 127);
}
__device__ __forceinline__ void transpose_item(const float* W, int K, int N, int Npad, bf16_t* WT, int map, float* scr, int item, int lane, const float* ks0 = nullptr, const float* ks1 = nullptr) {
    const int nblk = Npad / 32, kb = item / nblk, nb = item % nblk, k0 = 128 * kb, n0 = 32 * nb;
    { const int n4 = lane & 7, n = n0 + 4 * n4;
      f32x4 w[16];
#pragma unroll
      for (int i = 0; i < 16; ++i) { const int kk = (lane >> 3) + 8 * i; w[i] = (n < N) ? __builtin_nontemporal_load((const f32x4*)(W + (size_t)(k0 + kk) * N + n)) : (f32x4){0.f, 0.f, 0.f, 0.f}; }
#pragma unroll
      for (int i = 0; i < 16; ++i) { const int kk = (lane >> 3) + 8 * i;
          if (ks0) w[i] = w[i] * ((k0 < 1024) ? ks0[k0 + kk] : ks1[k0 + kk - 1024]);
#pragma unroll
          for (int j = 0; j < 4; ++j) scr[kk * 33 + 4 * n4 + j] = w[i][j]; } }
    __builtin_amdgcn_s_waitcnt(0); asm volatile("" ::: "memory");
    const int c = lane & 15;
#pragma unroll
    for (int j = 0; j < 8; ++j) { const int n = (lane >> 4) + 4 * j; const float* s = scr + (8 * c) * 33 + n;
        v4u o; o.x = pk2(s[0 * 33], s[1 * 33]); o.y = pk2(s[2 * 33], s[3 * 33]); o.z = pk2(s[4 * 33], s[5 * 33]); o.w = pk2(s[6 * 33], s[7 * 33]);
        *(v4u*)(WT + (size_t)rowmap(n0 + n, map) * K + k0 + 8 * c) = o; }
    __builtin_amdgcn_s_waitcnt(0); asm volatile("" ::: "memory");
}
struct Ptrs {
    const float *x, *pre_mix_g, *w_in, *b_forget, *sinks, *grp_swa_g, *grp_fox_g, *w_out, *post_mix_g, *pre_ffn_g, *w_up, *conv_w, *conv_b, *w_down, *post_ffn_g;
    float* out; unsigned char* ws;
    int use_cg, pad;
};
constexpr int I_IN = (DM / 128) * (DINP / 32), I_OUT = (DM / 128) * (DM / 32), I_UP = (DM / 128) * (NUP / 32), I_DN = (DFF / 128) * (DM / 32);
constexpr int I_CUT = I_IN + I_OUT, I_ALL = I_IN + I_OUT + I_UP + I_DN;
__device__ __forceinline__ void convert_items(const Ptrs& P, float* scr_all, int lo, int hi, int gw, int NGW) {
    const int tid = threadIdx.x, lane = tid & 63, wave = tid >> 6;
    float* scr = scr_all + wave * 128 * 33;
    for (int it = lo + gw; it < hi; it += NGW) {
        int r = it;
        if (r < I_IN) { transpose_item(P.w_in, DM, DIN, DINP, (bf16_t*)(P.ws + WS_WIN), 0, scr, r, lane); continue; } r -= I_IN;
        if (r < I_OUT) { transpose_item(P.w_out, DM, DM, DM, (bf16_t*)(P.ws + WS_WOUT), 0, scr, r, lane, P.grp_swa_g, P.grp_fox_g); continue; } r -= I_OUT;
        if (r < I_UP) { transpose_item(P.w_up, DM, NUP, NUP, (bf16_t*)(P.ws + WS_WUP), 1, scr, r, lane); continue; } r -= I_UP;
        transpose_item(P.w_down, DFF, DM, DM, (bf16_t*)(P.ws + WS_WDN), 0, scr, r, lane);
    }
}
__device__ __forceinline__ void ph_prologue(const Ptrs& P, float* scr_all) {
    const int tid = threadIdx.x;
    const bool defer = (gridDim.x == 256);
    convert_items(P, scr_all, 0, defer ? I_CUT : I_ALL, blockIdx.x * 8 + (tid >> 6), gridDim.x * 8);
    for (int i = blockIdx.x * 512 + tid; i < M * 2; i += gridDim.x * 512) ((float*)(P.ws + WS_CS))[i] = 0.f;
}

__device__ __forceinline__ void row_load(const float* row, int lane, f32x4 (&v)[8]) {
#pragma unroll
    for (int j = 0; j < 8; ++j) v[j] = ((const f32x4*)row)[lane + 64 * j];
}
__device__ __forceinline__ void row_load_bf16(const bf16_t* row, int lane, f32x4 (&v)[8]) {
#pragma unroll
    for (int j = 0; j < 8; ++j) { const unsigned long long w = ((const unsigned long long*)row)[lane + 64 * j];
        v[j] = (f32x4){bf2f((unsigned)w & 0xffffu), bf2f(((unsigned)w >> 16)), bf2f((unsigned)(w >> 32) & 0xffffu), bf2f((unsigned)(w >> 48))}; }
}
__device__ __forceinline__ float row_sumsq(const f32x4 (&v)[8]) {
    float s = 0.f;
#pragma unroll
    for (int j = 0; j < 8; ++j) s += (v[j].x * v[j].x + v[j].y * v[j].y) + (v[j].z * v[j].z + v[j].w * v[j].w);
    return wave_sum(s);
}
__device__ __forceinline__ void row_store_bf16(bf16_t* orow, int lane, const f32x4 (&v)[8]) {
#pragma unroll
    for (int j = 0; j < 8; ++j) ((unsigned long long*)orow)[lane + 64 * j] = (unsigned long long)pk2(v[j].x, v[j].y) | ((unsigned long long)pk2(v[j].z, v[j].w) << 32);
}
__device__ __forceinline__ void pass_prenorm(const float* x, const float* g, bf16_t* xn, float* r0s, int gw, int NGW, int lane) {
    f32x4 gv[8]; row_load(g, lane, gv);
    for (int m = gw; m < M; m += NGW) {
        f32x4 v[8];
#pragma unroll
        for (int j = 0; j < 8; ++j) v[j] = __builtin_nontemporal_load((const f32x4*)(x + (size_t)m * DM) + lane + 64 * j);
        const float r = 1.0f / sqrtf(row_sumsq(v) * (1.0f / DM) + EPS);
#pragma unroll
        for (int j = 0; j < 8; ++j) v[j] = v[j] * r * gv[j];
        row_store_bf16(xn + (size_t)m * DM, lane, v);
        if (lane == 0) r0s[m] = r;
    }
}
__device__ __forceinline__ void pass_postmix(bf16_t* xn, const float* r0s, const float* gpm, const bf16_t* mix, const float* gpost, const float* gpre, float* r2s, int gw, int NGW, int lane) {
    f32x4 ig[8]; row_load(gpm, lane, ig);
#pragma unroll
    for (int j = 0; j < 8; ++j) { ig[j][0] = __builtin_amdgcn_rcpf(ig[j][0]); ig[j][1] = __builtin_amdgcn_rcpf(ig[j][1]); ig[j][2] = __builtin_amdgcn_rcpf(ig[j][2]); ig[j][3] = __builtin_amdgcn_rcpf(ig[j][3]); }
    for (int m = gw; m < M; m += NGW) {
        f32x4 v[8], xv[8], gv[8]; row_load_bf16(mix + (size_t)m * DM, lane, v); row_load_bf16(xn + (size_t)m * DM, lane, xv); row_load(gpost, lane, gv);
        const float ir0 = __builtin_amdgcn_rcpf(r0s[m]);
        const float r = 1.0f / sqrtf(row_sumsq(v) * (1.0f / DM) + EPS);
#pragma unroll
        for (int j = 0; j < 8; ++j) v[j] = xv[j] * ig[j] * ir0 + v[j] * r * gv[j];
        const float r2 = 1.0f / sqrtf(row_sumsq(v) * (1.0f / DM) + EPS);
        row_load(gpre, lane, gv);
#pragma unroll
        for (int j = 0; j < 8; ++j) v[j] = v[j] * r2 * gv[j];
        row_store_bf16(xn + (size_t)m * DM, lane, v);
        if (lane == 0) r2s[m] = r2;
    }
}
__device__ __forceinline__ void pass_final(const bf16_t* xn, const float* r2s, const float* gpre, const bf16_t* y, const float* g, float* out, int gw, int NGW, int lane) {
    f32x4 ig[8]; row_load(gpre, lane, ig);
#pragma unroll
    for (int j = 0; j < 8; ++j) { ig[j][0] = __builtin_amdgcn_rcpf(ig[j][0]); ig[j][1] = __builtin_amdgcn_rcpf(ig[j][1]); ig[j][2] = __builtin_amdgcn_rcpf(ig[j][2]); ig[j][3] = __builtin_amdgcn_rcpf(ig[j][3]); }
    f32x4 gv[8]; row_load(g, lane, gv);
    for (int m = gw; m < M; m += NGW) {
        f32x4 v[8], xv[8]; row_load_bf16(xn + (size_t)m * DM, lane, xv); row_load_bf16(y + (size_t)m * DM, lane, v);
        const float ir2 = __builtin_amdgcn_rcpf(r2s[m]);
        const float r = 1.0f / sqrtf(row_sumsq(v) * (1.0f / DM) + EPS);
#pragma unroll
        for (int j = 0; j < 8; ++j) __builtin_nontemporal_store(xv[j] * ig[j] * ir2 + v[j] * r * gv[j], (f32x4*)(out + (size_t)m * DM) + lane + 64 * j);
    }
}
__device__ __forceinline__ float log_sigmoid(float z) { return z >= 0.f ? -log1pf(expf(-z)) : z - log1pf(expf(z)); }
__device__ __forceinline__ float gelu_tanh(float x) {
    const float z = 0.7978845608028654f * (x + 0.044715f * x * x * x);
    return x / (1.0f + exp2f(-2.0f * LOG2E * z));
}
namespace pg8 {
#define PG8_LAS __attribute__((address_space(3)))
typedef unsigned short bf16_t;
typedef short bf16x8 __attribute__((ext_vector_type(8)));
typedef float f32x4 __attribute__((ext_vector_type(4)));
typedef unsigned u32x4 __attribute__((ext_vector_type(4)));
constexpr int BM = 256, BK = 64, HALF = 128, HTB = HALF * BK * 2  , STAGE_BYTES = 8 * HTB, NXCD = 8, WGM = 8;

__host__ __device__ __forceinline__ int lds_byte(int r, int c) { const int st = (r >> 4) * 2 + (c >> 5), rr = r & 15, cc = c & 31, ob = rr * 64 + cc * 2; return st * 1024 + (ob ^ (((ob >> 9) & 1) << 5)); }
__host__ __device__ __forceinline__ void stage_rc(int b, int& R, int& C) { const int st = b / 1024, sb = b % 1024, swz = sb ^ (((sb >> 9) & 1) << 5); R = (st >> 1) * 16 + swz / 64; C = (st & 1) * 32 + (swz % 64) / 2; }
__host__ __device__ __forceinline__ int perm32(int rho) { const int n = rho >> 4, i = rho & 15; return 8 * (i >> 2) + 4 * n + (i & 3); }

struct Unit { int pm, pn; };
struct Gemm { const bf16_t* A; const bf16_t* Bt; int M, N, K; };

struct StaticOrder {
    int nM, nN, nwg, G, c;
    __host__ __device__ void init(int M, int N, int G_, int c_) { nM = M / BM; nN = N / BM; nwg = nM * nN; G = G_; c = c_; }
    __host__ __device__ bool next(int i, Unit& u) const {
        const long L = (long)i * G + c; if (L >= nwg) return false;
        int wgid = (int)L; { const int q = nwg / NXCD, r = nwg % NXCD, xcd = wgid % NXCD, off = wgid / NXCD; wgid = (xcd < r ? xcd * (q + 1) : r * (q + 1) + (xcd - r) * q) + off; }
        const int nig = WGM * nN, gid = wgid / nig, fm = gid * WGM, gsz = (nM - fm) < WGM ? (nM - fm) : WGM;
        u.pm = fm + ((wgid % nig) % gsz); u.pn = (wgid % nig) / gsz; return true;
    }
    __device__ __forceinline__ void a_ready(const Unit&) const {}
    __device__ __forceinline__ void done(const Unit&) const {}
};

__device__ __forceinline__ unsigned cvt_pk_bf16(float lo, float hi) { unsigned r; asm volatile("v_cvt_pk_bf16_f32 %0, %1, %2" : "=v"(r) : "v"(lo), "v"(hi)); return r; }
typedef float f32x2 __attribute__((ext_vector_type(2)));
template <class Epi, class Sched, bool ALIGN_EPI = false, bool SP2 = false>
__device__ __forceinline__ void gemm_phase(PG8_LAS unsigned char* lds, const Gemm g, const Sched& S, const Epi& E) {
    int tid = threadIdx.x; asm volatile("" : "+v"(tid));
    const int wid = __builtin_amdgcn_readfirstlane(tid >> 6), lane = tid & 63, wr = wid >> 2, wc = wid & 3, fr = lane & 15, fq = lane >> 4;
    const int K = g.K, nt = K / BK;
    unsigned voffA[2], voffB[2];
#pragma unroll
    for (int i = 0; i < 2; ++i) { int R, C; stage_rc(tid * 16 + i * 8192, R, C); const int Rb = Epi::PERM ? ((R & ~31) + perm32(R & 31)) : R;
        voffA[i] = (unsigned)(R * K + C) * 2u; voffB[i] = (unsigned)(Rb * K + C) * 2u; }
    const size_t kstep = (size_t)(BK * 2);
    const size_t hstep = (size_t)HALF * K * 2;
    const size_t tstep = 2 * hstep;
    const unsigned ldsw = (unsigned)wid * 1024u;
    const int aoff = lds_byte(wr * 64 + fr, fq * 8), boff = lds_byte(wc * 32 + fr, fq * 8);
#define PG8_SA(b, h) (((b) * 2 + (h)) * HTB)
#define PG8_SB(b, h) ((4 + (b) * 2 + (h)) * HTB)
    const unsigned ldsb = (unsigned)(uintptr_t)lds + ldsw;
#define PG8_STAGE(bufoff, gbase, voff) do { _Pragma("unroll") for (int _i = 0; _i < 2; ++_i) { unsigned keep_; \
        asm volatile("s_mov_b32 %0, m0\n\ts_mov_b32 m0, %3\n\ts_nop 0\n\tglobal_load_lds_dwordx4 %1, %2\n\ts_mov_b32 m0, %0" : "=&s"(keep_) \
                     : "v"((voff)[_i]), "s"((const char*)(gbase)), "s"((unsigned)__builtin_amdgcn_readfirstlane(ldsb + (unsigned)((bufoff) + _i * 8192))) : "memory"); } } while (0)
#define PG8_LDA(dst, b, h) do { _Pragma("unroll") for (int m = 0; m < 4; ++m) _Pragma("unroll") for (int k = 0; k < 2; ++k) dst[m][k] = *(const PG8_LAS bf16x8*)(lds + PG8_SA(b, h) + aoff + m * 2048 + k * 1024); } while (0)
#define PG8_LDB(dst, b, h) do { _Pragma("unroll") for (int n = 0; n < 2; ++n) _Pragma("unroll") for (int k = 0; k < 2; ++k) dst[n][k] = *(const PG8_LAS bf16x8*)(lds + PG8_SB(b, h) + boff + n * 2048 + k * 1024); } while (0)
#define PG8_MMA(ai, bj, At, Bt) do { __builtin_amdgcn_s_setprio(1); _Pragma("unroll") for (int m = 0; m < 4; ++m) _Pragma("unroll") for (int n = 0; n < 2; ++n) _Pragma("unroll") for (int k = 0; k < 2; ++k) \
        acc[ai][bj][m][n] = __builtin_amdgcn_mfma_f32_16x16x32_bf16(Bt[n][k], At[m][k], acc[ai][bj][m][n], 0, 0, 0); __builtin_amdgcn_s_setprio(0); } while (0)
#define PG8_WAIT_V(n) asm volatile("s_waitcnt vmcnt(" #n ")" ::: "memory")
#define PG8_WAIT_L(n) asm volatile("s_waitcnt lgkmcnt(" #n ")" ::: "memory")
#define PG8_BAR __builtin_amdgcn_s_barrier()
#define PG8_SCHED __builtin_amdgcn_sched_barrier(0)
    Unit cur, nxt; int ui = 0;
    if (!S.next(0, cur)) return;
    f32x4 acc[2][2][4][2];
#pragma unroll
    for (int a = 0; a < 2; ++a)
#pragma unroll
        for (int b = 0; b < 2; ++b)
#pragma unroll
            for (int m = 0; m < 4; ++m)
#pragma unroll
                for (int n = 0; n < 2; ++n) acc[a][b][m][n] = (f32x4){0.f, 0.f, 0.f, 0.f};
    bf16x8 At[4][2], B0[2][2], B1[2][2];
    const char* cA = (const char*)g.A + (size_t)cur.pm * tstep; const char* cB = (const char*)g.Bt + (size_t)cur.pn * tstep;
    S.a_ready(cur);
    if constexpr (SP2) {
        PG8_STAGE(PG8_SB(0, 0), cB, voffB); PG8_STAGE(PG8_SB(0, 1), cB + hstep, voffB); PG8_STAGE(PG8_SA(0, 0), cA, voffA); PG8_STAGE(PG8_SA(0, 1), cA + hstep, voffA);
        if (wr == 1) PG8_BAR;
        PG8_WAIT_V(2); PG8_BAR;
        PG8_STAGE(PG8_SB(1, 0), cB + kstep, voffB); PG8_STAGE(PG8_SA(1, 0), cA + kstep, voffA); PG8_STAGE(PG8_SB(1, 1), cB + hstep + kstep, voffB);
        PG8_WAIT_V(6); PG8_BAR;
    } else {
        PG8_STAGE(PG8_SB(0, 0), cB, voffB); PG8_STAGE(PG8_SA(0, 0), cA, voffA); PG8_STAGE(PG8_SB(0, 1), cB + hstep, voffB); PG8_STAGE(PG8_SA(0, 1), cA + hstep, voffA);
        if (wr == 1) PG8_BAR;
        PG8_WAIT_V(4); PG8_BAR;
        PG8_STAGE(PG8_SB(1, 0), cB + kstep, voffB); PG8_STAGE(PG8_SA(1, 0), cA + kstep, voffA); PG8_STAGE(PG8_SB(1, 1), cB + hstep + kstep, voffB);
        PG8_WAIT_V(6); PG8_BAR;
    }
    for (;;) {
        const bool has_next = S.next(ui + 1, nxt);
        const char* nA = has_next ? (const char*)g.A + (size_t)nxt.pm * tstep : cA; const char* nB = has_next ? (const char*)g.Bt + (size_t)nxt.pn * tstep : cB;
        for (int t = 0; t < nt; t += 2) {
            if constexpr (Epi::MIDK) { if (t == nt / 2) E.midk(acc, ui, wr, fr); }
            const bool last = (t == nt - 2);
            const char* a1 = cA + (size_t)(t + 1) * kstep;
            const char* a2 = last ? nA : cA + (size_t)(t + 2) * kstep; const char* b2 = last ? nB : cB + (size_t)(t + 2) * kstep;
            const char* a3 = a2 + kstep; const char* b3 = b2 + kstep;
            if (last && has_next) S.a_ready(nxt);
            if constexpr (SP2) {
            PG8_LDB(B0, 0, 0); PG8_LDB(B1, 0, 1); PG8_SCHED; PG8_LDA(At, 0, 0); PG8_STAGE(PG8_SA(1, 1), a1 + hstep, voffA);
            PG8_WAIT_V(8); PG8_WAIT_L(0); PG8_BAR; PG8_MMA(0, 0, At, B0); PG8_MMA(0, 1, At, B1); PG8_BAR; PG8_SCHED;
            PG8_LDA(At, 0, 1); PG8_STAGE(PG8_SB(0, 0), b2, voffB); PG8_STAGE(PG8_SB(0, 1), b2 + hstep, voffB); PG8_STAGE(PG8_SA(0, 0), a2, voffA);
            PG8_WAIT_V(8); PG8_WAIT_L(0); PG8_BAR; PG8_MMA(1, 0, At, B0); PG8_MMA(1, 1, At, B1); PG8_BAR; PG8_SCHED;
            PG8_LDB(B0, 1, 0); PG8_LDB(B1, 1, 1); PG8_SCHED; PG8_LDA(At, 1, 0); PG8_STAGE(PG8_SA(0, 1), a2 + hstep, voffA);
            PG8_WAIT_V(8); PG8_WAIT_L(0); PG8_BAR; PG8_MMA(0, 0, At, B0); PG8_MMA(0, 1, At, B1); PG8_BAR; PG8_SCHED;
            PG8_LDA(At, 1, 1); PG8_STAGE(PG8_SB(1, 0), b3, voffB); PG8_STAGE(PG8_SB(1, 1), b3 + hstep, voffB); PG8_STAGE(PG8_SA(1, 0), a3, voffA);
            PG8_WAIT_V(8); PG8_WAIT_L(0); PG8_BAR; PG8_MMA(1, 0, At, B0); PG8_MMA(1, 1, At, B1); PG8_BAR; PG8_SCHED;
            } else {
            PG8_LDB(B0, 0, 0); PG8_SCHED; PG8_LDA(At, 0, 0); PG8_STAGE(PG8_SA(1, 1), a1 + hstep, voffA);
            PG8_WAIT_L(8); PG8_BAR; PG8_WAIT_L(0); PG8_MMA(0, 0, At, B0); PG8_BAR; PG8_SCHED;
            PG8_LDB(B1, 0, 1); PG8_STAGE(PG8_SB(0, 0), b2, voffB);
            PG8_BAR; PG8_WAIT_L(0); PG8_MMA(0, 1, At, B1); PG8_BAR;
            PG8_LDA(At, 0, 1); PG8_STAGE(PG8_SA(0, 0), a2, voffA);
            PG8_BAR; PG8_WAIT_L(0); PG8_MMA(1, 0, At, B0); PG8_BAR; PG8_SCHED;
            PG8_STAGE(PG8_SB(0, 1), b2 + hstep, voffB);
            PG8_WAIT_V(6); PG8_BAR; PG8_MMA(1, 1, At, B1); PG8_BAR;
            PG8_LDB(B0, 1, 0); PG8_SCHED; PG8_LDA(At, 1, 0); PG8_STAGE(PG8_SA(0, 1), a2 + hstep, voffA);
            PG8_WAIT_L(8); PG8_BAR; PG8_WAIT_L(0); PG8_MMA(0, 0, At, B0); PG8_BAR; PG8_SCHED;
            PG8_LDB(B1, 1, 1); PG8_STAGE(PG8_SB(1, 0), b3, voffB);
            PG8_BAR; PG8_WAIT_L(0); PG8_MMA(0, 1, At, B1); PG8_BAR;
            PG8_LDA(At, 1, 1); PG8_STAGE(PG8_SA(1, 0), a3, voffA);
            PG8_BAR; PG8_WAIT_L(0); PG8_MMA(1, 0, At, B0); PG8_BAR; PG8_SCHED;
            PG8_STAGE(PG8_SB(1, 1), b3 + hstep, voffB);
            PG8_WAIT_V(6); PG8_BAR; PG8_MMA(1, 1, At, B1); PG8_BAR;
            }
        }
        if constexpr (ALIGN_EPI) { if (wr == 0) PG8_BAR; }
        if constexpr (Epi::MIDK) { E.epi(acc, cur, ui, wr, wc, fr, fq); S.done(cur); }
        else if constexpr (!Epi::AFTER_DRAIN) { E(acc, cur, wr, wc, fr, fq); S.done(cur); }
        if (!has_next) break;
#pragma unroll
        for (int a = 0; a < 2; ++a)
#pragma unroll
            for (int b = 0; b < 2; ++b)
#pragma unroll
                for (int m = 0; m < 4; ++m)
#pragma unroll
                    for (int n = 0; n < 2; ++n) acc[a][b][m][n] = (f32x4){0.f, 0.f, 0.f, 0.f};
        cur = nxt; cA = nA; cB = nB; ++ui;
        if constexpr (ALIGN_EPI) { if (wr == 1) PG8_BAR; }
    }
    PG8_WAIT_V(0);
    if constexpr (!ALIGN_EPI) { if (wr == 0) PG8_BAR; }
    PG8_BAR;
    if constexpr (Epi::AFTER_DRAIN) { E.fused(acc, cur, wr, wc, fr, fq, lds, wid, lane); S.done(cur); }
#undef PG8_SA
#undef PG8_SB
#undef PG8_STAGE
#undef PG8_LDA
#undef PG8_LDB
#undef PG8_MMA
#undef PG8_WAIT_V
#undef PG8_WAIT_L
#undef PG8_BAR
#undef PG8_SCHED
}
}

namespace pg8 {
struct EpiInProjT {
    static constexpr bool PERM = true, AFTER_DRAIN = false, MIDK = false;
    unsigned char* ws;
    __device__ __forceinline__ void operator()(const f32x4 (&acc)[2][2][4][2], const Unit& u, int wr, int wc, int fr, int fq) const {
        const int row0 = u.pm * BM + wr * 64 + fr, pn = u.pn, cin = wc * 32 + 8 * fq;
        if (pn == 17) {
            if (wc == 0 && fq < 2) { float* F = (float*)(ws + WS_F);
#pragma unroll
                for (int ai = 0; ai < 2; ++ai)
#pragma unroll
                    for (int m = 0; m < 4; ++m)
#pragma unroll
                        for (int n = 0; n < 2; ++n)
#pragma unroll
                            for (int j = 0; j < 4; ++j) F[(size_t)(8 * fq + 4 * n + j) * M + row0 + ai * HALF + m * 16] = acc[ai][0][m][n][j]; }
            return;
        }
        bf16_t *b0, *b1; int ldc; float sc = 1.f;
        if (pn < 4) { b0 = (bf16_t*)(ws + WS_QA) + pn * 256 + cin; b1 = b0 + HALF; ldc = 1024; sc = C2; }
        else if (pn == 4) { b0 = (bf16_t*)(ws + WS_KA) + cin; b1 = (bf16_t*)(ws + WS_VA) + cin; ldc = 128; }
        else if (pn < 9) { b0 = (bf16_t*)(ws + WS_QB) + (pn - 5) * 256 + cin; b1 = b0 + HALF; ldc = 1024; sc = C2; }
        else if (pn < 13) { b0 = (bf16_t*)(ws + WS_KB) + (pn - 9) * 256 + cin; b1 = b0 + HALF; ldc = 1024; }
        else { b0 = (bf16_t*)(ws + WS_VB) + (pn - 13) * 256 + cin; b1 = b0 + HALF; ldc = 1024; }
#pragma unroll
        for (int ai = 0; ai < 2; ++ai)
#pragma unroll
            for (int m = 0; m < 4; ++m) { const size_t ro = (size_t)(row0 + ai * HALF + m * 16) * ldc;
#pragma unroll
                for (int bj = 0; bj < 2; ++bj) { const f32x4 v0 = acc[ai][bj][m][0] * sc, v1 = acc[ai][bj][m][1] * sc;
                    u32x4 w; w.x = cvt_pk_bf16(v0[0], v0[1]); w.y = cvt_pk_bf16(v0[2], v0[3]); w.z = cvt_pk_bf16(v1[0], v1[1]); w.w = cvt_pk_bf16(v1[2], v1[3]);
                    *(u32x4*)((bj ? b1 : b0) + ro) = w; } }
    }
};
struct EpiBf16T {
    static constexpr bool PERM = true, AFTER_DRAIN = false, MIDK = false;
    bf16_t* C; int ldc;
    __device__ __forceinline__ void operator()(const f32x4 (&acc)[2][2][4][2], const Unit& u, int wr, int wc, int fr, int fq) const {
        const int row0 = u.pm * BM + wr * 64 + fr, col0 = u.pn * BM + wc * 32 + 8 * fq;
#pragma unroll
        for (int ai = 0; ai < 2; ++ai)
#pragma unroll
            for (int m = 0; m < 4; ++m) { bf16_t* rp = C + (size_t)(row0 + ai * HALF + m * 16) * ldc + col0;
#pragma unroll
                for (int bj = 0; bj < 2; ++bj) { const f32x4 v0 = acc[ai][bj][m][0], v1 = acc[ai][bj][m][1];
                    u32x4 w; w.x = cvt_pk_bf16(v0[0], v0[1]); w.y = cvt_pk_bf16(v0[2], v0[3]); w.z = cvt_pk_bf16(v1[0], v1[1]); w.w = cvt_pk_bf16(v1[2], v1[3]);
                    *(u32x4*)(rp + bj * HALF) = w; } }
    }
};
struct EpiOutT {
    static constexpr bool PERM = true, AFTER_DRAIN = false, MIDK = true;
    bf16_t* C; int ldc; const PG8_LAS float* T;
    __device__ __forceinline__ void midk(f32x4 (&acc)[2][2][4][2], int ui, int wr, int fr) const {
#pragma unroll
        for (int ai = 0; ai < 2; ++ai)
#pragma unroll
            for (int m = 0; m < 4; ++m) { const float r = T[((ui & 1) * 256 + ai * HALF + wr * 64 + m * 16 + fr) * 2];
#pragma unroll
                for (int bj = 0; bj < 2; ++bj)
#pragma unroll
                    for (int n = 0; n < 2; ++n) acc[ai][bj][m][n] *= r; }
    }
    __device__ __forceinline__ void epi(const f32x4 (&acc)[2][2][4][2], const Unit& u, int ui, int wr, int wc, int fr, int fq) const {
        const int row0 = u.pm * BM + wr * 64 + fr, col0 = u.pn * BM + wc * 32 + 8 * fq;
#pragma unroll
        for (int ai = 0; ai < 2; ++ai)
#pragma unroll
            for (int m = 0; m < 4; ++m) { bf16_t* rp = C + (size_t)(row0 + ai * HALF + m * 16) * ldc + col0; const float r = T[((ui & 1) * 256 + ai * HALF + wr * 64 + m * 16 + fr) * 2 + 1];
#pragma unroll
                for (int bj = 0; bj < 2; ++bj) { const f32x4 v0 = acc[ai][bj][m][0] * r, v1 = acc[ai][bj][m][1] * r;
                    u32x4 w; w.x = cvt_pk_bf16(v0[0], v0[1]); w.y = cvt_pk_bf16(v0[2], v0[3]); w.z = cvt_pk_bf16(v1[0], v1[1]); w.w = cvt_pk_bf16(v1[2], v1[3]);
                    *(u32x4*)(rp + bj * HALF) = w; } }
    }
};
}

namespace pg8 {
__device__ __forceinline__ float dpp_ror1(float x) { return __builtin_bit_cast(float, __builtin_amdgcn_mov_dpp(__builtin_bit_cast(int, x), 0x121, 0xf, 0xf, true)); }
__device__ __forceinline__ float dpp_ror2(float x) { return __builtin_bit_cast(float, __builtin_amdgcn_mov_dpp(__builtin_bit_cast(int, x), 0x122, 0xf, 0xf, true)); }
__device__ __forceinline__ float gelu_tanh_fast(float x) {
    const float e = __builtin_amdgcn_exp2f(-2.3022082f * x * (1.0f + 0.044715f * x * x));
    return x * __builtin_amdgcn_rcpf(1.0f + e);
}
__device__ __forceinline__ f32x4 geglu4(f32x4 g, f32x4 v) {
    const f32x4 t = (g * g) * 0.044715f + 1.0f, a = (g * -2.3022082f) * t;
    f32x4 e; e[0] = __builtin_amdgcn_exp2f(a[0]); e[1] = __builtin_amdgcn_exp2f(a[1]); e[2] = __builtin_amdgcn_exp2f(a[2]); e[3] = __builtin_amdgcn_exp2f(a[3]);
    e = e + 1.0f;
    f32x4 r; r[0] = __builtin_amdgcn_rcpf(e[0]); r[1] = __builtin_amdgcn_rcpf(e[1]); r[2] = __builtin_amdgcn_rcpf(e[2]); r[3] = __builtin_amdgcn_rcpf(e[3]);
    return (g * v) * r;
}
constexpr size_t SIDE_HEAD = 0, SIDE_TAIL = 6 * MiB;
struct EpiUpT {
    static constexpr bool PERM = true, AFTER_DRAIN = false, MIDK = false;
    bf16_t* act; const float* cw; const float* cb; float* side; PG8_LAS float* X;
    __device__ __forceinline__ void operator()(const f32x4 (&acc)[2][2][4][2], const Unit& u, int wr, int wc, int fr, int fq) const {
        const int cin = wc * 32 + 8 * fq;
        f32x4 Wt[2][2][4];
#define EPIUP_LOADW(n_) do { _Pragma("unroll") for (int bj_ = 0; bj_ < 2; ++bj_) { const int col_ = bj_ * DFF + HALF * u.pn + cin + 4 * (n_); \
            if ((n_) == 0) Wt[n_][bj_][0] = *(const f32x4*)(cw + col_); Wt[n_][bj_][1] = *(const f32x4*)(cw + NUP + col_); Wt[n_][bj_][2] = *(const f32x4*)(cw + 2 * NUP + col_); } } while (0)
#define EPIUP_LOADB(n_) do { _Pragma("unroll") for (int bj_ = 0; bj_ < 2; ++bj_) { Wt[n_][bj_][3] = *(const f32x4*)(cb + bj_ * DFF + HALF * u.pn + cin + 4 * (n_)); if ((n_) == 1) Wt[n_][bj_][0] = *(const f32x4*)(cw + bj_ * DFF + HALF * u.pn + cin + 4 * (n_)); } } while (0)
        EPIUP_LOADW(0); EPIUP_LOADB(0); EPIUP_LOADW(1);
        if (fr >= 14) {
#pragma unroll
            for (int ai = 0; ai < 2; ++ai)
#pragma unroll
                for (int bj = 0; bj < 2; ++bj)
#pragma unroll
                    for (int n = 0; n < 2; ++n) *(PG8_LAS f32x4*)(X + ((2 * ai + wr) * 2 + (fr - 14)) * 256 + bj * HALF + cin + 4 * n) = acc[ai][bj][3][n];
            if (wr == 1) {
#pragma unroll
                for (int bj = 0; bj < 2; ++bj)
#pragma unroll
                    for (int n = 0; n < 2; ++n) *(f32x4*)(side + SIDE_TAIL / 4 + ((size_t)u.pm * 2 + (fr - 14)) * NUP + u.pn * BM + bj * HALF + cin + 4 * n) = acc[1][bj][3][n];
            }
        }
        if (fr < 2 && wr == 0) {
#pragma unroll
            for (int bj = 0; bj < 2; ++bj)
#pragma unroll
                for (int n = 0; n < 2; ++n) *(f32x4*)(side + SIDE_HEAD / 4 + ((size_t)u.pm * 2 + fr) * NUP + u.pn * BM + bj * HALF + cin + 4 * n) = acc[0][bj][0][n];
        }
        asm volatile("s_waitcnt lgkmcnt(0)" ::: "memory"); __builtin_amdgcn_s_barrier(); asm volatile("" ::: "memory");
#pragma unroll
        for (int ai = 0; ai < 2; ++ai) {
            const int b4 = 2 * ai + wr;
            typedef unsigned u32x2v __attribute__((ext_vector_type(2)));
            u32x2v st[4];
#pragma unroll
            for (int n = 0; n < 2; ++n) {
                f32x4 p1[2], p2[2];
#pragma unroll
                for (int bj = 0; bj < 2; ++bj) {
                    f32x4 h62 = (f32x4){0.f, 0.f, 0.f, 0.f}, h63 = h62;
                    if (b4 > 0) { h62 = *(const PG8_LAS f32x4*)(X + ((b4 - 1) * 2 + 0) * 256 + bj * HALF + cin + 4 * n); h63 = *(const PG8_LAS f32x4*)(X + ((b4 - 1) * 2 + 1) * 256 + bj * HALF + cin + 4 * n); }
                    p1[bj] = h63; p2[bj] = (fr == 1) ? h63 : h62;
                }
#pragma unroll
                for (int m = 0; m < 4; ++m) {
                    f32x4 y[2];
#pragma unroll
                    for (int bj = 0; bj < 2; ++bj) {
                        const f32x4 v = acc[ai][bj][m][n];
                        f32x4 r1, r2;
#pragma unroll
                        for (int j = 0; j < 4; ++j) { r1[j] = dpp_ror1(v[j]); r2[j] = dpp_ror2(v[j]); }
                        const f32x4 q1 = (fr >= 1) ? r1 : p1[bj], q2 = (fr >= 2) ? r2 : p2[bj];
                        y[bj] = (Wt[n][bj][2] * v + Wt[n][bj][1] * q1) + (Wt[n][bj][0] * q2 + Wt[n][bj][3]);
                        p1[bj] = r1; p2[bj] = r2;
                    }
                    const f32x4 o4 = geglu4(y[0], y[1]); u32x2v w; w.x = cvt_pk_bf16(o4[0], o4[1]); w.y = cvt_pk_bf16(o4[2], o4[3]);
                    if (n == 0) st[m] = w;
                    else *(u32x4*)(act + (size_t)(u.pm * BM + ai * HALF + wr * 64 + m * 16 + fr) * DFF + HALF * u.pn + cin) = (u32x4){st[m].x, st[m].y, w.x, w.y};
                    __builtin_amdgcn_sched_barrier(0);
                }
                if (ai == 0 && n == 0) { EPIUP_LOADB(1); __builtin_amdgcn_sched_barrier(0); }
            }
            asm volatile("" ::: "memory"); __builtin_amdgcn_sched_barrier(0);
        }
#undef EPIUP_LOADW
#undef EPIUP_LOADB
    }
};
}
__device__ __forceinline__ void ph_convfix(const float* side, const float* cw, const float* cb, bf16_t* act) {
    const float* head = side + pg8::SIDE_HEAD / 4; const float* tail = side + pg8::SIDE_TAIL / 4;
    for (int idx = blockIdx.x * 512 + threadIdx.x; idx < 64 * 2 * DFF; idx += gridDim.x * 512) {
        const int pm = idx / (2 * DFF), r = (idx / DFF) & 1, n = idx % DFF;
        if ((pm & 15) == 0) continue;
        const int pg = ((n >> 7) << 8) + (n & 127);
        float y[2];
#pragma unroll
        for (int h = 0; h < 2; ++h) { const int pc = pg + 128 * h, col = h * DFF + n;
            const float H0 = head[((size_t)pm * 2 + 0) * NUP + pc], H1 = head[((size_t)pm * 2 + 1) * NUP + pc];
            const float T0 = tail[((size_t)(pm - 1) * 2 + 0) * NUP + pc], T1 = tail[((size_t)(pm - 1) * 2 + 1) * NUP + pc];
            const float w0 = cw[col], w1 = cw[NUP + col], w2 = cw[2 * NUP + col];
            y[h] = cb[col] + (r == 0 ? (w2 * H0 + w1 * T1 + w0 * T0) : (w2 * H1 + w1 * H0 + w0 * T1)); }
        act[(size_t)(256 * pm + r) * DFF + n] = (bf16_t)f2bf(gelu_tanh(y[0]) * y[1]);
    }
}
#include <hip/hip_bf16.h>
#include <cmath>
namespace attn_body {
using bf16=__hip_bfloat16;
using bf16x8=__attribute__((ext_vector_type(8)))short;
using s16x4=__attribute__((ext_vector_type(4)))short;
using f32x16=__attribute__((ext_vector_type(16)))float;
using u32x4=__attribute__((ext_vector_type(4)))unsigned;
using f32x4v=__attribute__((ext_vector_type(4)))float;
constexpr int BATCH=4,NHEAD=16,SEQ=4096,D=64,QP=1024,OP=2048;
constexpr int NW=8,QBLK=32,QB=QBLK*NW,KVBLK=64,NQB=SEQ/QB;
constexpr int ATTN_UNIT_ROWS=QB;
__device__ __forceinline__ int crow(int r,int hi){return (r&3)+8*(r>>2)+4*hi;}
#define SBAR() __builtin_amdgcn_sched_barrier(0)
template<bool WIN> __device__ __forceinline__ void amask(f32x16&p0,f32x16&p1,int koff,int qrel,int hi){
  const float NEG=-INFINITY; int d=qrel-(koff+4*hi); asm volatile("":"+v"(d));
  #pragma unroll
  for(int r=0;r<16;++r){const int kc=(r&3)+8*(r>>2);
    if(kc>d||(WIN&&kc<=d-128))p0[r]=NEG; if(kc+32>d||(WIN&&kc+32<=d-128))p1[r]=NEG;}
}

constexpr int NSLOT=3, SLOTB=8192;
constexpr int LDS_K=0, LDS_V=NSLOT*SLOTB, LDS_WS=2*NSLOT*SLOTB, LDS_OST=LDS_WS+NW*64*4, LDS_CL=LDS_OST+NW*4096+2048, LDS_CL2=LDS_CL+SEQ*4, LDS_WT=LDS_CL2+384*4, LDS_BYTES=LDS_WT+64;
constexpr float C2=0.125f*1.4426950408889634f;
__device__ __forceinline__ void glds16(const void*gsrc,unsigned lds_dst){unsigned keep;
  asm volatile("s_mov_b32 %0, m0\n\ts_mov_b32 m0, %2\n\ts_nop 0\n\tglobal_load_lds_dwordx4 %1, off\n\ts_mov_b32 m0, %0":"=&s"(keep):"v"(gsrc),"s"(lds_dst):"memory");}
__device__ __forceinline__ float max3f(float a,float b,float c){float r;asm("v_max3_f32 %0, %1, %2, %3":"=v"(r):"v"(a),"v"(b),"v"(c));return r;}
__device__ __forceinline__ float max2f(float a,float b){float r;asm("v_max_f32_e32 %0, %1, %2":"=v"(r):"v"(a),"v"(b));return r;}
__device__ __forceinline__ float fadd_s(float a,float b){float r;asm("v_add_f32_e32 %0, %1, %2":"=v"(r):"v"(a),"v"(b));return r;}
__device__ __forceinline__ float fsub_s(float a,float b){float r;asm("v_sub_f32_e32 %0, %1, %2":"=v"(r):"v"(a),"v"(b));return r;}
typedef float f32x2_t __attribute__((ext_vector_type(2))); typedef __bf16 bf16x2_t __attribute__((ext_vector_type(2)));
__device__ __forceinline__ unsigned cvtpk_s(float lo,float hi){f32x2_t v={lo,hi};bf16x2_t b=__builtin_convertvector(v,bf16x2_t);return __builtin_bit_cast(unsigned,b);}
#define WAIT_BAR(N) asm volatile("s_waitcnt vmcnt(" #N ") lgkmcnt(0)\n\ts_barrier":::"memory")

__device__ __forceinline__ void qkt(f32x16&p0,f32x16&p1,const char*Kslot,const bf16x8*qr,int r32,int hi){
  const char*kb=Kslot+hi*1024+r32*16;
  #pragma unroll
  for(int d0=0;d0<4;++d0){
    const bf16x8 b0=*reinterpret_cast<const bf16x8*>(kb+d0*2048);
    const bf16x8 b1=*reinterpret_cast<const bf16x8*>(kb+d0*2048+512);
    if(d0==0){p0=__builtin_amdgcn_mfma_f32_32x32x16_bf16(b0,qr[0],p0,0,0,0);p1=__builtin_amdgcn_mfma_f32_32x32x16_bf16(b1,qr[0],p1,0,0,0);}
    else{p0=__builtin_amdgcn_mfma_f32_32x32x16_bf16(b0,qr[d0],p0,0,0,0);p1=__builtin_amdgcn_mfma_f32_32x32x16_bf16(b1,qr[d0],p1,0,0,0);}}
}
typedef __attribute__((address_space(3))) const char* lds_cptr;
typedef short v4i16_t __attribute__((ext_vector_type(4)));
__device__ __forceinline__ void kload8(bf16x8*kf,lds_cptr kp){
  kf[0]=*(const __attribute__((address_space(3))) bf16x8*)(kp);      kf[1]=*(const __attribute__((address_space(3))) bf16x8*)(kp+512);
  kf[2]=*(const __attribute__((address_space(3))) bf16x8*)(kp+2048); kf[3]=*(const __attribute__((address_space(3))) bf16x8*)(kp+2560);
  kf[4]=*(const __attribute__((address_space(3))) bf16x8*)(kp+4096); kf[5]=*(const __attribute__((address_space(3))) bf16x8*)(kp+4608);
  kf[6]=*(const __attribute__((address_space(3))) bf16x8*)(kp+6144); kf[7]=*(const __attribute__((address_space(3))) bf16x8*)(kp+6656);
}
__device__ __forceinline__ void kload2(bf16x8*kf,lds_cptr kp,int j){ kf[2*j]=*(const __attribute__((address_space(3))) bf16x8*)(kp+j*2048); kf[2*j+1]=*(const __attribute__((address_space(3))) bf16x8*)(kp+j*2048+512); }
__device__ __forceinline__ s16x4 vtr(lds_cptr p){ return __builtin_bit_cast(s16x4,__builtin_amdgcn_ds_read_tr16_b64_v4i16((__attribute__((address_space(3))) v4i16_t*)p)); }
__device__ __forceinline__ float rowmax(const f32x16&p0,const f32x16&p1){
  float a=max3f(p0[0],p0[1],p1[0]),b=max3f(p0[2],p0[3],p1[1]);a=max3f(a,p1[2],p1[3]);
  #pragma unroll
  for(int r=4;r<16;r+=4){a=max3f(a,p0[r],p0[r+1]);b=max3f(b,p0[r+2],p0[r+3]);a=max3f(a,p1[r],p1[r+1]);b=max3f(b,p1[r+2],p1[r+3]);}
  const float m=max2f(a,b);
  auto rr=__builtin_amdgcn_permlane32_swap(__float_as_uint(m),__float_as_uint(m),false,false);
  return max2f(__uint_as_float(rr[0]),__uint_as_float(rr[1]));
}
__device__ __forceinline__ void pv(f32x16*o,int vb,bf16x8 pa0,bf16x8 pa1,bf16x8 pa2,bf16x8 pa3){
  #pragma unroll
  for(int d0=0;d0<2;++d0){s16x4 lo[4],hi[4];
    #pragma unroll
    for(int ks=0;ks<4;++ks){
      asm volatile("ds_read_b64_tr_b16 %0,%1 offset:%c2":"=&v"(lo[ks]):"v"(vb),"i"(d0*4096+ks*1024):"memory");
      asm volatile("ds_read_b64_tr_b16 %0,%1 offset:%c2":"=&v"(hi[ks]):"v"(vb),"i"(d0*4096+ks*1024+512):"memory");}
    asm volatile("s_waitcnt lgkmcnt(0)":::"memory");SBAR();
    #define PK(k) (bf16x8){lo[k][0],lo[k][1],lo[k][2],lo[k][3],hi[k][0],hi[k][1],hi[k][2],hi[k][3]}
    o[d0]=__builtin_amdgcn_mfma_f32_32x32x16_bf16(pa0,PK(0),o[d0],0,0,0);
    o[d0]=__builtin_amdgcn_mfma_f32_32x32x16_bf16(pa1,PK(1),o[d0],0,0,0);
    o[d0]=__builtin_amdgcn_mfma_f32_32x32x16_bf16(pa2,PK(2),o[d0],0,0,0);
    o[d0]=__builtin_amdgcn_mfma_f32_32x32x16_bf16(pa3,PK(3),o[d0],0,0,0);
    #undef PK
  }
}

#ifndef ATTN_STORE16
#define ATTN_STORE16(p,v) (*(u32x4*)(p)=(v))
#endif
template<int THRL,int MODE> __device__ __forceinline__ void attn_unit(int b,int h,int qb,const bf16*Q,const bf16*__restrict__ K,const bf16*__restrict__ V,int KP,int kvcol,bf16*O,int ocol,float*ssq,float slope_l2,float sink_l2,char*shm){
  int tid=threadIdx.x; asm volatile("":"+v"(tid));
  const int lane=tid&63,r32=lane&31,hi=lane>>5; const int wid=__builtin_amdgcn_readfirstlane(tid>>6);
  const long rowbase=(long)b*SEQ; const int q0=qb*QB;
  const int t0=(MODE==0)?((qb>0)?4*qb-2:0):0;
  const bf16*Qw=Q+(rowbase+q0+wid*QBLK)*QP+h*D;
  const bf16*Kh=K+(rowbase+(long)t0*KVBLK)*KP+kvcol,*Vh=V+(rowbase+(long)t0*KVBLK)*KP+kvcol;
  const unsigned lds0=(unsigned)(uintptr_t)shm;
  float*wsf=(float*)(shm+LDS_WS)+wid*64;
  const bf16*ksrc=Kh+(long)lane*KP+wid*8;
  const bf16*vsrc=Vh+(long)(16*(wid&3)+(lane>>2))*KP+(wid>>2)*32+(lane&3)*8;
  const unsigned kdst=lds0+LDS_K+wid*1024, vdst=lds0+LDS_V+wid*1024;
  #define DMA_K(t,slot) glds16(ksrc+(long)(t)*KVBLK*KP,(unsigned)__builtin_amdgcn_readfirstlane(kdst+(slot)))
  #define DMA_V(t,slot) glds16(vsrc+(long)(t)*KVBLK*KP,(unsigned)__builtin_amdgcn_readfirstlane(vdst+(slot)))
  const int vb0=(int)(lds0+LDS_V)+((lane>>4)&1)*32+(lane&3)*8+(4*hi+((lane&15)>>2))*64;
  const char*Kbase=shm+LDS_K; bf16x8 kf[8];
  const lds_cptr shm3=(lds_cptr)shm; const lds_cptr kp0=shm3+LDS_K+hi*1024+r32*16; const lds_cptr vp0=shm3+LDS_V+((lane>>4)&1)*32+(lane&3)*8+(4*hi+((lane&15)>>2))*64;
  const int NT=(MODE==0)?((qb>0)?6:4):(q0+QB)/KVBLK;
  typedef __attribute__((address_space(3))) float* lds_fptr;
  const lds_fptr cl=(lds_fptr)((lds_cptr)shm+((MODE==1)?LDS_CL:LDS_CL2));
  if(MODE==0){ if(tid<384)cl[tid]=-slope_l2*(float)tid; }
  DMA_K(0,0);DMA_V(0,0);DMA_K(1,SLOTB);
  bf16x8 qr[4];
  #pragma unroll
  for(int d0=0;d0<4;++d0)qr[d0]=*reinterpret_cast<const bf16x8*>(&Qw[(long)r32*QP+d0*16+hi*8]);
  float mhat=0.f,l_reg=0.f;f32x16 o[2];o[0]=f32x16{};o[1]=f32x16{};
  const int qrel=wid*QBLK+r32;
  asm volatile("s_waitcnt lgkmcnt(0)\n\ts_barrier":::"memory");
  const float ct=cl[q0-t0*KVBLK+qrel];
  float nm=ct;
  #define CINIT(I0,I1,t) do{ const lds_fptr cp_=cl+64*(t)+4*hi; _Pragma("unroll") for(int g_=0;g_<4;++g_){ \
      const f32x4v a_=*(const __attribute__((address_space(3))) f32x4v*)(cp_+8*g_), b_=*(const __attribute__((address_space(3))) f32x4v*)(cp_+8*g_+32); \
      _Pragma("unroll") for(int j_=0;j_<4;++j_){ I0[4*g_+j_]=nm-a_[j_]; I1[4*g_+j_]=nm-b_[j_]; } SBAR(); } }while(0)
  #define CMASK(P0,P1,t) do{int ko_=64*((t)-(NT-4)); if(MODE==0||ko_>=0)amask<MODE==0>(P0,P1,ko_,qrel,hi);}while(0)
  bool resc=false;
  #define START(P0,P1) do{ const float rm=rowmax(P0,P1); resc=false; \
    { const float dl=__builtin_fmaxf(rm,-1000.f); mhat=fadd_s(mhat,dl); \
      _Pragma("unroll") for(int r=0;r<16;++r){P0[r]=fsub_s(P0[r],dl);P1[r]=fsub_s(P1[r],dl);} \
      nm=ct-mhat; } \
    _Pragma("unroll") for(int r=0;r<16;++r)P0[r]=__builtin_amdgcn_exp2f(P0[r]); }while(0)
  #define RESC() do{ if(resc){ asm volatile("s_waitcnt lgkmcnt(0)":::"memory"); \
      _Pragma("unroll") for(int d_=0;d_<2;++d_) _Pragma("unroll") for(int r=0;r<16;++r)o[d_][r]*=wsf[crow(r,hi)]; } }while(0)
  f32x16 pA0,pA1,pB0,pB1;
  int sl_prev=0,sl_cur=0,sl_next=SLOTB;
  #define ROT() do{sl_prev=sl_cur;sl_cur=sl_next;sl_next=(sl_next==(NSLOT-1)*SLOTB)?0:sl_next+SLOTB;}while(0)
  DMA_K(2,2*SLOTB);
  WAIT_BAR(3);
  CINIT(pA0,pA1,0); qkt(pA0,pA1,Kbase,qr,r32,hi);asm volatile("s_nop 15\n\ts_nop 7":"+v"(pA0),"+v"(pA1));CMASK(pA0,pA1,0);
  START(pA0,pA1);
  _Pragma("unroll") for(int r=0;r<16;++r)pA1[r]=__builtin_amdgcn_exp2f(pA1[r]);
  WAIT_BAR(0);
  DMA_K(3,0);DMA_V(1,SLOTB);
  ROT();
  kload8(kf,kp0+sl_cur);
  WAIT_BAR(2);
  s16x4 vlo[8],vhi[8]; u32x4 pw0,pw1,pw2,pw3;
  #define PKW(P,B) cvtpk_s(P[B],P[B+1])
  #define PAF(k) __builtin_bit_cast(bf16x8,pw##k)
  #define VFR(i) (bf16x8){vlo[i][0],vlo[i][1],vlo[i][2],vlo[i][3],vhi[i][0],vhi[i][1],vhi[i][2],vhi[i][3]}
  #define PIN(x) asm volatile("":"+v"(x))
  #define MX3(a,b,c) __builtin_fmaxf(__builtin_fmaxf((a),(b)),(c))
  #define GAPA(MF,A0,A1,A2,A3,W0,W1,PW) do{ MF; sacc+=A0; sacc+=A1; sacc+=A2; sacc+=A3; PIN(sacc); W0; W1; PIN(PW); SBAR(); }while(0)
  #define EX(v) __builtin_amdgcn_exp2f(v)
  #define GAPB(MF,X,B) do{ MF; X[B]=EX(X[B]); X[B+1]=EX(X[B+1]); X[B+2]=EX(X[B+2]); X[B+3]=EX(X[B+3]); PIN(X); SBAR(); }while(0)
  #define VRD(i) do{ vlo[i]=vtr(vp_+(((i)>>2)*4096+((i)&3)*1024)); vhi[i]=vtr(vp_+(((i)>>2)*4096+((i)&3)*1024+512)); }while(0)
  #define KRD(G,j) do{ if(G){ kload2(kf,kp0+sl_next,j); SBAR(); } }while(0)
  #define STEP(C0,C1,P0,P1,t,GK,GV,GL) do{ SBAR(); CINIT(C0,C1,t); SBAR(); \
    const lds_cptr vp_=vp0+sl_prev; \
    VRD(0); SBAR(); float sacc=(P0[0]+P0[1]); \
    GAPA(C0=__builtin_amdgcn_mfma_f32_32x32x16_bf16(kf[0],qr[0],C0,0,0,0), P0[2],P0[3],P0[4],P0[5],     pw0[0]=PKW(P0,0), pw0[1]=PKW(P0,2), pw0); \
    VRD(4); SBAR(); GAPA(C1=__builtin_amdgcn_mfma_f32_32x32x16_bf16(kf[1],qr[0],C1,0,0,0), P0[6],P0[7],P0[8],P0[9],     pw0[2]=PKW(P0,4), pw0[3]=PKW(P0,6), pw0); \
    VRD(1); SBAR(); GAPA(C0=__builtin_amdgcn_mfma_f32_32x32x16_bf16(kf[2],qr[1],C0,0,0,0),   P0[10],P0[11],P0[12],P0[13], pw1[0]=PKW(P0,8), pw1[1]=PKW(P0,10), pw1); \
    VRD(5); SBAR(); GAPA(C1=__builtin_amdgcn_mfma_f32_32x32x16_bf16(kf[3],qr[1],C1,0,0,0),   P0[14],P0[15],P1[0],P1[1],   pw1[2]=PKW(P0,12),pw1[3]=PKW(P0,14), pw1); \
    VRD(2); SBAR(); GAPA(C0=__builtin_amdgcn_mfma_f32_32x32x16_bf16(kf[4],qr[2],C0,0,0,0),   P1[2],P1[3],P1[4],P1[5],     pw2[0]=PKW(P1,0), pw2[1]=PKW(P1,2), pw2); \
    VRD(6); SBAR(); GAPA(C1=__builtin_amdgcn_mfma_f32_32x32x16_bf16(kf[5],qr[2],C1,0,0,0),   P1[6],P1[7],P1[8],P1[9],     pw2[2]=PKW(P1,4), pw2[3]=PKW(P1,6), pw2); \
    VRD(3); SBAR(); GAPA(C0=__builtin_amdgcn_mfma_f32_32x32x16_bf16(kf[6],qr[3],C0,0,0,0),   P1[10],P1[11],P1[12],P1[13], pw3[0]=PKW(P1,8), pw3[1]=PKW(P1,10), pw3); \
    VRD(7); SBAR(); GAPA(C1=__builtin_amdgcn_mfma_f32_32x32x16_bf16(kf[7],qr[3],C1,0,0,0),   P1[14],P1[15],0.f,0.f,       pw3[2]=PKW(P1,12),pw3[3]=PKW(P1,14), pw3); \
    l_reg+=sacc; \
    if(GK){DMA_K((t)+3,sl_cur);} if(GV){DMA_V((t)+1,sl_next);} \
    CMASK(C0,C1,t); \
    { float a=MX3(C0[0],C0[1],C1[0]),b=MX3(C0[2],C0[3],C1[1]); a=MX3(a,C1[2],C1[3]); \
      _Pragma("unroll") for(int r=4;r<16;r+=4){a=MX3(a,C0[r],C0[r+1]);b=MX3(b,C0[r+2],C0[r+3]);a=MX3(a,C1[r],C1[r+1]);b=MX3(b,C1[r+2],C1[r+3]);} \
      float rm=__builtin_fmaxf(a,b); { auto rr=__builtin_amdgcn_permlane32_swap(__float_as_uint(rm),__float_as_uint(rm),false,false); rm=__builtin_fmaxf(__uint_as_float(rr[0]),__uint_as_float(rr[1])); } \
      resc=false; \
      if(__builtin_expect(__any(rm>(float)THRL),0)){ const float dl=__builtin_fmaxf(rm,0.f); mhat+=dl; \
        _Pragma("unroll") for(int r=0;r<16;++r){C0[r]-=dl;C1[r]-=dl;} \
        nm=ct-mhat; \
        const float f=__builtin_amdgcn_exp2f(-dl); l_reg*=f; if(hi==0)wsf[r32]=f; resc=true; } } \
    SBAR(); \
    GAPB(o[0]=__builtin_amdgcn_mfma_f32_32x32x16_bf16(PAF(0),VFR(0),o[0],0,0,0), C0,0); \
    GAPB(o[1]=__builtin_amdgcn_mfma_f32_32x32x16_bf16(PAF(0),VFR(4),o[1],0,0,0), C0,4); \
    KRD(GL,0); GAPB(o[0]=__builtin_amdgcn_mfma_f32_32x32x16_bf16(PAF(1),VFR(1),o[0],0,0,0), C0,8); \
    KRD(GL,1); GAPB(o[1]=__builtin_amdgcn_mfma_f32_32x32x16_bf16(PAF(1),VFR(5),o[1],0,0,0), C0,12); \
    KRD(GL,2); GAPB(o[0]=__builtin_amdgcn_mfma_f32_32x32x16_bf16(PAF(2),VFR(2),o[0],0,0,0), C1,0); \
    KRD(GL,3); GAPB(o[1]=__builtin_amdgcn_mfma_f32_32x32x16_bf16(PAF(2),VFR(6),o[1],0,0,0), C1,4); \
    GAPB(o[0]=__builtin_amdgcn_mfma_f32_32x32x16_bf16(PAF(3),VFR(3),o[0],0,0,0), C1,8); \
    GAPB(o[1]=__builtin_amdgcn_mfma_f32_32x32x16_bf16(PAF(3),VFR(7),o[1],0,0,0), C1,12); \
    }while(0)
  #define ACT(tt) ((64*((tt)-(NT-4))+63>=32*wid-127)&&(64*((tt)-(NT-4))<=32*wid+31))
  #define STEPW(C0,C1,P0,P1,t,GK,GV,GL) do{ SBAR(); \
    const bool aq_=ACT(t), ap_=ACT((t)-1); \
    const lds_cptr vp_=vp0+sl_prev; \
    if(ap_){ VRD(0);VRD(4);VRD(1);VRD(5);VRD(2);VRD(6);VRD(3);VRD(7); \
      float sacc=(P0[0]+P0[1]); _Pragma("unroll") for(int r=2;r<16;++r)sacc+=P0[r]; _Pragma("unroll") for(int r=0;r<16;++r)sacc+=P1[r]; l_reg+=sacc; \
      pw0=(u32x4){PKW(P0,0),PKW(P0,2),PKW(P0,4),PKW(P0,6)};pw1=(u32x4){PKW(P0,8),PKW(P0,10),PKW(P0,12),PKW(P0,14)};pw2=(u32x4){PKW(P1,0),PKW(P1,2),PKW(P1,4),PKW(P1,6)};pw3=(u32x4){PKW(P1,8),PKW(P1,10),PKW(P1,12),PKW(P1,14)}; } \
    SBAR(); \
    if(aq_){ CINIT(C0,C1,t); \
      C0=__builtin_amdgcn_mfma_f32_32x32x16_bf16(kf[0],qr[0],C0,0,0,0); C1=__builtin_amdgcn_mfma_f32_32x32x16_bf16(kf[1],qr[0],C1,0,0,0); \
      C0=__builtin_amdgcn_mfma_f32_32x32x16_bf16(kf[2],qr[1],C0,0,0,0); C1=__builtin_amdgcn_mfma_f32_32x32x16_bf16(kf[3],qr[1],C1,0,0,0); \
      C0=__builtin_amdgcn_mfma_f32_32x32x16_bf16(kf[4],qr[2],C0,0,0,0); C1=__builtin_amdgcn_mfma_f32_32x32x16_bf16(kf[5],qr[2],C1,0,0,0); \
      C0=__builtin_amdgcn_mfma_f32_32x32x16_bf16(kf[6],qr[3],C0,0,0,0); C1=__builtin_amdgcn_mfma_f32_32x32x16_bf16(kf[7],qr[3],C1,0,0,0); } \
    if(GK){DMA_K((t)+3,sl_cur);} if(GV){DMA_V((t)+1,sl_next);} \
    resc=false; \
    if(aq_){ CMASK(C0,C1,t); \
      float a=MX3(C0[0],C0[1],C1[0]),b=MX3(C0[2],C0[3],C1[1]); a=MX3(a,C1[2],C1[3]); \
      _Pragma("unroll") for(int r=4;r<16;r+=4){a=MX3(a,C0[r],C0[r+1]);b=MX3(b,C0[r+2],C0[r+3]);a=MX3(a,C1[r],C1[r+1]);b=MX3(b,C1[r+2],C1[r+3]);} \
      float rm=__builtin_fmaxf(a,b); { auto rr=__builtin_amdgcn_permlane32_swap(__float_as_uint(rm),__float_as_uint(rm),false,false); rm=__builtin_fmaxf(__uint_as_float(rr[0]),__uint_as_float(rr[1])); } \
      if(__builtin_expect(__any(rm>(float)THRL),0)){ const float dl=__builtin_fmaxf(rm,0.f); mhat+=dl; \
        _Pragma("unroll") for(int r=0;r<16;++r){C0[r]-=dl;C1[r]-=dl;} \
        nm=ct-mhat; \
        const float f=__builtin_amdgcn_exp2f(-dl); l_reg*=f; if(hi==0)wsf[r32]=f; resc=true; } } \
    SBAR(); \
    if(ap_){ \
      o[0]=__builtin_amdgcn_mfma_f32_32x32x16_bf16(PAF(0),VFR(0),o[0],0,0,0); o[1]=__builtin_amdgcn_mfma_f32_32x32x16_bf16(PAF(0),VFR(4),o[1],0,0,0); \
      o[0]=__builtin_amdgcn_mfma_f32_32x32x16_bf16(PAF(1),VFR(1),o[0],0,0,0); o[1]=__builtin_amdgcn_mfma_f32_32x32x16_bf16(PAF(1),VFR(5),o[1],0,0,0); \
      o[0]=__builtin_amdgcn_mfma_f32_32x32x16_bf16(PAF(2),VFR(2),o[0],0,0,0); o[1]=__builtin_amdgcn_mfma_f32_32x32x16_bf16(PAF(2),VFR(6),o[1],0,0,0); \
      o[0]=__builtin_amdgcn_mfma_f32_32x32x16_bf16(PAF(3),VFR(3),o[0],0,0,0); o[1]=__builtin_amdgcn_mfma_f32_32x32x16_bf16(PAF(3),VFR(7),o[1],0,0,0); } \
    if((GL)&&ACT((t)+1)){ kload2(kf,kp0+sl_next,0); kload2(kf,kp0+sl_next,1); kload2(kf,kp0+sl_next,2); kload2(kf,kp0+sl_next,3); } \
    if(aq_){ _Pragma("unroll") for(int r=0;r<16;++r){C0[r]=EX(C0[r]);C1[r]=EX(C1[r]);} } else { C0=f32x16{}; C1=f32x16{}; } \
    SBAR(); \
    }while(0)
  #define STEPX(C0,C1,P0,P1,t,GK,GV,GL) do{ if(MODE==0){ STEPW(C0,C1,P0,P1,t,GK,GV,GL); } else { STEP(C0,C1,P0,P1,t,GK,GV,GL); } }while(0)
  int t=1;
  #undef CMASK
  #define CMASK(P0,P1,t) do{}while(0)
  for(;t+5<NT;t+=2){
    STEP(pB0,pB1,pA0,pA1,t,true,true,true);     WAIT_BAR(2); RESC(); ROT();
    STEP(pA0,pA1,pB0,pB1,t+1,true,true,true);   WAIT_BAR(2); RESC(); ROT();
  }
  #undef CMASK
  #define CMASK(P0,P1,t) do{int ko_=64*((t)-(NT-4)); if(MODE==0||ko_>=0)amask<MODE==0>(P0,P1,ko_,qrel,hi);}while(0)
  #define ENDW(tt) do{ if((tt)+3<NT){WAIT_BAR(2);} else if((tt)+2<NT){WAIT_BAR(1);} else {WAIT_BAR(0);} }while(0)
  for(;t+1<NT;t+=2){
    STEPX(pB0,pB1,pA0,pA1,t,(t+3<NT),(t+1<NT),(t+1<NT));       ENDW(t);   RESC(); ROT();
    STEPX(pA0,pA1,pB0,pB1,t+1,(t+4<NT),(t+2<NT),(t+2<NT));     ENDW(t+1); RESC(); ROT();
  }
  STEPX(pB0,pB1,pA0,pA1,NT-1,false,false,false); RESC();
  if(MODE==1||ACT(NT-1))
  { float sacc=pB0[0]+pB0[1]; _Pragma("unroll") for(int r=2;r<16;++r)sacc+=pB0[r]; _Pragma("unroll") for(int r=0;r<16;++r)sacc+=pB1[r]; l_reg+=sacc;
    pw0=(u32x4){PKW(pB0,0),PKW(pB0,2),PKW(pB0,4),PKW(pB0,6)};pw1=(u32x4){PKW(pB0,8),PKW(pB0,10),PKW(pB0,12),PKW(pB0,14)};pw2=(u32x4){PKW(pB1,0),PKW(pB1,2),PKW(pB1,4),PKW(pB1,6)};pw3=(u32x4){PKW(pB1,8),PKW(pB1,10),PKW(pB1,12),PKW(pB1,14)};
    SBAR(); pv(o,vb0+sl_cur,PAF(0),PAF(1),PAF(2),PAF(3)); }
  #undef PKW
  #undef PAF
  #undef VFR
  #undef PIN
  #undef MX3
  #undef GAPA
  #undef GAPB
  #undef EX
  #undef VRD
  #undef KRD
  #undef STEP
  #undef ENDW
  #undef STEPX
  #undef STEPW
  #undef ACT
  {auto rr=__builtin_amdgcn_permlane32_swap(__float_as_uint(l_reg),__float_as_uint(l_reg),false,false);l_reg=__uint_as_float(rr[0])+__uint_as_float(rr[1]);}
  if(MODE==0)l_reg+=__builtin_amdgcn_exp2f(sink_l2-mhat);
  if(hi==0)wsf[32+r32]=l_reg;asm volatile("s_waitcnt lgkmcnt(0)":::"memory");
  float rli[16];
  #pragma unroll
  for(int r=0;r<16;++r)rli[r]=__builtin_amdgcn_rcpf(wsf[32+crow(r,hi)]);
  bf16*Ow=O+(rowbase+q0+wid*QBLK)*OP+ocol;
  { bf16*stg=(bf16*)(shm+LDS_OST)+wid*2048;
    #pragma unroll
    for(int r=0;r<16;++r){const int orow=crow(r,hi);
      #pragma unroll
      for(int d0=0;d0<2;++d0)stg[orow*64+d0*32+r32]=__float2bfloat16(o[d0][r]*rli[r]);}
    asm volatile("s_waitcnt lgkmcnt(0)":::"memory");
    #pragma unroll
    for(int i=0;i<4;++i){const int row=i*8+(lane>>3),ch=lane&7; const u32x4 v=*(const u32x4*)(stg+row*64+ch*8); ATTN_STORE16(Ow+(long)row*OP+ch*8,v);
      float ss=0.f;
      #pragma unroll
      for(int e=0;e<4;++e){const float lo=__builtin_bit_cast(float,v[e]<<16),hh=__builtin_bit_cast(float,v[e]&0xffff0000u); ss+=lo*lo+hh*hh;}
      ss+=__shfl_xor(ss,1); ss+=__shfl_xor(ss,2); ss+=__shfl_xor(ss,4);
      if(ch==0)__hip_atomic_fetch_add(ssq+(rowbase+q0+wid*QBLK+row)*2+MODE,ss,__ATOMIC_RELAXED,__HIP_MEMORY_SCOPE_AGENT); } }
  asm volatile("s_waitcnt lgkmcnt(0)\n\ts_barrier":::"memory");
  #undef CINIT
  #undef DMA_K
  #undef DMA_V
  #undef CMASK
  #undef START
  #undef RESC
  #undef ROT
}
constexpr int ATTN_LDS_BYTES=LDS_BYTES;
#undef SBAR
#undef WAIT_BAR
}

__device__ __forceinline__ void fox_cumsum(const float* Ft, float bias, int b, int h, char* lds) {
    typedef __attribute__((address_space(3))) float* lds_fptr; typedef __attribute__((address_space(3))) const char* lds_cptr;
    const lds_fptr cl = (lds_fptr)((lds_cptr)lds + attn_body::LDS_CL), wt = (lds_fptr)((lds_cptr)lds + attn_body::LDS_WT);
    int tid = threadIdx.x; asm volatile("" : "+v"(tid));
    const int lane = tid & 63, wave = tid >> 6;
    const f32x4* f = (const f32x4*)(Ft + (size_t)h * M + (size_t)b * SEQ + 8 * tid);
    const f32x4 a = f[0], c = f[1];
    float v[8] = {a[0], a[1], a[2], a[3], c[0], c[1], c[2], c[3]};
#pragma unroll
    for (int k = 0; k < 8; ++k) v[k] = log_sigmoid(v[k] + bias);
#pragma unroll
    for (int k = 1; k < 8; ++k) v[k] += v[k - 1];
    float inc = v[7];
#pragma unroll
    for (int o = 1; o < 64; o <<= 1) { const float t = __shfl_up(inc, o); if (lane >= o) inc += t; }
    if (lane == 63) wt[wave] = inc;
    __syncthreads();
    float base = inc - v[7];
#pragma unroll
    for (int w = 0; w < 8; ++w) if (w < wave) base += wt[w];
    *(__attribute__((address_space(3))) f32x4*)(cl + 8 * tid) = (f32x4){(v[0] + base) * LOG2E, (v[1] + base) * LOG2E, (v[2] + base) * LOG2E, (v[3] + base) * LOG2E};
    *(__attribute__((address_space(3))) f32x4*)(cl + 8 * tid + 4) = (f32x4){(v[4] + base) * LOG2E, (v[5] + base) * LOG2E, (v[6] + base) * LOG2E, (v[7] + base) * LOG2E};
    __syncthreads();
}
__device__ __forceinline__ void attn_phase(const Ptrs& P, char* lds) {
    unsigned char* ws = P.ws;
    const int G = gridDim.x, bx = blockIdx.x, vcu0 = (G % 8 == 0) ? (bx % 8) * (G / 8) + bx / 8 : bx;
    for (int v = vcu0; v < 256; v += G) {
        const int bh = v >> 2, s = v & 3, b = bh >> 4, h = bh & 15;
        fox_cumsum((const float*)(ws + WS_F), P.b_forget[h], b, h, lds);
        for (int i = 0; i < 4; ++i) {
            const int qb = (i == 0) ? s : (i == 1) ? 7 - s : (i == 2) ? 8 + s : 15 - s;
            attn_body::attn_unit<60, 1>(b, h, qb, (const attn_body::bf16*)(ws + WS_QB), (const attn_body::bf16*)(ws + WS_KB), (const attn_body::bf16*)(ws + WS_VB), 1024, h * 64,
                                        (attn_body::bf16*)(ws + WS_O), 1024 + h * 64, (float*)(ws + WS_CS), 0.f, 0.f, lds);
        }
        for (int i = 0; i < 4; ++i) {
            const int qb = (i == 0) ? s : (i == 1) ? 7 - s : (i == 2) ? 8 + s : 15 - s;
            attn_body::attn_unit<8, 0>(b, h, qb, (const attn_body::bf16*)(ws + WS_QA), (const attn_body::bf16*)(ws + WS_KA), (const attn_body::bf16*)(ws + WS_VA), 128, (h >> 3) * 64,
                                       (attn_body::bf16*)(ws + WS_O), h * 64, (float*)(ws + WS_CS), exp2f(-0.5f * (float)(h + 1)) * LOG2E, P.sinks[h] * LOG2E, lds);
        }
    }
}
#define LAS __attribute__((address_space(3)))
#define XB_TMO      128
#define XB_XCNT(j)  (256  + 64 * (j))
#define XB_XSUB(j)  (1280 + 64 * (j))
#define XB_XGEN(j)  (2304 + 64 * (j))
#define XB_TOP      3328
#define XB_TOPGEN   3392
#define XCD_BAR_WORDS 3456
#define XB_SPIN_CAP (1u << 18)

__device__ __forceinline__ unsigned xb_ld(unsigned* p)              { return __hip_atomic_load(p, __ATOMIC_RELAXED, __HIP_MEMORY_SCOPE_AGENT); }
__device__ __forceinline__ unsigned xb_add(unsigned* p, unsigned v) { return __hip_atomic_fetch_add(p, v, __ATOMIC_RELAXED, __HIP_MEMORY_SCOPE_AGENT); }
__device__ __forceinline__ unsigned xb_xcc_id() { return (unsigned)__builtin_amdgcn_s_getreg((3 << 11) | 20) & 0xFu; }
#define XB_SPIN(cond, bar) do { unsigned _sp = 0; while (cond) { __builtin_amdgcn_s_sleep(1); \
    if ((++_sp & 255u) == 0u) { if (xb_ld(&(bar)[XB_TMO])) break; if (_sp > XB_SPIN_CAP) { atomicAdd(&(bar)[XB_TMO], 1u); break; } } } } while (0)

struct XcdBarrier {
    unsigned* bar; unsigned x;
    volatile LAS unsigned* st;
};

__device__ __forceinline__ XcdBarrier xcd_barrier_post(unsigned* bar, volatile LAS unsigned* st) {
    XcdBarrier b; b.bar = bar; b.x = xb_xcc_id(); b.st = st;
    if (threadIdx.x == 0) (void)xb_add(&bar[XB_XCNT(b.x)], 1u);
    return b;
}
__device__ __forceinline__ void xcd_barrier_complete(unsigned* bar, unsigned x, unsigned& nloc, unsigned& nx) {
    const unsigned G = gridDim.x * gridDim.y * gridDim.z;
    unsigned sum, cnt, mine, sp = 0u;
    for (;;) {
        sum = 0u; cnt = 0u; mine = 0u;
#pragma unroll
        for (unsigned j = 0; j < 16; ++j) { const unsigned c = xb_ld(&bar[XB_XCNT(j)]); sum += c; cnt += (c > 0u) ? 1u : 0u; mine = (j == x) ? c : mine; }
        if (sum == G) break;
        __builtin_amdgcn_s_sleep(1);
        if ((++sp & 255u) == 0u) { if (xb_ld(&bar[XB_TMO])) break; if (sp > XB_SPIN_CAP) { atomicAdd(&bar[XB_TMO], 1u); break; } }
    }
    nloc = mine > 0u ? mine : 1u; nx = cnt > 0u ? cnt : 1u;
}

__device__ __forceinline__ void xcd_barrier(const XcdBarrier& b) {
    asm volatile("s_waitcnt vmcnt(0)" ::: "memory");
    __syncthreads();
    if (threadIdx.x == 0) {
        unsigned* bar = b.bar;
        __builtin_amdgcn_s_waitcnt(0);
        unsigned nloc = b.st[0], nx = b.st[1];
        if (nloc == 0u) { xcd_barrier_complete(bar, b.x, nloc, nx); b.st[0] = nloc; b.st[1] = nx; }
        const unsigned old = xb_add(&bar[XB_XSUB(b.x)], 1u);
        const unsigned gen = old / nloc;
        if (old + 1u == (gen + 1u) * nloc) {
            __builtin_amdgcn_fence(__ATOMIC_RELEASE, "agent");
            asm volatile("s_waitcnt vmcnt(0)" ::: "memory");
            const unsigned og = xb_add(&bar[XB_TOP], 1u);
            const unsigned tg = og / nx;
            if (og + 1u == (tg + 1u) * nx) xb_add(&bar[XB_TOPGEN], 1u);
            else XB_SPIN(xb_ld(&bar[XB_TOPGEN]) == tg, bar);
            __builtin_amdgcn_fence(__ATOMIC_ACQUIRE, "agent");
            xb_add(&bar[XB_XGEN(b.x)], 1u);
            asm volatile("s_waitcnt vmcnt(0)" ::: "memory");
        } else {
            XB_SPIN(xb_ld(&bar[XB_XGEN(b.x)]) == gen, bar);
            __builtin_amdgcn_fence(__ATOMIC_ACQUIRE, "agent");
            asm volatile("s_waitcnt vmcnt(0)" ::: "memory");
        }
    }
    __syncthreads();
}

constexpr int LDS_BYTES = 147456;
__global__ void __launch_bounds__(512, 2) mega_fwd(Ptrs P) {
    extern __shared__ __attribute__((aligned(16))) unsigned char lds[];
    cg::grid_group grid = cg::this_grid();
    if (P.use_cg) grid.sync();
    unsigned char* ws = P.ws;
    PG8_LAS unsigned char* ldsp = (PG8_LAS unsigned char*)lds;
    const int NGW = gridDim.x * 8;
    volatile LAS unsigned* bst = (volatile LAS unsigned*)(ldsp + 143360);
    if (threadIdx.x == 0) { bst[0] = 0u; bst[1] = 0u; }
    __syncthreads();
    const XcdBarrier bar = xcd_barrier_post((unsigned*)(ws + WS_CTL), bst);
#define GRID_SYNC() xcd_barrier(bar)
#define FRESH_IDS() int tid_; asm volatile("v_mov_b32 %0, %1" : "=v"(tid_) : "v"(threadIdx.x)); const int lane = tid_ & 63, gw = blockIdx.x * 8 + (tid_ >> 6)
    ph_prologue(P, (float*)lds);
    { FRESH_IDS(); pass_prenorm(P.x, P.pre_mix_g, (bf16_t*)(ws + WS_XN), (float*)(ws + WS_CS + 512 * 1024), gw, NGW, lane); }
    GRID_SYNC();
    { pg8::Gemm g{(const bf16_t*)(ws + WS_XN), (const bf16_t*)(ws + WS_WIN), M, DINP, DM}; pg8::StaticOrder S; S.init(M, DINP, (int)gridDim.x, (int)blockIdx.x);
      pg8::gemm_phase<pg8::EpiInProjT, pg8::StaticOrder, true, true>(ldsp, g, S, pg8::EpiInProjT{ws}); }
    if (gridDim.x == 256 && blockIdx.x >= 128) convert_items(P, (float*)lds, I_CUT, I_ALL, (blockIdx.x - 128) * 8 + (threadIdx.x >> 6), 128 * 8);
    GRID_SYNC();
    attn_phase(P, (char*)lds);
    GRID_SYNC();
    { pg8::Gemm g{(const bf16_t*)(ws + WS_O), (const bf16_t*)(ws + WS_WOUT), M, DM, DM}; pg8::StaticOrder S; S.init(M, DM, (int)gridDim.x, (int)blockIdx.x);
      PG8_LAS float* T = (PG8_LAS float*)(ldsp + 139264);
      { pg8::Unit u; const float* SS = (const float*)(ws + WS_CS);
        for (int i = 0; i < 2; ++i) if (S.next(i, u) && threadIdx.x < 256) { const int row = u.pm * 256 + (int)threadIdx.x;
            const float ra = 1.0f / sqrtf(SS[row * 2] * (1.0f / 1024.f) + EPS), rb = 1.0f / sqrtf(SS[row * 2 + 1] * (1.0f / 1024.f) + EPS);
            T[(i * 256 + (int)threadIdx.x) * 2] = ra / rb; T[(i * 256 + (int)threadIdx.x) * 2 + 1] = rb; } }
      __syncthreads();
      pg8::gemm_phase<pg8::EpiOutT, pg8::StaticOrder, true, true>(ldsp, g, S, pg8::EpiOutT{(bf16_t*)(ws + WS_MIX), DM, T}); }
    GRID_SYNC();
    { FRESH_IDS(); pass_postmix((bf16_t*)(ws + WS_XN), (const float*)(ws + WS_CS + 512 * 1024), P.pre_mix_g, (const bf16_t*)(ws + WS_MIX), P.post_mix_g, P.pre_ffn_g, (float*)(ws + WS_CS + 256 * 1024), gw, NGW, lane); }
    GRID_SYNC();
    { pg8::Gemm g{(const bf16_t*)(ws + WS_XN), (const bf16_t*)(ws + WS_WUP), M, NUP, DM}; pg8::StaticOrder S; S.init(M, NUP, (int)gridDim.x, (int)blockIdx.x);
      pg8::gemm_phase<pg8::EpiUpT, pg8::StaticOrder, true, true>(ldsp, g, S, pg8::EpiUpT{(bf16_t*)(ws + WS_ACT), P.conv_w, P.conv_b, (float*)(ws + WS_SIDE), (PG8_LAS float*)(ldsp + 131072)}); }
    GRID_SYNC();
    ph_convfix((const float*)(ws + WS_SIDE), P.conv_w, P.conv_b, (bf16_t*)(ws + WS_ACT));
    GRID_SYNC();
    { pg8::Gemm g{(const bf16_t*)(ws + WS_ACT), (const bf16_t*)(ws + WS_WDN), M, DM, DFF}; pg8::StaticOrder S; S.init(M, DM, (int)gridDim.x, (int)blockIdx.x);
      pg8::gemm_phase<pg8::EpiBf16T, pg8::StaticOrder, true, true>(ldsp, g, S, pg8::EpiBf16T{(bf16_t*)(ws + WS_Y), DM}); }
    GRID_SYNC();
    { FRESH_IDS(); pass_final((const bf16_t*)(ws + WS_XN), (const float*)(ws + WS_CS + 256 * 1024), P.pre_ffn_g, (const bf16_t*)(ws + WS_Y), P.post_ffn_g, P.out, gw, NGW, lane); }
}

extern "C" void kernel_launch(void* const* d_in, const int* in_sizes, int n_in, void* d_out, int out_size, void* d_ws, size_t ws_size, hipStream_t stream) {
    if (n_in != 15 || ws_size < WS_END || out_size != M * DM) { fprintf(stderr, "kernel_launch: unexpected sizes n_in %d ws %zu out %d\n", n_in, ws_size, out_size); return; }
    static int grid_blocks = 0;
    if (!grid_blocks) {
        int dev = 0, cus = 0, per_cu = 0;
        hipGetDevice(&dev);
        hipDeviceGetAttribute(&cus, hipDeviceAttributeMultiprocessorCount, dev);
        if (hipFuncSetAttribute((const void*)mega_fwd, hipFuncAttributeMaxDynamicSharedMemorySize, LDS_BYTES) != hipSuccess) fprintf(stderr, "kernel_launch: hipFuncSetAttribute failed\n");
        hipOccupancyMaxActiveBlocksPerMultiprocessor(&per_cu, (const void*)mega_fwd, 512, LDS_BYTES);
        if (per_cu < 1) { fprintf(stderr, "kernel_launch: occupancy query gave %d\n", per_cu); per_cu = 1; }
        grid_blocks = cus * per_cu;
        if (grid_blocks != 256) fprintf(stderr, "kernel_launch: expected 256 resident workgroups, got %d (the output projection assumes two units per workgroup)\n", grid_blocks);
        (void)hipGetLastError();
    }
    Ptrs P{};
    const float** pp = (const float**)&P;
    for (int i = 0; i < 15; ++i) pp[i] = (const float*)d_in[i];
    P.out = (float*)d_out; P.ws = (unsigned char*)d_ws;
    P.use_cg = 0; P.pad = 0;
    if (hipMemsetAsync((char*)d_ws + WS_CTL, 0, CTL_BYTES, stream) != hipSuccess) { fprintf(stderr, "kernel_launch: hipMemsetAsync failed\n"); return; }
    void* args[] = {&P};
    hipError_t e = hipLaunchCooperativeKernel((const void*)mega_fwd, dim3(grid_blocks), dim3(512), args, LDS_BYTES, stream);
    if (e != hipSuccess) fprintf(stderr, "cooperative launch failed: %s (grid %d)\n", hipGetErrorString(e), grid_blocks);
}
```

```cpp
#include <hip/hip_runtime.h>
#include <hip/hip_cooperative_groups.h>
namespace cg = cooperative_groups;
#include <cstdio>
#include <cstdint>

constexpr int NB = 4, SEQ = 4096, DM = 2048, M = NB * SEQ;
constexpr int HD = 64, NHA = 16, NKVA = 2, NHB = 16, WIN = 128, DFF = 5632, NUP = 2 * DFF;
constexpr int DIN = 4368, DINP = 4608;
constexpr float EPS = 1e-6f;
constexpr float LOG2E = 1.4426950408889634f;
constexpr float C2 = 0.125f * LOG2E;

constexpr size_t MiB = 1u << 20;
constexpr size_t WS_WIN = 0, WS_WOUT = 18 * MiB, WS_WUP = 26 * MiB, WS_WDN = 70 * MiB;
constexpr size_t WS_XN = 92 * MiB;
constexpr size_t WS_CS = 156 * MiB, WS_F = 157 * MiB, WS_SIDE = 158 * MiB;
constexpr size_t WS_QA = 170 * MiB, WS_KA = 202 * MiB, WS_VA = 206 * MiB, WS_QB = 210 * MiB, WS_KB = 242 * MiB, WS_VB = 274 * MiB, WS_O = 306 * MiB;
constexpr size_t WS_ACT = 170 * MiB;
constexpr size_t WS_MIX = 370 * MiB, WS_Y = 434 * MiB;
constexpr size_t WS_CTL = 169 * MiB + 768 * 1024, CTL_BYTES = 64 * 1024;
constexpr size_t WS_END = 498 * MiB;

typedef unsigned short bf16_t;
typedef unsigned v4u __attribute__((ext_vector_type(4)));
typedef float f32x4 __attribute__((ext_vector_type(4)));

__device__ __forceinline__ unsigned f2bf(float f) { unsigned u = __builtin_bit_cast(unsigned, f); return (u + 0x7fffu + ((u >> 16) & 1u)) >> 16; }
__device__ __forceinline__ unsigned pk2(float lo, float hi) { return f2bf(lo) | (f2bf(hi) << 16); }
__device__ __forceinline__ float bf2f(unsigned h) { return __builtin_bit_cast(float, h << 16); }
__device__ __forceinline__ float wave_sum(float v) {
#pragma unroll
    for (int o = 1; o < 64; o <<= 1) v += __shfl_xor(v, o);
    return v;
}
__device__ __forceinline__ float wave_max(float v) {
#pragma unroll
    for (int o = 1; o < 64; o <<= 1) v = fmaxf(v, __shfl_xor(v, o));
    return v;
}

__device__ __forceinline__ int rowmap(int n, int map) {
    if (map == 0) return n;
    if (n < DFF) return ((n >> 7) << 8) + (n & 127);
    const int g = n - DFF; return ((g >> 7) << 8) + 128 + (g & 127);
}
__device__ __forceinline__ void transpose_item(const float* W, int K, int N, int Npad, bf16_t* WT, int map, float* scr, int item, int lane, const float* ks0 = nullptr, const float* ks1 = nullptr) {
    const int nblk = Npad / 32, kb = item / nblk, nb = item % nblk, k0 = 128 * kb, n0 = 32 * nb;
    { const int n4 = lane & 7, n = n0 + 4 * n4;
      f32x4 w[16];
#pragma unroll
      for (int i = 0; i < 16; ++i) { const int kk = (lane >> 3) + 8 * i; w[i] = (n < N) ? __builtin_nontemporal_load((const f32x4*)(W + (size_t)(k0 + kk) * N + n)) : (f32x4){0.f, 0.f, 0.f, 0.f}; }
#pragma unroll
      for (int i = 0; i < 16; ++i) { const int kk = (lane >> 3) + 8 * i;
          if (ks0) w[i] = w[i] * ((k0 < 1024) ? ks0[k0 + kk] : ks1[k0 + kk - 1024]);
#pragma unroll
          for (int j = 0; j < 4; ++j) scr[kk * 33 + 4 * n4 + j] = w[i][j]; } }
    __builtin_amdgcn_s_waitcnt(0); asm volatile("" ::: "memory");
    const int c = lane & 15;
#pragma unroll
    for (int j = 0; j < 8; ++j) { const int n = (lane >> 4) + 4 * j; const float* s = scr + (8 * c) * 33 + n;
        v4u o; o.x = pk2(s[0 * 33], s[1 * 33]); o.y = pk2(s[2 * 33], s[3 * 33]); o.z = pk2(s[4 * 33], s[5 * 33]); o.w = pk2(s[6 * 33], s[7 * 33]);
        *(v4u*)(WT + (size_t)rowmap(n0 + n, map) * K + k0 + 8 * c) = o; }
    __builtin_amdgcn_s_waitcnt(0); asm volatile("" ::: "memory");
}
struct Ptrs {
    const float *x, *pre_mix_g, *w_in, *b_forget, *sinks, *grp_swa_g, *grp_fox_g, *w_out, *post_mix_g, *pre_ffn_g, *w_up, *conv_w, *conv_b, *w_down, *post_ffn_g;
    float* out; unsigned char* ws;
    int use_cg, pad;
};
constexpr int I_IN = (DM / 128) * (DINP / 32), I_OUT = (DM / 128) * (DM / 32), I_UP = (DM / 128) * (NUP / 32), I_DN = (DFF / 128) * (DM / 32);
constexpr int I_CUT = I_IN + I_OUT, I_ALL = I_IN + I_OUT + I_UP + I_DN;
__device__ __forceinline__ void convert_items(const Ptrs& P, float* scr_all, int lo, int hi, int gw, int NGW) {
    const int tid = threadIdx.x, lane = tid & 63, wave = tid >> 6;
    float* scr = scr_all + wave * 128 * 33;
    for (int it = lo + gw; it < hi; it += NGW) {
        int r = it;
        if (r < I_IN) { transpose_item(P.w_in, DM, DIN, DINP, (bf16_t*)(P.ws + WS_WIN), 0, scr, r, lane); continue; } r -= I_IN;
        if (r < I_OUT) { transpose_item(P.w_out, DM, DM, DM, (bf16_t*)(P.ws + WS_WOUT), 0, scr, r, lane, P.grp_swa_g, P.grp_fox_g); continue; } r -= I_OUT;
        if (r < I_UP) { transpose_item(P.w_up, DM, NUP, NUP, (bf16_t*)(P.ws + WS_WUP), 1, scr, r, lane); continue; } r -= I_UP;
        transpose_item(P.w_down, DFF, DM, DM, (bf16_t*)(P.ws + WS_WDN), 0, scr, r, lane);
    }
}
__device__ __forceinline__ void ph_prologue(const Ptrs& P, float* scr_all) {
    const int tid = threadIdx.x;
    const bool defer = (gridDim.x == 256);
    convert_items(P, scr_all, 0, defer ? I_CUT : I_ALL, blockIdx.x * 8 + (tid >> 6), gridDim.x * 8);
    for (int i = blockIdx.x * 512 + tid; i < M * 2; i += gridDim.x * 512) ((float*)(P.ws + WS_CS))[i] = 0.f;
}

__device__ __forceinline__ void row_load(const float* row, int lane, f32x4 (&v)[8]) {
#pragma unroll
    for (int j = 0; j < 8; ++j) v[j] = ((const f32x4*)row)[lane + 64 * j];
}
__device__ __forceinline__ void row_load_bf16(const bf16_t* row, int lane, f32x4 (&v)[8]) {
#pragma unroll
    for (int j = 0; j < 8; ++j) { const unsigned long long w = ((const unsigned long long*)row)[lane + 64 * j];
        v[j] = (f32x4){bf2f((unsigned)w & 0xffffu), bf2f(((unsigned)w >> 16)), bf2f((unsigned)(w >> 32) & 0xffffu), bf2f((unsigned)(w >> 48))}; }
}
__device__ __forceinline__ float row_sumsq(const f32x4 (&v)[8]) {
    float s = 0.f;
#pragma unroll
    for (int j = 0; j < 8; ++j) s += (v[j].x * v[j].x + v[j].y * v[j].y) + (v[j].z * v[j].z + v[j].w * v[j].w);
    return wave_sum(s);
}
__device__ __forceinline__ void row_store_bf16(bf16_t* orow, int lane, const f32x4 (&v)[8]) {
#pragma unroll
    for (int j = 0; j < 8; ++j) ((unsigned long long*)orow)[lane + 64 * j] = (unsigned long long)pk2(v[j].x, v[j].y) | ((unsigned long long)pk2(v[j].z, v[j].w) << 32);
}
__device__ __forceinline__ void pass_prenorm(const float* x, const float* g, bf16_t* xn, float* r0s, int gw, int NGW, int lane) {
    f32x4 gv[8]; row_load(g, lane, gv);
    for (int m = gw; m < M; m += NGW) {
        f32x4 v[8];
#pragma unroll
        for (int j = 0; j < 8; ++j) v[j] = __builtin_nontemporal_load((const f32x4*)(x + (size_t)m * DM) + lane + 64 * j);
        const float r = 1.0f / sqrtf(row_sumsq(v) * (1.0f / DM) + EPS);
#pragma unroll
        for (int j = 0; j < 8; ++j) v[j] = v[j] * r * gv[j];
        row_store_bf16(xn + (size_t)m * DM, lane, v);
        if (lane == 0) r0s[m] = r;
    }
}
__device__ __forceinline__ void pass_postmix(bf16_t* xn, const float* r0s, const float* gpm, const bf16_t* mix, const float* gpost, const float* gpre, float* r2s, int gw, int NGW, int lane) {
    f32x4 ig[8]; row_load(gpm, lane, ig);
#pragma unroll
    for (int j = 0; j < 8; ++j) { ig[j][0] = __builtin_amdgcn_rcpf(ig[j][0]); ig[j][1] = __builtin_amdgcn_rcpf(ig[j][1]); ig[j][2] = __builtin_amdgcn_rcpf(ig[j][2]); ig[j][3] = __builtin_amdgcn_rcpf(ig[j][3]); }
    for (int m = gw; m < M; m += NGW) {
        f32x4 v[8], xv[8], gv[8]; row_load_bf16(mix + (size_t)m * DM, lane, v); row_load_bf16(xn + (size_t)m * DM, lane, xv); row_load(gpost, lane, gv);
        const float ir0 = __builtin_amdgcn_rcpf(r0s[m]);
        const float r = 1.0f / sqrtf(row_sumsq(v) * (1.0f / DM) + EPS);
#pragma unroll
        for (int j = 0; j < 8; ++j) v[j] = xv[j] * ig[j] * ir0 + v[j] * r * gv[j];
        const float r2 = 1.0f / sqrtf(row_sumsq(v) * (1.0f / DM) + EPS);
        row_load(gpre, lane, gv);
#pragma unroll
        for (int j = 0; j < 8; ++j) v[j] = v[j] * r2 * gv[j];
        row_store_bf16(xn + (size_t)m * DM, lane, v);
        if (lane == 0) r2s[m] = r2;
    }
}
__device__ __forceinline__ void pass_final(const bf16_t* xn, const float* r2s, const float* gpre, const bf16_t* y, const float* g, float* out, int gw, int NGW, int lane) {
    f32x4 ig[8]; row_load(gpre, lane, ig);
#pragma unroll
    for (int j = 0; j < 8; ++j) { ig[j][0] = __builtin_amdgcn_rcpf(ig[j][0]); ig[j][1] = __builtin_amdgcn_rcpf(ig[j][1]); ig[j][2] = __builtin_amdgcn_rcpf(ig[j][2]); ig[j][3] = __builtin_amdgcn_rcpf(ig[j][3]); }
    f32x4 gv[8]; row_load(g, lane, gv);
    for (int m = gw; m < M; m += NGW) {
        f32x4 v[8], xv[8]; row_load_bf16(xn + (size_t)m * DM, lane, xv); row_load_bf16(y + (size_t)m * DM, lane, v);
        const float ir2 = __builtin_amdgcn_rcpf(r2s[m]);
        const float r = 1.0f / sqrtf(row_sumsq(v) * (1.0f / DM) + EPS);
#pragma unroll
        for (int j = 0; j < 8; ++j) __builtin_nontemporal_store(xv[j] * ig[j] * ir2 + v[j] * r * gv[j], (f32x4*)(out + (size_t)m * DM) + lane + 64 * j);
    }
}
__device__ __forceinline__ float log_sigmoid(float z) { return z >= 0.f ? -log1pf(expf(-z)) : z - log1pf(expf(z)); }
__device__ __forceinline__ float gelu_tanh(float x) {
    const float z = 0.7978845608028654f * (x + 0.044715f * x * x * x);
    return x / (1.0f + exp2f(-2.0f * LOG2E * z));
}
namespace pg8 {
#define PG8_LAS __attribute__((address_space(3)))
typedef unsigned short bf16_t;
typedef short bf16x8 __attribute__((ext_vector_type(8)));
typedef float f32x4 __attribute__((ext_vector_type(4)));
typedef unsigned u32x4 __attribute__((ext_vector_type(4)));
constexpr int BM = 256, BK = 64, HALF = 128, HTB = HALF * BK * 2  , STAGE_BYTES = 8 * HTB, NXCD = 8, WGM = 8;

__host__ __device__ __forceinline__ int lds_byte(int r, int c) { const int st = (r >> 4) * 2 + (c >> 5), rr = r & 15, cc = c & 31, ob = rr * 64 + cc * 2; return st * 1024 + (ob ^ (((ob >> 9) & 1) << 5)); }
__host__ __device__ __forceinline__ void stage_rc(int b, int& R, int& C) { const int st = b / 1024, sb = b % 1024, swz = sb ^ (((sb >> 9) & 1) << 5); R = (st >> 1) * 16 + swz / 64; C = (st & 1) * 32 + (swz % 64) / 2; }
__host__ __device__ __forceinline__ int perm32(int rho) { const int n = rho >> 4, i = rho & 15; return 8 * (i >> 2) + 4 * n + (i & 3); }

struct Unit { int pm, pn; };
struct Gemm { const bf16_t* A; const bf16_t* Bt; int M, N, K; };

struct StaticOrder {
    int nM, nN, nwg, G, c;
    __host__ __device__ void init(int M, int N, int G_, int c_) { nM = M / BM; nN = N / BM; nwg = nM * nN; G = G_; c = c_; }
    __host__ __device__ bool next(int i, Unit& u) const {
        const long L = (long)i * G + c; if (L >= nwg) return false;
        int wgid = (int)L; { const int q = nwg / NXCD, r = nwg % NXCD, xcd = wgid % NXCD, off = wgid / NXCD; wgid = (xcd < r ? xcd * (q + 1) : r * (q + 1) + (xcd - r) * q) + off; }
        const int nig = WGM * nN, gid = wgid / nig, fm = gid * WGM, gsz = (nM - fm) < WGM ? (nM - fm) : WGM;
        u.pm = fm + ((wgid % nig) % gsz); u.pn = (wgid % nig) / gsz; return true;
    }
    __device__ __forceinline__ void a_ready(const Unit&) const {}
    __device__ __forceinline__ void done(const Unit&) const {}
};

__device__ __forceinline__ unsigned cvt_pk_bf16(float lo, float hi) { unsigned r; asm volatile("v_cvt_pk_bf16_f32 %0, %1, %2" : "=v"(r) : "v"(lo), "v"(hi)); return r; }
typedef float f32x2 __attribute__((ext_vector_type(2)));
template <class Epi, class Sched, bool ALIGN_EPI = false, bool SP2 = false>
__device__ __forceinline__ void gemm_phase(PG8_LAS unsigned char* lds, const Gemm g, const Sched& S, const Epi& E) {
    int tid = threadIdx.x; asm volatile("" : "+v"(tid));
    const int wid = __builtin_amdgcn_readfirstlane(tid >> 6), lane = tid & 63, wr = wid >> 2, wc = wid & 3, fr = lane & 15, fq = lane >> 4;
    const int K = g.K, nt = K / BK;
    unsigned voffA[2], voffB[2];
#pragma unroll
    for (int i = 0; i < 2; ++i) { int R, C; stage_rc(tid * 16 + i * 8192, R, C); const int Rb = Epi::PERM ? ((R & ~31) + perm32(R & 31)) : R;
        voffA[i] = (unsigned)(R * K + C) * 2u; voffB[i] = (unsigned)(Rb * K + C) * 2u; }
    const size_t kstep = (size_t)(BK * 2);
    const size_t hstep = (size_t)HALF * K * 2;
    const size_t tstep = 2 * hstep;
    const unsigned ldsw = (unsigned)wid * 1024u;
    const int aoff = lds_byte(wr * 64 + fr, fq * 8), boff = lds_byte(wc * 32 + fr, fq * 8);
#define PG8_SA(b, h) (((b) * 2 + (h)) * HTB)
#define PG8_SB(b, h) ((4 + (b) * 2 + (h)) * HTB)
    const unsigned ldsb = (unsigned)(uintptr_t)lds + ldsw;
#define PG8_STAGE(bufoff, gbase, voff) do { _Pragma("unroll") for (int _i = 0; _i < 2; ++_i) { unsigned keep_; \
        asm volatile("s_mov_b32 %0, m0\n\ts_mov_b32 m0, %3\n\ts_nop 0\n\tglobal_load_lds_dwordx4 %1, %2\n\ts_mov_b32 m0, %0" : "=&s"(keep_) \
                     : "v"((voff)[_i]), "s"((const char*)(gbase)), "s"((unsigned)__builtin_amdgcn_readfirstlane(ldsb + (unsigned)((bufoff) + _i * 8192))) : "memory"); } } while (0)
#define PG8_LDA(dst, b, h) do { _Pragma("unroll") for (int m = 0; m < 4; ++m) _Pragma("unroll") for (int k = 0; k < 2; ++k) dst[m][k] = *(const PG8_LAS bf16x8*)(lds + PG8_SA(b, h) + aoff + m * 2048 + k * 1024); } while (0)
#define PG8_LDB(dst, b, h) do { _Pragma("unroll") for (int n = 0; n < 2; ++n) _Pragma("unroll") for (int k = 0; k < 2; ++k) dst[n][k] = *(const PG8_LAS bf16x8*)(lds + PG8_SB(b, h) + boff + n * 2048 + k * 1024); } while (0)
#define PG8_MMA(ai, bj, At, Bt) do { __builtin_amdgcn_s_setprio(1); _Pragma("unroll") for (int m = 0; m < 4; ++m) _Pragma("unroll") for (int n = 0; n < 2; ++n) _Pragma("unroll") for (int k = 0; k < 2; ++k) \
        acc[ai][bj][m][n] = __builtin_amdgcn_mfma_f32_16x16x32_bf16(Bt[n][k], At[m][k], acc[ai][bj][m][n], 0, 0, 0); __builtin_amdgcn_s_setprio(0); } while (0)
#define PG8_WAIT_V(n) asm volatile("s_waitcnt vmcnt(" #n ")" ::: "memory")
#define PG8_WAIT_L(n) asm volatile("s_waitcnt lgkmcnt(" #n ")" ::: "memory")
#define PG8_BAR __builtin_amdgcn_s_barrier()
#define PG8_SCHED __builtin_amdgcn_sched_barrier(0)
    Unit cur, nxt; int ui = 0;
    if (!S.next(0, cur)) return;
    f32x4 acc[2][2][4][2];
#pragma unroll
    for (int a = 0; a < 2; ++a)
#pragma unroll
        for (int b = 0; b < 2; ++b)
#pragma unroll
            for (int m = 0; m < 4; ++m)
#pragma unroll
                for (int n = 0; n < 2; ++n) acc[a][b][m][n] = (f32x4){0.f, 0.f, 0.f, 0.f};
    bf16x8 At[4][2], B0[2][2], B1[2][2];
    const char* cA = (const char*)g.A + (size_t)cur.pm * tstep; const char* cB = (const char*)g.Bt + (size_t)cur.pn * tstep;
    S.a_ready(cur);
    if constexpr (SP2) {
        PG8_STAGE(PG8_SB(0, 0), cB, voffB); PG8_STAGE(PG8_SB(0, 1), cB + hstep, voffB); PG8_STAGE(PG8_SA(0, 0), cA, voffA); PG8_STAGE(PG8_SA(0, 1), cA + hstep, voffA);
        if (wr == 1) PG8_BAR;
        PG8_WAIT_V(2); PG8_BAR;
        PG8_STAGE(PG8_SB(1, 0), cB + kstep, voffB); PG8_STAGE(PG8_SA(1, 0), cA + kstep, voffA); PG8_STAGE(PG8_SB(1, 1), cB + hstep + kstep, voffB);
        PG8_WAIT_V(6); PG8_BAR;
    } else {
        PG8_STAGE(PG8_SB(0, 0), cB, voffB); PG8_STAGE(PG8_SA(0, 0), cA, voffA); PG8_STAGE(PG8_SB(0, 1), cB + hstep, voffB); PG8_STAGE(PG8_SA(0, 1), cA + hstep, voffA);
        if (wr == 1) PG8_BAR;
        PG8_WAIT_V(4); PG8_BAR;
        PG8_STAGE(PG8_SB(1, 0), cB + kstep, voffB); PG8_STAGE(PG8_SA(1, 0), cA + kstep, voffA); PG8_STAGE(PG8_SB(1, 1), cB + hstep + kstep, voffB);
        PG8_WAIT_V(6); PG8_BAR;
    }
    for (;;) {
        const bool has_next = S.next(ui + 1, nxt);
        const char* nA = has_next ? (const char*)g.A + (size_t)nxt.pm * tstep : cA; const char* nB = has_next ? (const char*)g.Bt + (size_t)nxt.pn * tstep : cB;
        for (int t = 0; t < nt; t += 2) {
            if constexpr (Epi::MIDK) { if (t == nt / 2) E.midk(acc, ui, wr, fr); }
            const bool last = (t == nt - 2);
            const char* a1 = cA + (size_t)(t + 1) * kstep;
            const char* a2 = last ? nA : cA + (size_t)(t + 2) * kstep; const char* b2 = last ? nB : cB + (size_t)(t + 2) * kstep;
            const char* a3 = a2 + kstep; const char* b3 = b2 + kstep;
            if (last && has_next) S.a_ready(nxt);
            if constexpr (SP2) {
            PG8_LDB(B0, 0, 0); PG8_LDB(B1, 0, 1); PG8_SCHED; PG8_LDA(At, 0, 0); PG8_STAGE(PG8_SA(1, 1), a1 + hstep, voffA);
            PG8_WAIT_V(8); PG8_WAIT_L(0); PG8_BAR; PG8_MMA(0, 0, At, B0); PG8_MMA(0, 1, At, B1); PG8_BAR; PG8_SCHED;
            PG8_LDA(At, 0, 1); PG8_STAGE(PG8_SB(0, 0), b2, voffB); PG8_STAGE(PG8_SB(0, 1), b2 + hstep, voffB); PG8_STAGE(PG8_SA(0, 0), a2, voffA);
            PG8_WAIT_V(8); PG8_WAIT_L(0); PG8_BAR; PG8_MMA(1, 0, At, B0); PG8_MMA(1, 1, At, B1); PG8_BAR; PG8_SCHED;
            PG8_LDB(B0, 1, 0); PG8_LDB(B1, 1, 1); PG8_SCHED; PG8_LDA(At, 1, 0); PG8_STAGE(PG8_SA(0, 1), a2 + hstep, voffA);
            PG8_WAIT_V(8); PG8_WAIT_L(0); PG8_BAR; PG8_MMA(0, 0, At, B0); PG8_MMA(0, 1, At, B1); PG8_BAR; PG8_SCHED;
            PG8_LDA(At, 1, 1); PG8_STAGE(PG8_SB(1, 0), b3, voffB); PG8_STAGE(PG8_SB(1, 1), b3 + hstep, voffB); PG8_STAGE(PG8_SA(1, 0), a3, voffA);
            PG8_WAIT_V(8); PG8_WAIT_L(0); PG8_BAR; PG8_MMA(1, 0, At, B0); PG8_MMA(1, 1, At, B1); PG8_BAR; PG8_SCHED;
            } else {
            PG8_LDB(B0, 0, 0); PG8_SCHED; PG8_LDA(At, 0, 0); PG8_STAGE(PG8_SA(1, 1), a1 + hstep, voffA);
            PG8_WAIT_L(8); PG8_BAR; PG8_WAIT_L(0); PG8_MMA(0, 0, At, B0); PG8_BAR; PG8_SCHED;
            PG8_LDB(B1, 0, 1); PG8_STAGE(PG8_SB(0, 0), b2, voffB);
            PG8_BAR; PG8_WAIT_L(0); PG8_MMA(0, 1, At, B1); PG8_BAR;
            PG8_LDA(At, 0, 1); PG8_STAGE(PG8_SA(0, 0), a2, voffA);
            PG8_BAR; PG8_WAIT_L(0); PG8_MMA(1, 0, At, B0); PG8_BAR; PG8_SCHED;
            PG8_STAGE(PG8_SB(0, 1), b2 + hstep, voffB);
            PG8_WAIT_V(6); PG8_BAR; PG8_MMA(1, 1, At, B1); PG8_BAR;
            PG8_LDB(B0, 1, 0); PG8_SCHED; PG8_LDA(At, 1, 0); PG8_STAGE(PG8_SA(0, 1), a2 + hstep, voffA);
            PG8_WAIT_L(8); PG8_BAR; PG8_WAIT_L(0); PG8_MMA(0, 0, At, B0); PG8_BAR; PG8_SCHED;
            PG8_LDB(B1, 1, 1); PG8_STAGE(PG8_SB(1, 0), b3, voffB);
            PG8_BAR; PG8_WAIT_L(0); PG8_MMA(0, 1, At, B1); PG8_BAR;
            PG8_LDA(At, 1, 1); PG8_STAGE(PG8_SA(1, 0), a3, voffA);
            PG8_BAR; PG8_WAIT_L(0); PG8_MMA(1, 0, At, B0); PG8_BAR; PG8_SCHED;
            PG8_STAGE(PG8_SB(1, 1), b3 + hstep, voffB);
            PG8_WAIT_V(6); PG8_BAR; PG8_MMA(1, 1, At, B1); PG8_BAR;
            }
        }
        if constexpr (ALIGN_EPI) { if (wr == 0) PG8_BAR; }
        if constexpr (Epi::MIDK) { E.epi(acc, cur, ui, wr, wc, fr, fq); S.done(cur); }
        else if constexpr (!Epi::AFTER_DRAIN) { E(acc, cur, wr, wc, fr, fq); S.done(cur); }
        if (!has_next) break;
#pragma unroll
        for (int a = 0; a < 2; ++a)
#pragma unroll
            for (int b = 0; b < 2; ++b)
#pragma unroll
                for (int m = 0; m < 4; ++m)
#pragma unroll
                    for (int n = 0; n < 2; ++n) acc[a][b][m][n] = (f32x4){0.f, 0.f, 0.f, 0.f};
        cur = nxt; cA = nA; cB = nB; ++ui;
        if constexpr (ALIGN_EPI) { if (wr == 1) PG8_BAR; }
    }
    PG8_WAIT_V(0);
    if constexpr (!ALIGN_EPI) { if (wr == 0) PG8_BAR; }
    PG8_BAR;
    if constexpr (Epi::AFTER_DRAIN) { E.fused(acc, cur, wr, wc, fr, fq, lds, wid, lane); S.done(cur); }
#undef PG8_SA
#undef PG8_SB
#undef PG8_STAGE
#undef PG8_LDA
#undef PG8_LDB
#undef PG8_MMA
#undef PG8_WAIT_V
#undef PG8_WAIT_L
#undef PG8_BAR
#undef PG8_SCHED
}
}

namespace pg8 {
struct EpiInProjT {
    static constexpr bool PERM = true, AFTER_DRAIN = false, MIDK = false;
    unsigned char* ws;
    __device__ __forceinline__ void operator()(const f32x4 (&acc)[2][2][4][2], const Unit& u, int wr, int wc, int fr, int fq) const {
        const int row0 = u.pm * BM + wr * 64 + fr, pn = u.pn, cin = wc * 32 + 8 * fq;
        if (pn == 17) {
            if (wc == 0 && fq < 2) { float* F = (float*)(ws + WS_F);
#pragma unroll
                for (int ai = 0; ai < 2; ++ai)
#pragma unroll
                    for (int m = 0; m < 4; ++m)
#pragma unroll
                        for (int n = 0; n < 2; ++n)
#pragma unroll
                            for (int j = 0; j < 4; ++j) F[(size_t)(8 * fq + 4 * n + j) * M + row0 + ai * HALF + m * 16] = acc[ai][0][m][n][j]; }
            return;
        }
        bf16_t *b0, *b1; int ldc; float sc = 1.f;
        if (pn < 4) { b0 = (bf16_t*)(ws + WS_QA) + pn * 256 + cin; b1 = b0 + HALF; ldc = 1024; sc = C2; }
        else if (pn == 4) { b0 = (bf16_t*)(ws + WS_KA) + cin; b1 = (bf16_t*)(ws + WS_VA) + cin; ldc = 128; }
        else if (pn < 9) { b0 = (bf16_t*)(ws + WS_QB) + (pn - 5) * 256 + cin; b1 = b0 + HALF; ldc = 1024; sc = C2; }
        else if (pn < 13) { b0 = (bf16_t*)(ws + WS_KB) + (pn - 9) * 256 + cin; b1 = b0 + HALF; ldc = 1024; }
        else { b0 = (bf16_t*)(ws + WS_VB) + (pn - 13) * 256 + cin; b1 = b0 + HALF; ldc = 1024; }
#pragma unroll
        for (int ai = 0; ai < 2; ++ai)
#pragma unroll
            for (int m = 0; m < 4; ++m) { const size_t ro = (size_t)(row0 + ai * HALF + m * 16) * ldc;
#pragma unroll
                for (int bj = 0; bj < 2; ++bj) { const f32x4 v0 = acc[ai][bj][m][0] * sc, v1 = acc[ai][bj][m][1] * sc;
                    u32x4 w; w.x = cvt_pk_bf16(v0[0], v0[1]); w.y = cvt_pk_bf16(v0[2], v0[3]); w.z = cvt_pk_bf16(v1[0], v1[1]); w.w = cvt_pk_bf16(v1[2], v1[3]);
                    *(u32x4*)((bj ? b1 : b0) + ro) = w; } }
    }
};
struct EpiBf16T {
    static constexpr bool PERM = true, AFTER_DRAIN = false, MIDK = false;
    bf16_t* C; int ldc;
    __device__ __forceinline__ void operator()(const f32x4 (&acc)[2][2][4][2], const Unit& u, int wr, int wc, int fr, int fq) const {
        const int row0 = u.pm * BM + wr * 64 + fr, col0 = u.pn * BM + wc * 32 + 8 * fq;
#pragma unroll
        for (int ai = 0; ai < 2; ++ai)
#pragma unroll
            for (int m = 0; m < 4; ++m) { bf16_t* rp = C + (size_t)(row0 + ai * HALF + m * 16) * ldc + col0;
#pragma unroll
                for (int bj = 0; bj < 2; ++bj) { const f32x4 v0 = acc[ai][bj][m][0], v1 = acc[ai][bj][m][1];
                    u32x4 w; w.x = cvt_pk_bf16(v0[0], v0[1]); w.y = cvt_pk_bf16(v0[2], v0[3]); w.z = cvt_pk_bf16(v1[0], v1[1]); w.w = cvt_pk_bf16(v1[2], v1[3]);
                    *(u32x4*)(rp + bj * HALF) = w; } }
    }
};
struct EpiOutT {
    static constexpr bool PERM = true, AFTER_DRAIN = false, MIDK = true;
    bf16_t* C; int ldc; const PG8_LAS float* T;
    __device__ __forceinline__ void midk(f32x4 (&acc)[2][2][4][2], int ui, int wr, int fr) const {
#pragma unroll
        for (int ai = 0; ai < 2; ++ai)
#pragma unroll
            for (int m = 0; m < 4; ++m) { const float r = T[((ui & 1) * 256 + ai * HALF + wr * 64 + m * 16 + fr) * 2];
#pragma unroll
                for (int bj = 0; bj < 2; ++bj)
#pragma unroll
                    for (int n = 0; n < 2; ++n) acc[ai][bj][m][n] *= r; }
    }
    __device__ __forceinline__ void epi(const f32x4 (&acc)[2][2][4][2], const Unit& u, int ui, int wr, int wc, int fr, int fq) const {
        const int row0 = u.pm * BM + wr * 64 + fr, col0 = u.pn * BM + wc * 32 + 8 * fq;
#pragma unroll
        for (int ai = 0; ai < 2; ++ai)
#pragma unroll
            for (int m = 0; m < 4; ++m) { bf16_t* rp = C + (size_t)(row0 + ai * HALF + m * 16) * ldc + col0; const float r = T[((ui & 1) * 256 + ai * HALF + wr * 64 + m * 16 + fr) * 2 + 1];
#pragma unroll
                for (int bj = 0; bj < 2; ++bj) { const f32x4 v0 = acc[ai][bj][m][0] * r, v1 = acc[ai][bj][m][1] * r;
                    u32x4 w; w.x = cvt_pk_bf16(v0[0], v0[1]); w.y = cvt_pk_bf16(v0[2], v0[3]); w.z = cvt_pk_bf16(v1[0], v1[1]); w.w = cvt_pk_bf16(v1[2], v1[3]);
                    *(u32x4*)(rp + bj * HALF) = w; } }
    }
};
}

namespace pg8 {
__device__ __forceinline__ float dpp_ror1(float x) { return __builtin_bit_cast(float, __builtin_amdgcn_mov_dpp(__builtin_bit_cast(int, x), 0x121, 0xf, 0xf, true)); }
__device__ __forceinline__ float dpp_ror2(float x) { return __builtin_bit_cast(float, __builtin_amdgcn_mov_dpp(__builtin_bit_cast(int, x), 0x122, 0xf, 0xf, true)); }
__device__ __forceinline__ float gelu_tanh_fast(float x) {
    const float e = __builtin_amdgcn_exp2f(-2.3022082f * x * (1.0f + 0.044715f * x * x));
    return x * __builtin_amdgcn_rcpf(1.0f + e);
}
__device__ __forceinline__ f32x4 geglu4(f32x4 g, f32x4 v) {
    const f32x4 t = (g * g) * 0.044715f + 1.0f, a = (g * -2.3022082f) * t;
    f32x4 e; e[0] = __builtin_amdgcn_exp2f(a[0]); e[1] = __builtin_amdgcn_exp2f(a[1]); e[2] = __builtin_amdgcn_exp2f(a[2]); e[3] = __builtin_amdgcn_exp2f(a[3]);
    e = e + 1.0f;
    f32x4 r; r[0] = __builtin_amdgcn_rcpf(e[0]); r[1] = __builtin_amdgcn_rcpf(e[1]); r[2] = __builtin_amdgcn_rcpf(e[2]); r[3] = __builtin_amdgcn_rcpf(e[3]);
    return (g * v) * r;
}
constexpr size_t SIDE_HEAD = 0, SIDE_TAIL = 6 * MiB;
struct EpiUpT {
    static constexpr bool PERM = true, AFTER_DRAIN = false, MIDK = false;
    bf16_t* act; const float* cw; const float* cb; float* side; PG8_LAS float* X;
    __device__ __forceinline__ void operator()(const f32x4 (&acc)[2][2][4][2], const Unit& u, int wr, int wc, int fr, int fq) const {
        const int cin = wc * 32 + 8 * fq;
        f32x4 Wt[2][2][4];
#define EPIUP_LOADW(n_) do { _Pragma("unroll") for (int bj_ = 0; bj_ < 2; ++bj_) { const int col_ = bj_ * DFF + HALF * u.pn + cin + 4 * (n_); \
            if ((n_) == 0) Wt[n_][bj_][0] = *(const f32x4*)(cw + col_); Wt[n_][bj_][1] = *(const f32x4*)(cw + NUP + col_); Wt[n_][bj_][2] = *(const f32x4*)(cw + 2 * NUP + col_); } } while (0)
#define EPIUP_LOADB(n_) do { _Pragma("unroll") for (int bj_ = 0; bj_ < 2; ++bj_) { Wt[n_][bj_][3] = *(const f32x4*)(cb + bj_ * DFF + HALF * u.pn + cin + 4 * (n_)); if ((n_) == 1) Wt[n_][bj_][0] = *(const f32x4*)(cw + bj_ * DFF + HALF * u.pn + cin + 4 * (n_)); } } while (0)
        EPIUP_LOADW(0); EPIUP_LOADB(0); EPIUP_LOADW(1);
        if (fr >= 14) {
#pragma unroll
            for (int ai = 0; ai < 2; ++ai)
#pragma unroll
                for (int bj = 0; bj < 2; ++bj)
#pragma unroll
                    for (int n = 0; n < 2; ++n) *(PG8_LAS f32x4*)(X + ((2 * ai + wr) * 2 + (fr - 14)) * 256 + bj * HALF + cin + 4 * n) = acc[ai][bj][3][n];
            if (wr == 1) {
#pragma unroll
                for (int bj = 0; bj < 2; ++bj)
#pragma unroll
                    for (int n = 0; n < 2; ++n) *(f32x4*)(side + SIDE_TAIL / 4 + ((size_t)u.pm * 2 + (fr - 14)) * NUP + u.pn * BM + bj * HALF + cin + 4 * n) = acc[1][bj][3][n];
            }
        }
        if (fr < 2 && wr == 0) {
#pragma unroll
            for (int bj = 0; bj < 2; ++bj)
#pragma unroll
                for (int n = 0; n < 2; ++n) *(f32x4*)(side + SIDE_HEAD / 4 + ((size_t)u.pm * 2 + fr) * NUP + u.pn * BM + bj * HALF + cin + 4 * n) = acc[0][bj][0][n];
        }
        asm volatile("s_waitcnt lgkmcnt(0)" ::: "memory"); __builtin_amdgcn_s_barrier(); asm volatile("" ::: "memory");
#pragma unroll
        for (int ai = 0; ai < 2; ++ai) {
            const int b4 = 2 * ai + wr;
            typedef unsigned u32x2v __attribute__((ext_vector_type(2)));
            u32x2v st[4];
#pragma unroll
            for (int n = 0; n < 2; ++n) {
                f32x4 p1[2], p2[2];
#pragma unroll
                for (int bj = 0; bj < 2; ++bj) {
                    f32x4 h62 = (f32x4){0.f, 0.f, 0.f, 0.f}, h63 = h62;
                    if (b4 > 0) { h62 = *(const PG8_LAS f32x4*)(X + ((b4 - 1) * 2 + 0) * 256 + bj * HALF + cin + 4 * n); h63 = *(const PG8_LAS f32x4*)(X + ((b4 - 1) * 2 + 1) * 256 + bj * HALF + cin + 4 * n); }
                    p1[bj] = h63; p2[bj] = (fr == 1) ? h63 : h62;
                }
#pragma unroll
                for (int m = 0; m < 4; ++m) {
                    f32x4 y[2];
#pragma unroll
                    for (int bj = 0; bj < 2; ++bj) {
                        const f32x4 v = acc[ai][bj][m][n];
                        f32x4 r1, r2;
#pragma unroll
                        for (int j = 0; j < 4; ++j) { r1[j] = dpp_ror1(v[j]); r2[j] = dpp_ror2(v[j]); }
                        const f32x4 q1 = (fr >= 1) ? r1 : p1[bj], q2 = (fr >= 2) ? r2 : p2[bj];
                        y[bj] = (Wt[n][bj][2] * v + Wt[n][bj][1] * q1) + (Wt[n][bj][0] * q2 + Wt[n][bj][3]);
                        p1[bj] = r1; p2[bj] = r2;
                    }
                    const f32x4 o4 = geglu4(y[0], y[1]); u32x2v w; w.x = cvt_pk_bf16(o4[0], o4[1]); w.y = cvt_pk_bf16(o4[2], o4[3]);
                    if (n == 0) st[m] = w;
                    else __builtin_nontemporal_store((u32x4){st[m].x, st[m].y, w.x, w.y}, (u32x4*)(act + (size_t)(u.pm * BM + ai * HALF + wr * 64 + m * 16 + fr) * DFF + HALF * u.pn + cin));
                    __builtin_amdgcn_sched_barrier(0);
                }
                if (ai == 0 && n == 0) { EPIUP_LOADB(1); __builtin_amdgcn_sched_barrier(0); }
            }
            asm volatile("" ::: "memory"); __builtin_amdgcn_sched_barrier(0);
        }
#undef EPIUP_LOADW
#undef EPIUP_LOADB
    }
};
}
__device__ __forceinline__ void ph_convfix(const float* side, const float* cw, const float* cb, bf16_t* act) {
    const float* head = side + pg8::SIDE_HEAD / 4; const float* tail = side + pg8::SIDE_TAIL / 4;
    for (int idx = blockIdx.x * 512 + threadIdx.x; idx < 64 * 2 * DFF; idx += gridDim.x * 512) {
        const int pm = idx / (2 * DFF), r = (idx / DFF) & 1, n = idx % DFF;
        if ((pm & 15) == 0) continue;
        const int pg = ((n >> 7) << 8) + (n & 127);
        float y[2];
#pragma unroll
        for (int h = 0; h < 2; ++h) { const int pc = pg + 128 * h, col = h * DFF + n;
            const float H0 = head[((size_t)pm * 2 + 0) * NUP + pc], H1 = head[((size_t)pm * 2 + 1) * NUP + pc];
            const float T0 = tail[((size_t)(pm - 1) * 2 + 0) * NUP + pc], T1 = tail[((size_t)(pm - 1) * 2 + 1) * NUP + pc];
            const float w0 = cw[col], w1 = cw[NUP + col], w2 = cw[2 * NUP + col];
            y[h] = cb[col] + (r == 0 ? (w2 * H0 + w1 * T1 + w0 * T0) : (w2 * H1 + w1 * H0 + w0 * T1)); }
        act[(size_t)(256 * pm + r) * DFF + n] = (bf16_t)f2bf(gelu_tanh(y[0]) * y[1]);
    }
}
#include <hip/hip_bf16.h>
#include <cmath>
namespace attn_body {
using bf16=__hip_bfloat16;
using bf16x8=__attribute__((ext_vector_type(8)))short;
using s16x4=__attribute__((ext_vector_type(4)))short;
using f32x16=__attribute__((ext_vector_type(16)))float;
using u32x4=__attribute__((ext_vector_type(4)))unsigned;
using f32x4v=__attribute__((ext_vector_type(4)))float;
constexpr int BATCH=4,NHEAD=16,SEQ=4096,D=64,QP=1024,OP=2048;
constexpr int NW=8,QBLK=32,QB=QBLK*NW,KVBLK=64,NQB=SEQ/QB;
constexpr int ATTN_UNIT_ROWS=QB;
__device__ __forceinline__ int crow(int r,int hi){return (r&3)+8*(r>>2)+4*hi;}
#define SBAR() __builtin_amdgcn_sched_barrier(0)
template<bool WIN> __device__ __forceinline__ void amask(f32x16&p0,f32x16&p1,int koff,int qrel,int hi){
  const float NEG=-INFINITY; int d=qrel-(koff+4*hi); asm volatile("":"+v"(d));
  #pragma unroll
  for(int r=0;r<16;++r){const int kc=(r&3)+8*(r>>2);
    if(kc>d||(WIN&&kc<=d-128))p0[r]=NEG; if(kc+32>d||(WIN&&kc+32<=d-128))p1[r]=NEG;}
}

constexpr int NSLOT=3, SLOTB=8192;
constexpr int LDS_K=0, LDS_V=NSLOT*SLOTB, LDS_WS=2*NSLOT*SLOTB, LDS_OST=LDS_WS+NW*64*4, LDS_CL=LDS_OST+NW*4096+2048, LDS_CL2=LDS_CL+SEQ*4, LDS_WT=LDS_CL2+384*4, LDS_BYTES=LDS_WT+64;
constexpr float C2=0.125f*1.4426950408889634f;
__device__ __forceinline__ void glds16(const void*gsrc,unsigned lds_dst){unsigned keep;
  asm volatile("s_mov_b32 %0, m0\n\ts_mov_b32 m0, %2\n\ts_nop 0\n\tglobal_load_lds_dwordx4 %1, off\n\ts_mov_b32 m0, %0":"=&s"(keep):"v"(gsrc),"s"(lds_dst):"memory");}
__device__ __forceinline__ float max3f(float a,float b,float c){float r;asm("v_max3_f32 %0, %1, %2, %3":"=v"(r):"v"(a),"v"(b),"v"(c));return r;}
__device__ __forceinline__ float max2f(float a,float b){float r;asm("v_max_f32_e32 %0, %1, %2":"=v"(r):"v"(a),"v"(b));return r;}
__device__ __forceinline__ float fadd_s(float a,float b){float r;asm("v_add_f32_e32 %0, %1, %2":"=v"(r):"v"(a),"v"(b));return r;}
__device__ __forceinline__ float fsub_s(float a,float b){float r;asm("v_sub_f32_e32 %0, %1, %2":"=v"(r):"v"(a),"v"(b));return r;}
typedef float f32x2_t __attribute__((ext_vector_type(2))); typedef __bf16 bf16x2_t __attribute__((ext_vector_type(2)));
__device__ __forceinline__ unsigned cvtpk_s(float lo,float hi){f32x2_t v={lo,hi};bf16x2_t b=__builtin_convertvector(v,bf16x2_t);return __builtin_bit_cast(unsigned,b);}
#define WAIT_BAR(N) asm volatile("s_waitcnt vmcnt(" #N ") lgkmcnt(0)\n\ts_barrier":::"memory")

__device__ __forceinline__ void qkt(f32x16&p0,f32x16&p1,const char*Kslot,const bf16x8*qr,int r32,int hi){
  const char*kb=Kslot+hi*1024+r32*16;
  #pragma unroll
  for(int d0=0;d0<4;++d0){
    const bf16x8 b0=*reinterpret_cast<const bf16x8*>(kb+d0*2048);
    const bf16x8 b1=*reinterpret_cast<const bf16x8*>(kb+d0*2048+512);
    if(d0==0){p0=__builtin_amdgcn_mfma_f32_32x32x16_bf16(b0,qr[0],p0,0,0,0);p1=__builtin_amdgcn_mfma_f32_32x32x16_bf16(b1,qr[0],p1,0,0,0);}
    else{p0=__builtin_amdgcn_mfma_f32_32x32x16_bf16(b0,qr[d0],p0,0,0,0);p1=__builtin_amdgcn_mfma_f32_32x32x16_bf16(b1,qr[d0],p1,0,0,0);}}
}
typedef __attribute__((address_space(3))) const char* lds_cptr;
typedef short v4i16_t __attribute__((ext_vector_type(4)));
__device__ __forceinline__ void kload8(bf16x8*kf,lds_cptr kp){
  kf[0]=*(const __attribute__((address_space(3))) bf16x8*)(kp);      kf[1]=*(const __attribute__((address_space(3))) bf16x8*)(kp+512);
  kf[2]=*(const __attribute__((address_space(3))) bf16x8*)(kp+2048); kf[3]=*(const __attribute__((address_space(3))) bf16x8*)(kp+2560);
  kf[4]=*(const __attribute__((address_space(3))) bf16x8*)(kp+4096); kf[5]=*(const __attribute__((address_space(3))) bf16x8*)(kp+4608);
  kf[6]=*(const __attribute__((address_space(3))) bf16x8*)(kp+6144); kf[7]=*(const __attribute__((address_space(3))) bf16x8*)(kp+6656);
}
__device__ __forceinline__ void kload2(bf16x8*kf,lds_cptr kp,int j){ kf[2*j]=*(const __attribute__((address_space(3))) bf16x8*)(kp+j*2048); kf[2*j+1]=*(const __attribute__((address_space(3))) bf16x8*)(kp+j*2048+512); }
__device__ __forceinline__ s16x4 vtr(lds_cptr p){ return __builtin_bit_cast(s16x4,__builtin_amdgcn_ds_read_tr16_b64_v4i16((__attribute__((address_space(3))) v4i16_t*)p)); }
__device__ __forceinline__ float rowmax(const f32x16&p0,const f32x16&p1){
  float a=max3f(p0[0],p0[1],p1[0]),b=max3f(p0[2],p0[3],p1[1]);a=max3f(a,p1[2],p1[3]);
  #pragma unroll
  for(int r=4;r<16;r+=4){a=max3f(a,p0[r],p0[r+1]);b=max3f(b,p0[r+2],p0[r+3]);a=max3f(a,p1[r],p1[r+1]);b=max3f(b,p1[r+2],p1[r+3]);}
  const float m=max2f(a,b);
  auto rr=__builtin_amdgcn_permlane32_swap(__float_as_uint(m),__float_as_uint(m),false,false);
  return max2f(__uint_as_float(rr[0]),__uint_as_float(rr[1]));
}
__device__ __forceinline__ void pv(f32x16*o,int vb,bf16x8 pa0,bf16x8 pa1,bf16x8 pa2,bf16x8 pa3){
  #pragma unroll
  for(int d0=0;d0<2;++d0){s16x4 lo[4],hi[4];
    #pragma unroll
    for(int ks=0;ks<4;++ks){
      asm volatile("ds_read_b64_tr_b16 %0,%1 offset:%c2":"=&v"(lo[ks]):"v"(vb),"i"(d0*4096+ks*1024):"memory");
      asm volatile("ds_read_b64_tr_b16 %0,%1 offset:%c2":"=&v"(hi[ks]):"v"(vb),"i"(d0*4096+ks*1024+512):"memory");}
    asm volatile("s_waitcnt lgkmcnt(0)":::"memory");SBAR();
    #define PK(k) (bf16x8){lo[k][0],lo[k][1],lo[k][2],lo[k][3],hi[k][0],hi[k][1],hi[k][2],hi[k][3]}
    o[d0]=__builtin_amdgcn_mfma_f32_32x32x16_bf16(pa0,PK(0),o[d0],0,0,0);
    o[d0]=__builtin_amdgcn_mfma_f32_32x32x16_bf16(pa1,PK(1),o[d0],0,0,0);
    o[d0]=__builtin_amdgcn_mfma_f32_32x32x16_bf16(pa2,PK(2),o[d0],0,0,0);
    o[d0]=__builtin_amdgcn_mfma_f32_32x32x16_bf16(pa3,PK(3),o[d0],0,0,0);
    #undef PK
  }
}

#ifndef ATTN_STORE16
#define ATTN_STORE16(p,v) (*(u32x4*)(p)=(v))
#endif
template<int THRL,int MODE> __device__ __forceinline__ void attn_unit(int b,int h,int qb,const bf16*Q,const bf16*__restrict__ K,const bf16*__restrict__ V,int KP,int kvcol,bf16*O,int ocol,float*ssq,float slope_l2,float sink_l2,char*shm){
  int tid=threadIdx.x; asm volatile("":"+v"(tid));
  const int lane=tid&63,r32=lane&31,hi=lane>>5; const int wid=__builtin_amdgcn_readfirstlane(tid>>6);
  const long rowbase=(long)b*SEQ; const int q0=qb*QB;
  const int t0=(MODE==0)?((qb>0)?4*qb-2:0):0;
  const bf16*Qw=Q+(rowbase+q0+wid*QBLK)*QP+h*D;
  const bf16*Kh=K+(rowbase+(long)t0*KVBLK)*KP+kvcol,*Vh=V+(rowbase+(long)t0*KVBLK)*KP+kvcol;
  const unsigned lds0=(unsigned)(uintptr_t)shm;
  float*wsf=(float*)(shm+LDS_WS)+wid*64;
  const bf16*ksrc=Kh+(long)lane*KP+wid*8;
  const bf16*vsrc=Vh+(long)(16*(wid&3)+(lane>>2))*KP+(wid>>2)*32+(lane&3)*8;
  const unsigned kdst=lds0+LDS_K+wid*1024, vdst=lds0+LDS_V+wid*1024;
  #define DMA_K(t,slot) glds16(ksrc+(long)(t)*KVBLK*KP,(unsigned)__builtin_amdgcn_readfirstlane(kdst+(slot)))
  #define DMA_V(t,slot) glds16(vsrc+(long)(t)*KVBLK*KP,(unsigned)__builtin_amdgcn_readfirstlane(vdst+(slot)))
  const int vb0=(int)(lds0+LDS_V)+((lane>>4)&1)*32+(lane&3)*8+(4*hi+((lane&15)>>2))*64;
  const char*Kbase=shm+LDS_K; bf16x8 kf[8];
  const lds_cptr shm3=(lds_cptr)shm; const lds_cptr kp0=shm3+LDS_K+hi*1024+r32*16; const lds_cptr vp0=shm3+LDS_V+((lane>>4)&1)*32+(lane&3)*8+(4*hi+((lane&15)>>2))*64;
  const int NT=(MODE==0)?((qb>0)?6:4):(q0+QB)/KVBLK;
  typedef __attribute__((address_space(3))) float* lds_fptr;
  const lds_fptr cl=(lds_fptr)((lds_cptr)shm+((MODE==1)?LDS_CL:LDS_CL2));
  if(MODE==0){ if(tid<384)cl[tid]=-slope_l2*(float)tid; }
  DMA_K(0,0);DMA_V(0,0);DMA_K(1,SLOTB);
  bf16x8 qr[4];
  #pragma unroll
  for(int d0=0;d0<4;++d0)qr[d0]=*reinterpret_cast<const bf16x8*>(&Qw[(long)r32*QP+d0*16+hi*8]);
  float mhat=0.f,l_reg=0.f;f32x16 o[2];o[0]=f32x16{};o[1]=f32x16{};
  const int qrel=wid*QBLK+r32;
  asm volatile("s_waitcnt lgkmcnt(0)\n\ts_barrier":::"memory");
  const float ct=cl[q0-t0*KVBLK+qrel];
  float nm=ct;
  #define CINIT(I0,I1,t) do{ const lds_fptr cp_=cl+64*(t)+4*hi; _Pragma("unroll") for(int g_=0;g_<4;++g_){ \
      const f32x4v a_=*(const __attribute__((address_space(3))) f32x4v*)(cp_+8*g_), b_=*(const __attribute__((address_space(3))) f32x4v*)(cp_+8*g_+32); \
      _Pragma("unroll") for(int j_=0;j_<4;++j_){ I0[4*g_+j_]=nm-a_[j_]; I1[4*g_+j_]=nm-b_[j_]; } SBAR(); } }while(0)
  #define CMASK(P0,P1,t) do{int ko_=64*((t)-(NT-4)); if(MODE==0||ko_>=0)amask<MODE==0>(P0,P1,ko_,qrel,hi);}while(0)
  bool resc=false;
  #define START(P0,P1) do{ const float rm=rowmax(P0,P1); resc=false; \
    { const float dl=__builtin_fmaxf(rm,-1000.f); mhat=fadd_s(mhat,dl); \
      _Pragma("unroll") for(int r=0;r<16;++r){P0[r]=fsub_s(P0[r],dl);P1[r]=fsub_s(P1[r],dl);} \
      nm=ct-mhat; } \
    _Pragma("unroll") for(int r=0;r<16;++r)P0[r]=__builtin_amdgcn_exp2f(P0[r]); }while(0)
  #define RESC() do{ if(resc){ asm volatile("s_waitcnt lgkmcnt(0)":::"memory"); \
      _Pragma("unroll") for(int d_=0;d_<2;++d_) _Pragma("unroll") for(int r=0;r<16;++r)o[d_][r]*=wsf[crow(r,hi)]; } }while(0)
  f32x16 pA0,pA1,pB0,pB1;
  int sl_prev=0,sl_cur=0,sl_next=SLOTB;
  #define ROT() do{sl_prev=sl_cur;sl_cur=sl_next;sl_next=(sl_next==(NSLOT-1)*SLOTB)?0:sl_next+SLOTB;}while(0)
  DMA_K(2,2*SLOTB);
  WAIT_BAR(3);
  CINIT(pA0,pA1,0); qkt(pA0,pA1,Kbase,qr,r32,hi);asm volatile("s_nop 15\n\ts_nop 7":"+v"(pA0),"+v"(pA1));CMASK(pA0,pA1,0);
  START(pA0,pA1);
  _Pragma("unroll") for(int r=0;r<16;++r)pA1[r]=__builtin_amdgcn_exp2f(pA1[r]);
  WAIT_BAR(0);
  DMA_K(3,0);DMA_V(1,SLOTB);
  ROT();
  kload8(kf,kp0+sl_cur);
  WAIT_BAR(2);
  s16x4 vlo[8],vhi[8]; u32x4 pw0,pw1,pw2,pw3;
  #define PKW(P,B) cvtpk_s(P[B],P[B+1])
  #define PAF(k) __builtin_bit_cast(bf16x8,pw##k)
  #define VFR(i) (bf16x8){vlo[i][0],vlo[i][1],vlo[i][2],vlo[i][3],vhi[i][0],vhi[i][1],vhi[i][2],vhi[i][3]}
  #define PIN(x) asm volatile("":"+v"(x))
  #define MX3(a,b,c) __builtin_fmaxf(__builtin_fmaxf((a),(b)),(c))
  #define GAPA(MF,A0,A1,A2,A3,W0,W1,PW) do{ MF; sacc+=A0; sacc+=A1; sacc+=A2; sacc+=A3; PIN(sacc); W0; W1; PIN(PW); SBAR(); }while(0)
  #define EX(v) __builtin_amdgcn_exp2f(v)
  #define GAPB(MF,X,B) do{ MF; X[B]=EX(X[B]); X[B+1]=EX(X[B+1]); X[B+2]=EX(X[B+2]); X[B+3]=EX(X[B+3]); PIN(X); SBAR(); }while(0)
  #define VRD(i) do{ vlo[i]=vtr(vp_+(((i)>>2)*4096+((i)&3)*1024)); vhi[i]=vtr(vp_+(((i)>>2)*4096+((i)&3)*1024+512)); }while(0)
  #define KRD(G,j) do{ if(G){ kload2(kf,kp0+sl_next,j); SBAR(); } }while(0)
  #define STEP(C0,C1,P0,P1,t,GK,GV,GL) do{ SBAR(); CINIT(C0,C1,t); SBAR(); \
    const lds_cptr vp_=vp0+sl_prev; \
    VRD(0); SBAR(); float sacc=(P0[0]+P0[1]); \
    GAPA(C0=__builtin_amdgcn_mfma_f32_32x32x16_bf16(kf[0],qr[0],C0,0,0,0), P0[2],P0[3],P0[4],P0[5],     pw0[0]=PKW(P0,0), pw0[1]=PKW(P0,2), pw0); \
    VRD(4); SBAR(); GAPA(C1=__builtin_amdgcn_mfma_f32_32x32x16_bf16(kf[1],qr[0],C1,0,0,0), P0[6],P0[7],P0[8],P0[9],     pw0[2]=PKW(P0,4), pw0[3]=PKW(P0,6), pw0); \
    VRD(1); SBAR(); GAPA(C0=__builtin_amdgcn_mfma_f32_32x32x16_bf16(kf[2],qr[1],C0,0,0,0),   P0[10],P0[11],P0[12],P0[13], pw1[0]=PKW(P0,8), pw1[1]=PKW(P0,10), pw1); \
    VRD(5); SBAR(); GAPA(C1=__builtin_amdgcn_mfma_f32_32x32x16_bf16(kf[3],qr[1],C1,0,0,0),   P0[14],P0[15],P1[0],P1[1],   pw1[2]=PKW(P0,12),pw1[3]=PKW(P0,14), pw1); \
    VRD(2); SBAR(); GAPA(C0=__builtin_amdgcn_mfma_f32_32x32x16_bf16(kf[4],qr[2],C0,0,0,0),   P1[2],P1[3],P1[4],P1[5],     pw2[0]=PKW(P1,0), pw2[1]=PKW(P1,2), pw2); \
    VRD(6); SBAR(); GAPA(C1=__builtin_amdgcn_mfma_f32_32x32x16_bf16(kf[5],qr[2],C1,0,0,0),   P1[6],P1[7],P1[8],P1[9],     pw2[2]=PKW(P1,4), pw2[3]=PKW(P1,6), pw2); \
    VRD(3); SBAR(); GAPA(C0=__builtin_amdgcn_mfma_f32_32x32x16_bf16(kf[6],qr[3],C0,0,0,0),   P1[10],P1[11],P1[12],P1[13], pw3[0]=PKW(P1,8), pw3[1]=PKW(P1,10), pw3); \
    VRD(7); SBAR(); GAPA(C1=__builtin_amdgcn_mfma_f32_32x32x16_bf16(kf[7],qr[3],C1,0,0,0),   P1[14],P1[15],0.f,0.f,       pw3[2]=PKW(P1,12),pw3[3]=PKW(P1,14), pw3); \
    l_reg+=sacc; \
    if(GK){DMA_K((t)+3,sl_cur);} if(GV){DMA_V((t)+1,sl_next);} \
    CMASK(C0,C1,t); \
    { float a=MX3(C0[0],C0[1],C1[0]),b=MX3(C0[2],C0[3],C1[1]); a=MX3(a,C1[2],C1[3]); \
      _Pragma("unroll") for(int r=4;r<16;r+=4){a=MX3(a,C0[r],C0[r+1]);b=MX3(b,C0[r+2],C0[r+3]);a=MX3(a,C1[r],C1[r+1]);b=MX3(b,C1[r+2],C1[r+3]);} \
      float rm=__builtin_fmaxf(a,b); { auto rr=__builtin_amdgcn_permlane32_swap(__float_as_uint(rm),__float_as_uint(rm),false,false); rm=__builtin_fmaxf(__uint_as_float(rr[0]),__uint_as_float(rr[1])); } \
      resc=false; \
      if(__builtin_expect(__any(rm>(float)THRL),0)){ const float dl=__builtin_fmaxf(rm,0.f); mhat+=dl; \
        _Pragma("unroll") for(int r=0;r<16;++r){C0[r]-=dl;C1[r]-=dl;} \
        nm=ct-mhat; \
        const float f=__builtin_amdgcn_exp2f(-dl); l_reg*=f; if(hi==0)wsf[r32]=f; resc=true; } } \
    SBAR(); \
    GAPB(o[0]=__builtin_amdgcn_mfma_f32_32x32x16_bf16(PAF(0),VFR(0),o[0],0,0,0), C0,0); \
    GAPB(o[1]=__builtin_amdgcn_mfma_f32_32x32x16_bf16(PAF(0),VFR(4),o[1],0,0,0), C0,4); \
    KRD(GL,0); GAPB(o[0]=__builtin_amdgcn_mfma_f32_32x32x16_bf16(PAF(1),VFR(1),o[0],0,0,0), C0,8); \
    KRD(GL,1); GAPB(o[1]=__builtin_amdgcn_mfma_f32_32x32x16_bf16(PAF(1),VFR(5),o[1],0,0,0), C0,12); \
    KRD(GL,2); GAPB(o[0]=__builtin_amdgcn_mfma_f32_32x32x16_bf16(PAF(2),VFR(2),o[0],0,0,0), C1,0); \
    KRD(GL,3); GAPB(o[1]=__builtin_amdgcn_mfma_f32_32x32x16_bf16(PAF(2),VFR(6),o[1],0,0,0), C1,4); \
    GAPB(o[0]=__builtin_amdgcn_mfma_f32_32x32x16_bf16(PAF(3),VFR(3),o[0],0,0,0), C1,8); \
    GAPB(o[1]=__builtin_amdgcn_mfma_f32_32x32x16_bf16(PAF(3),VFR(7),o[1],0,0,0), C1,12); \
    }while(0)
  #define ACT(tt) ((64*((tt)-(NT-4))+63>=32*wid-127)&&(64*((tt)-(NT-4))<=32*wid+31))
  #define STEPW(C0,C1,P0,P1,t,GK,GV,GL) do{ SBAR(); \
    const bool aq_=ACT(t), ap_=ACT((t)-1); \
    const lds_cptr vp_=vp0+sl_prev; \
    if(ap_){ VRD(0);VRD(4);VRD(1);VRD(5);VRD(2);VRD(6);VRD(3);VRD(7); \
      float sacc=(P0[0]+P0[1]); _Pragma("unroll") for(int r=2;r<16;++r)sacc+=P0[r]; _Pragma("unroll") for(int r=0;r<16;++r)sacc+=P1[r]; l_reg+=sacc; \
      pw0=(u32x4){PKW(P0,0),PKW(P0,2),PKW(P0,4),PKW(P0,6)};pw1=(u32x4){PKW(P0,8),PKW(P0,10),PKW(P0,12),PKW(P0,14)};pw2=(u32x4){PKW(P1,0),PKW(P1,2),PKW(P1,4),PKW(P1,6)};pw3=(u32x4){PKW(P1,8),PKW(P1,10),PKW(P1,12),PKW(P1,14)}; } \
    SBAR(); \
    if(aq_){ CINIT(C0,C1,t); \
      C0=__builtin_amdgcn_mfma_f32_32x32x16_bf16(kf[0],qr[0],C0,0,0,0); C1=__builtin_amdgcn_mfma_f32_32x32x16_bf16(kf[1],qr[0],C1,0,0,0); \
      C0=__builtin_amdgcn_mfma_f32_32x32x16_bf16(kf[2],qr[1],C0,0,0,0); C1=__builtin_amdgcn_mfma_f32_32x32x16_bf16(kf[3],qr[1],C1,0,0,0); \
      C0=__builtin_amdgcn_mfma_f32_32x32x16_bf16(kf[4],qr[2],C0,0,0,0); C1=__builtin_amdgcn_mfma_f32_32x32x16_bf16(kf[5],qr[2],C1,0,0,0); \
      C0=__builtin_amdgcn_mfma_f32_32x32x16_bf16(kf[6],qr[3],C0,0,0,0); C1=__builtin_amdgcn_mfma_f32_32x32x16_bf16(kf[7],qr[3],C1,0,0,0); } \
    if(GK){DMA_K((t)+3,sl_cur);} if(GV){DMA_V((t)+1,sl_next);} \
    resc=false; \
    if(aq_){ CMASK(C0,C1,t); \
      float a=MX3(C0[0],C0[1],C1[0]),b=MX3(C0[2],C0[3],C1[1]); a=MX3(a,C1[2],C1[3]); \
      _Pragma("unroll") for(int r=4;r<16;r+=4){a=MX3(a,C0[r],C0[r+1]);b=MX3(b,C0[r+2],C0[r+3]);a=MX3(a,C1[r],C1[r+1]);b=MX3(b,C1[r+2],C1[r+3]);} \
      float rm=__builtin_fmaxf(a,b); { auto rr=__builtin_amdgcn_permlane32_swap(__float_as_uint(rm),__float_as_uint(rm),false,false); rm=__builtin_fmaxf(__uint_as_float(rr[0]),__uint_as_float(rr[1])); } \
      if(__builtin_expect(__any(rm>(float)THRL),0)){ const float dl=__builtin_fmaxf(rm,0.f); mhat+=dl; \
        _Pragma("unroll") for(int r=0;r<16;++r){C0[r]-=dl;C1[r]-=dl;} \
        nm=ct-mhat; \
        const float f=__builtin_amdgcn_exp2f(-dl); l_reg*=f; if(hi==0)wsf[r32]=f; resc=true; } } \
    SBAR(); \
    if(ap_){ \
      o[0]=__builtin_amdgcn_mfma_f32_32x32x16_bf16(PAF(0),VFR(0),o[0],0,0,0); o[1]=__builtin_amdgcn_mfma_f32_32x32x16_bf16(PAF(0),VFR(4),o[1],0,0,0); \
      o[0]=__builtin_amdgcn_mfma_f32_32x32x16_bf16(PAF(1),VFR(1),o[0],0,0,0); o[1]=__builtin_amdgcn_mfma_f32_32x32x16_bf16(PAF(1),VFR(5),o[1],0,0,0); \
      o[0]=__builtin_amdgcn_mfma_f32_32x32x16_bf16(PAF(2),VFR(2),o[0],0,0,0); o[1]=__builtin_amdgcn_mfma_f32_32x32x16_bf16(PAF(2),VFR(6),o[1],0,0,0); \
      o[0]=__builtin_amdgcn_mfma_f32_32x32x16_bf16(PAF(3),VFR(3),o[0],0,0,0); o[1]=__builtin_amdgcn_mfma_f32_32x32x16_bf16(PAF(3),VFR(7),o[1],0,0,0); } \
    if((GL)&&ACT((t)+1)){ kload2(kf,kp0+sl_next,0); kload2(kf,kp0+sl_next,1); kload2(kf,kp0+sl_next,2); kload2(kf,kp0+sl_next,3); } \
    if(aq_){ _Pragma("unroll") for(int r=0;r<16;++r){C0[r]=EX(C0[r]);C1[r]=EX(C1[r]);} } else { C0=f32x16{}; C1=f32x16{}; } \
    SBAR(); \
    }while(0)
  #define STEPX(C0,C1,P0,P1,t,GK,GV,GL) do{ if(MODE==0){ STEPW(C0,C1,P0,P1,t,GK,GV,GL); } else { STEP(C0,C1,P0,P1,t,GK,GV,GL); } }while(0)
  int t=1;
  #undef CMASK
  #define CMASK(P0,P1,t) do{}while(0)
  for(;t+5<NT;t+=2){
    STEP(pB0,pB1,pA0,pA1,t,true,true,true);     WAIT_BAR(2); RESC(); ROT();
    STEP(pA0,pA1,pB0,pB1,t+1,true,true,true);   WAIT_BAR(2); RESC(); ROT();
  }
  #undef CMASK
  #define CMASK(P0,P1,t) do{int ko_=64*((t)-(NT-4)); if(MODE==0||ko_>=0)amask<MODE==0>(P0,P1,ko_,qrel,hi);}while(0)
  #define ENDW(tt) do{ if((tt)+3<NT){WAIT_BAR(2);} else if((tt)+2<NT){WAIT_BAR(1);} else {WAIT_BAR(0);} }while(0)
  for(;t+1<NT;t+=2){
    STEPX(pB0,pB1,pA0,pA1,t,(t+3<NT),(t+1<NT),(t+1<NT));       ENDW(t);   RESC(); ROT();
    STEPX(pA0,pA1,pB0,pB1,t+1,(t+4<NT),(t+2<NT),(t+2<NT));     ENDW(t+1); RESC(); ROT();
  }
  STEPX(pB0,pB1,pA0,pA1,NT-1,false,false,false); RESC();
  if(MODE==1||ACT(NT-1))
  { float sacc=pB0[0]+pB0[1]; _Pragma("unroll") for(int r=2;r<16;++r)sacc+=pB0[r]; _Pragma("unroll") for(int r=0;r<16;++r)sacc+=pB1[r]; l_reg+=sacc;
    pw0=(u32x4){PKW(pB0,0),PKW(pB0,2),PKW(pB0,4),PKW(pB0,6)};pw1=(u32x4){PKW(pB0,8),PKW(pB0,10),PKW(pB0,12),PKW(pB0,14)};pw2=(u32x4){PKW(pB1,0),PKW(pB1,2),PKW(pB1,4),PKW(pB1,6)};pw3=(u32x4){PKW(pB1,8),PKW(pB1,10),PKW(pB1,12),PKW(pB1,14)};
    SBAR(); pv(o,vb0+sl_cur,PAF(0),PAF(1),PAF(2),PAF(3)); }
  #undef PKW
  #undef PAF
  #undef VFR
  #undef PIN
  #undef MX3
  #undef GAPA
  #undef GAPB
  #undef EX
  #undef VRD
  #undef KRD
  #undef STEP
  #undef ENDW
  #undef STEPX
  #undef STEPW
  #undef ACT
  {auto rr=__builtin_amdgcn_permlane32_swap(__float_as_uint(l_reg),__float_as_uint(l_reg),false,false);l_reg=__uint_as_float(rr[0])+__uint_as_float(rr[1]);}
  if(MODE==0)l_reg+=__builtin_amdgcn_exp2f(sink_l2-mhat);
  if(hi==0)wsf[32+r32]=l_reg;asm volatile("s_waitcnt lgkmcnt(0)":::"memory");
  float rli[16];
  #pragma unroll
  for(int r=0;r<16;++r)rli[r]=__builtin_amdgcn_rcpf(wsf[32+crow(r,hi)]);
  bf16*Ow=O+(rowbase+q0+wid*QBLK)*OP+ocol;
  { bf16*stg=(bf16*)(shm+LDS_OST)+wid*2048;
    #pragma unroll
    for(int r=0;r<16;++r){const int orow=crow(r,hi);
      #pragma unroll
      for(int d0=0;d0<2;++d0)stg[orow*64+d0*32+r32]=__float2bfloat16(o[d0][r]*rli[r]);}
    asm volatile("s_waitcnt lgkmcnt(0)":::"memory");
    #pragma unroll
    for(int i=0;i<4;++i){const int row=i*8+(lane>>3),ch=lane&7; const u32x4 v=*(const u32x4*)(stg+row*64+ch*8); ATTN_STORE16(Ow+(long)row*OP+ch*8,v);
      float ss=0.f;
      #pragma unroll
      for(int e=0;e<4;++e){const float lo=__builtin_bit_cast(float,v[e]<<16),hh=__builtin_bit_cast(float,v[e]&0xffff0000u); ss+=lo*lo+hh*hh;}
      ss+=__shfl_xor(ss,1); ss+=__shfl_xor(ss,2); ss+=__shfl_xor(ss,4);
      if(ch==0)__hip_atomic_fetch_add(ssq+(rowbase+q0+wid*QBLK+row)*2+MODE,ss,__ATOMIC_RELAXED,__HIP_MEMORY_SCOPE_AGENT); } }
  asm volatile("s_waitcnt lgkmcnt(0)\n\ts_barrier":::"memory");
  #undef CINIT
  #undef DMA_K
  #undef DMA_V
  #undef CMASK
  #undef START
  #undef RESC
  #undef ROT
}
constexpr int ATTN_LDS_BYTES=LDS_BYTES;
#undef SBAR
#undef WAIT_BAR
}

__device__ __forceinline__ void fox_cumsum(const float* Ft, float bias, int b, int h, char* lds) {
    typedef __attribute__((address_space(3))) float* lds_fptr; typedef __attribute__((address_space(3))) const char* lds_cptr;
    const lds_fptr cl = (lds_fptr)((lds_cptr)lds + attn_body::LDS_CL), wt = (lds_fptr)((lds_cptr)lds + attn_body::LDS_WT);
    int tid = threadIdx.x; asm volatile("" : "+v"(tid));
    const int lane = tid & 63, wave = tid >> 6;
    const f32x4* f = (const f32x4*)(Ft + (size_t)h * M + (size_t)b * SEQ + 8 * tid);
    const f32x4 a = f[0], c = f[1];
    float v[8] = {a[0], a[1], a[2], a[3], c[0], c[1], c[2], c[3]};
#pragma unroll
    for (int k = 0; k < 8; ++k) v[k] = log_sigmoid(v[k] + bias);
#pragma unroll
    for (int k = 1; k < 8; ++k) v[k] += v[k - 1];
    float inc = v[7];
#pragma unroll
    for (int o = 1; o < 64; o <<= 1) { const float t = __shfl_up(inc, o); if (lane >= o) inc += t; }
    if (lane == 63) wt[wave] = inc;
    __syncthreads();
    float base = inc - v[7];
#pragma unroll
    for (int w = 0; w < 8; ++w) if (w < wave) base += wt[w];
    *(__attribute__((address_space(3))) f32x4*)(cl + 8 * tid) = (f32x4){(v[0] + base) * LOG2E, (v[1] + base) * LOG2E, (v[2] + base) * LOG2E, (v[3] + base) * LOG2E};
    *(__attribute__((address_space(3))) f32x4*)(cl + 8 * tid + 4) = (f32x4){(v[4] + base) * LOG2E, (v[5] + base) * LOG2E, (v[6] + base) * LOG2E, (v[7] + base) * LOG2E};
    __syncthreads();
}
__device__ __forceinline__ void attn_phase(const Ptrs& P, char* lds) {
    unsigned char* ws = P.ws;
    const int G = gridDim.x, bx = blockIdx.x, vcu0 = (G % 8 == 0) ? (bx % 8) * (G / 8) + bx / 8 : bx;
    for (int v = vcu0; v < 256; v += G) {
        const int bh = v >> 2, s = v & 3, b = bh >> 4, h = bh & 15;
        fox_cumsum((const float*)(ws + WS_F), P.b_forget[h], b, h, lds);
        for (int i = 0; i < 4; ++i) {
            const int qb = (i == 0) ? s : (i == 1) ? 7 - s : (i == 2) ? 8 + s : 15 - s;
            attn_body::attn_unit<60, 1>(b, h, qb, (const attn_body::bf16*)(ws + WS_QB), (const attn_body::bf16*)(ws + WS_KB), (const attn_body::bf16*)(ws + WS_VB), 1024, h * 64,
                                        (attn_body::bf16*)(ws + WS_O), 1024 + h * 64, (float*)(ws + WS_CS), 0.f, 0.f, lds);
        }
        for (int i = 0; i < 4; ++i) {
            const int qb = (i == 0) ? s : (i == 1) ? 7 - s : (i == 2) ? 8 + s : 15 - s;
            attn_body::attn_unit<8, 0>(b, h, qb, (const attn_body::bf16*)(ws + WS_QA), (const attn_body::bf16*)(ws + WS_KA), (const attn_body::bf16*)(ws + WS_VA), 128, (h >> 3) * 64,
                                       (attn_body::bf16*)(ws + WS_O), h * 64, (float*)(ws + WS_CS), exp2f(-0.5f * (float)(h + 1)) * LOG2E, P.sinks[h] * LOG2E, lds);
        }
    }
}
#define LAS __attribute__((address_space(3)))
#define XB_TMO      128
#define XB_XCNT(j)  (256  + 64 * (j))
#define XB_XSUB(j)  (1280 + 64 * (j))
#define XB_XGEN(j)  (2304 + 64 * (j))
#define XB_TOP      3328
#define XB_TOPGEN   3392
#define XCD_BAR_WORDS 3456
#define XB_SPIN_CAP (1u << 18)

__device__ __forceinline__ unsigned xb_ld(unsigned* p)              { return __hip_atomic_load(p, __ATOMIC_RELAXED, __HIP_MEMORY_SCOPE_AGENT); }
__device__ __forceinline__ unsigned xb_add(unsigned* p, unsigned v) { return __hip_atomic_fetch_add(p, v, __ATOMIC_RELAXED, __HIP_MEMORY_SCOPE_AGENT); }
__device__ __forceinline__ unsigned xb_xcc_id() { return (unsigned)__builtin_amdgcn_s_getreg((3 << 11) | 20) & 0xFu; }
#define XB_SPIN(cond, bar) do { unsigned _sp = 0; while (cond) { __builtin_amdgcn_s_sleep(1); \
    if ((++_sp & 255u) == 0u) { if (xb_ld(&(bar)[XB_TMO])) break; if (_sp > XB_SPIN_CAP) { atomicAdd(&(bar)[XB_TMO], 1u); break; } } } } while (0)

struct XcdBarrier {
    unsigned* bar; unsigned x;
    volatile LAS unsigned* st;
};

__device__ __forceinline__ XcdBarrier xcd_barrier_post(unsigned* bar, volatile LAS unsigned* st) {
    XcdBarrier b; b.bar = bar; b.x = xb_xcc_id(); b.st = st;
    if (threadIdx.x == 0) (void)xb_add(&bar[XB_XCNT(b.x)], 1u);
    return b;
}
__device__ __forceinline__ void xcd_barrier_complete(unsigned* bar, unsigned x, unsigned& nloc, unsigned& nx) {
    const unsigned G = gridDim.x * gridDim.y * gridDim.z;
    unsigned sum, cnt, mine, sp = 0u;
    for (;;) {
        sum = 0u; cnt = 0u; mine = 0u;
#pragma unroll
        for (unsigned j = 0; j < 16; ++j) { const unsigned c = xb_ld(&bar[XB_XCNT(j)]); sum += c; cnt += (c > 0u) ? 1u : 0u; mine = (j == x) ? c : mine; }
        if (sum == G) break;
        __builtin_amdgcn_s_sleep(1);
        if ((++sp & 255u) == 0u) { if (xb_ld(&bar[XB_TMO])) break; if (sp > XB_SPIN_CAP) { atomicAdd(&bar[XB_TMO], 1u); break; } }
    }
    nloc = mine > 0u ? mine : 1u; nx = cnt > 0u ? cnt : 1u;
}

__device__ __forceinline__ void xcd_barrier(const XcdBarrier& b) {
    asm volatile("s_waitcnt vmcnt(0)" ::: "memory");
    __syncthreads();
    if (threadIdx.x == 0) {
        unsigned* bar = b.bar;
        __builtin_amdgcn_s_waitcnt(0);
        unsigned nloc = b.st[0], nx = b.st[1];
        if (nloc == 0u) { xcd_barrier_complete(bar, b.x, nloc, nx); b.st[0] = nloc; b.st[1] = nx; }
        const unsigned old = xb_add(&bar[XB_XSUB(b.x)], 1u);
        const unsigned gen = old / nloc;
        if (old + 1u == (gen + 1u) * nloc) {
            __builtin_amdgcn_fence(__ATOMIC_RELEASE, "agent");
            asm volatile("s_waitcnt vmcnt(0)" ::: "memory");
            const unsigned og = xb_add(&bar[XB_TOP], 1u);
            const unsigned tg = og / nx;
            if (og + 1u == (tg + 1u) * nx) xb_add(&bar[XB_TOPGEN], 1u);
            else XB_SPIN(xb_ld(&bar[XB_TOPGEN]) == tg, bar);
            __builtin_amdgcn_fence(__ATOMIC_ACQUIRE, "agent");
            xb_add(&bar[XB_XGEN(b.x)], 1u);
            asm volatile("s_waitcnt vmcnt(0)" ::: "memory");
        } else {
            XB_SPIN(xb_ld(&bar[XB_XGEN(b.x)]) == gen, bar);
            __builtin_amdgcn_fence(__ATOMIC_ACQUIRE, "agent");
            asm volatile("s_waitcnt vmcnt(0)" ::: "memory");
        }
    }
    __syncthreads();
}

constexpr int LDS_BYTES = 147456;
__global__ void __launch_bounds__(512, 2) mega_fwd(Ptrs P) {
    extern __shared__ __attribute__((aligned(16))) unsigned char lds[];
    cg::grid_group grid = cg::this_grid();
    if (P.use_cg) grid.sync();
    unsigned char* ws = P.ws;
    PG8_LAS unsigned char* ldsp = (PG8_LAS unsigned char*)lds;
    const int NGW = gridDim.x * 8;
    volatile LAS unsigned* bst = (volatile LAS unsigned*)(ldsp + 143360);
    if (threadIdx.x == 0) { bst[0] = 0u; bst[1] = 0u; }
    __syncthreads();
    const XcdBarrier bar = xcd_barrier_post((unsigned*)(ws + WS_CTL), bst);
#define GRID_SYNC() xcd_barrier(bar)
#define FRESH_IDS() int tid_; asm volatile("v_mov_b32 %0, %1" : "=v"(tid_) : "v"(threadIdx.x)); const int lane = tid_ & 63, gw = blockIdx.x * 8 + (tid_ >> 6)
    ph_prologue(P, (float*)lds);
    { FRESH_IDS(); pass_prenorm(P.x, P.pre_mix_g, (bf16_t*)(ws + WS_XN), (float*)(ws + WS_CS + 512 * 1024), gw, NGW, lane); }
    GRID_SYNC();
    { pg8::Gemm g{(const bf16_t*)(ws + WS_XN), (const bf16_t*)(ws + WS_WIN), M, DINP, DM}; pg8::StaticOrder S; S.init(M, DINP, (int)gridDim.x, (int)blockIdx.x);
      pg8::gemm_phase<pg8::EpiInProjT, pg8::StaticOrder, true, true>(ldsp, g, S, pg8::EpiInProjT{ws}); }
    if (gridDim.x == 256 && blockIdx.x >= 128) convert_items(P, (float*)lds, I_CUT, I_ALL, (blockIdx.x - 128) * 8 + (threadIdx.x >> 6), 128 * 8);
    GRID_SYNC();
    attn_phase(P, (char*)lds);
    GRID_SYNC();
    { pg8::Gemm g{(const bf16_t*)(ws + WS_O), (const bf16_t*)(ws + WS_WOUT), M, DM, DM}; pg8::StaticOrder S; S.init(M, DM, (int)gridDim.x, (int)blockIdx.x);
      PG8_LAS float* T = (PG8_LAS float*)(ldsp + 139264);
      { pg8::Unit u; const float* SS = (const float*)(ws + WS_CS);
        for (int i = 0; i < 2; ++i) if (S.next(i, u) && threadIdx.x < 256) { const int row = u.pm * 256 + (int)threadIdx.x;
            const float ra = 1.0f / sqrtf(SS[row * 2] * (1.0f / 1024.f) + EPS), rb = 1.0f / sqrtf(SS[row * 2 + 1] * (1.0f / 1024.f) + EPS);
            T[(i * 256 + (int)threadIdx.x) * 2] = ra / rb; T[(i * 256 + (int)threadIdx.x) * 2 + 1] = rb; } }
      __syncthreads();
      pg8::gemm_phase<pg8::EpiOutT, pg8::StaticOrder, true, true>(ldsp, g, S, pg8::EpiOutT{(bf16_t*)(ws + WS_MIX), DM, T}); }
    GRID_SYNC();
    { FRESH_IDS(); pass_postmix((bf16_t*)(ws + WS_XN), (const float*)(ws + WS_CS + 512 * 1024), P.pre_mix_g, (const bf16_t*)(ws + WS_MIX), P.post_mix_g, P.pre_ffn_g, (float*)(ws + WS_CS + 256 * 1024), gw, NGW, lane); }
    GRID_SYNC();
    { pg8::Gemm g{(const bf16_t*)(ws + WS_XN), (const bf16_t*)(ws + WS_WUP), M, NUP, DM}; pg8::StaticOrder S; S.init(M, NUP, (int)gridDim.x, (int)blockIdx.x);
      pg8::gemm_phase<pg8::EpiUpT, pg8::StaticOrder, true, true>(ldsp, g, S, pg8::EpiUpT{(bf16_t*)(ws + WS_ACT), P.conv_w, P.conv_b, (float*)(ws + WS_SIDE), (PG8_LAS float*)(ldsp + 131072)}); }
    GRID_SYNC();
    ph_convfix((const float*)(ws + WS_SIDE), P.conv_w, P.conv_b, (bf16_t*)(ws + WS_ACT));
    GRID_SYNC();
    { pg8::Gemm g{(const bf16_t*)(ws + WS_ACT), (const bf16_t*)(ws + WS_WDN), M, DM, DFF}; pg8::StaticOrder S; S.init(M, DM, (int)gridDim.x, (int)blockIdx.x);
      pg8::gemm_phase<pg8::EpiBf16T, pg8::StaticOrder, true, true>(ldsp, g, S, pg8::EpiBf16T{(bf16_t*)(ws + WS_Y), DM}); }
    GRID_SYNC();
    { FRESH_IDS(); pass_final((const bf16_t*)(ws + WS_XN), (const float*)(ws + WS_CS + 256 * 1024), P.pre_ffn_g, (const bf16_t*)(ws + WS_Y), P.post_ffn_g, P.out, gw, NGW, lane); }
}

extern "C" void kernel_launch(void* const* d_in, const int* in_sizes, int n_in, void* d_out, int out_size, void* d_ws, size_t ws_size, hipStream_t stream) {
    if (n_in != 15 || ws_size < WS_END || out_size != M * DM) { fprintf(stderr, "kernel_launch: unexpected sizes n_in %d ws %zu out %d\n", n_in, ws_size, out_size); return; }
    static int grid_blocks = 0;
    if (!grid_blocks) {
        int dev = 0, cus = 0, per_cu = 0;
        hipGetDevice(&dev);
        hipDeviceGetAttribute(&cus, hipDeviceAttributeMultiprocessorCount, dev);
        if (hipFuncSetAttribute((const void*)mega_fwd, hipFuncAttributeMaxDynamicSharedMemorySize, LDS_BYTES) != hipSuccess) fprintf(stderr, "kernel_launch: hipFuncSetAttribute failed\n");
        hipOccupancyMaxActiveBlocksPerMultiprocessor(&per_cu, (const void*)mega_fwd, 512, LDS_BYTES);
        if (per_cu < 1) { fprintf(stderr, "kernel_launch: occupancy query gave %d\n", per_cu); per_cu = 1; }
        grid_blocks = cus * per_cu;
        if (grid_blocks != 256) fprintf(stderr, "kernel_launch: expected 256 resident workgroups, got %d (the output projection assumes two units per workgroup)\n", grid_blocks);
        (void)hipGetLastError();
    }
    Ptrs P{};
    const float** pp = (const float**)&P;
    for (int i = 0; i < 15; ++i) pp[i] = (const float*)d_in[i];
    P.out = (float*)d_out; P.ws = (unsigned char*)d_ws;
    P.use_cg = 0; P.pad = 0;
    if (hipMemsetAsync((char*)d_ws + WS_CTL, 0, CTL_BYTES, stream) != hipSuccess) { fprintf(stderr, "kernel_launch: hipMemsetAsync failed\n"); return; }
    void* args[] = {&P};
    hipError_t e = hipLaunchCooperativeKernel((const void*)mega_fwd, dim3(grid_blocks), dim3(512), args, LDS_BYTES, stream);
    if (e != hipSuccess) fprintf(stderr, "cooperative launch failed: %s (grid %d)\n", hipGetErrorString(e), grid_blocks);
}
```

```cpp
#include <hip/hip_runtime.h>
#include <hip/hip_cooperative_groups.h>
namespace cg = cooperative_groups;
#include <cstdio>
#include <cstdint>

constexpr int NB = 4, SEQ = 4096, DM = 2048, M = NB * SEQ;
constexpr int HD = 64, NHA = 16, NKVA = 2, NHB = 16, WIN = 128, DFF = 5632, NUP = 2 * DFF;
constexpr int DIN = 4368, DINP = 4608;
constexpr float EPS = 1e-6f;
constexpr float LOG2E = 1.4426950408889634f;
constexpr float C2 = 0.125f * LOG2E;

constexpr size_t MiB = 1u << 20;
constexpr size_t WS_WIN = 0, WS_WOUT = 18 * MiB, WS_WUP = 26 * MiB, WS_WDN = 70 * MiB;
constexpr size_t WS_XN = 92 * MiB;
constexpr size_t WS_CS = 156 * MiB, WS_F = 157 * MiB, WS_SIDE = 158 * MiB;
constexpr size_t WS_QA = 170 * MiB, WS_KA = 202 * MiB, WS_VA = 206 * MiB, WS_QB = 210 * MiB, WS_KB = 242 * MiB, WS_VB = 274 * MiB, WS_O = 306 * MiB;
constexpr size_t WS_ACT = 170 * MiB;
constexpr size_t WS_MIX = 370 * MiB, WS_Y = 434 * MiB;
constexpr size_t WS_CTL = 169 * MiB + 768 * 1024, CTL_BYTES = 64 * 1024;
constexpr size_t WS_END = 498 * MiB;

typedef unsigned short bf16_t;
typedef unsigned v4u __attribute__((ext_vector_type(4)));
typedef float f32x4 __attribute__((ext_vector_type(4)));

__device__ __forceinline__ unsigned f2bf(float f) { unsigned u = __builtin_bit_cast(unsigned, f); return (u + 0x7fffu + ((u >> 16) & 1u)) >> 16; }
__device__ __forceinline__ unsigned pk2(float lo, float hi) { return f2bf(lo) | (f2bf(hi) << 16); }
__device__ __forceinline__ float bf2f(unsigned h) { return __builtin_bit_cast(float, h << 16); }
__device__ __forceinline__ float wave_sum(float v) {
#pragma unroll
    for (int o = 1; o < 64; o <<= 1) v += __shfl_xor(v, o);
    return v;
}
__device__ __forceinline__ float wave_max(float v) {
#pragma unroll
    for (int o = 1; o < 64; o <<= 1) v = fmaxf(v, __shfl_xor(v, o));
    return v;
}

__device__ __forceinline__ int rowmap(int n, int map) {
    if (map == 0) return n;
    if (n < DFF) return ((n >> 7) << 8) + (n & 127);
    const int g = n - DFF; return ((g >> 7) << 8) + 128 + (g & 127);
}
__device__ __forceinline__ void transpose_item(const float* W, int K, int N, int Npad, bf16_t* WT, int map, float* scr, int item, int lane, const float* ks0 = nullptr, const float* ks1 = nullptr) {
    const int nblk = Npad / 32, kb = item / nblk, nb = item % nblk, k0 = 128 * kb, n0 = 32 * nb;
    { const int n4 = lane & 7, n = n0 + 4 * n4;
      f32x4 w[16];
#pragma unroll
      for (int i = 0; i < 16; ++i) { const int kk = (lane >> 3) + 8 * i; w[i] = (n < N) ? __builtin_nontemporal_load((const f32x4*)(W + (size_t)(k0 + kk) * N + n)) : (f32x4){0.f, 0.f, 0.f, 0.f}; }
#pragma unroll
      for (int i = 0; i < 16; ++i) { const int kk = (lane >> 3) + 8 * i;
          if (ks0) w[i] = w[i] * ((k0 < 1024) ? ks0[k0 + kk] : ks1[k0 + kk - 1024]);
#pragma unroll
          for (int j = 0; j < 4; ++j) scr[kk * 33 + 4 * n4 + j] = w[i][j]; } }
    __builtin_amdgcn_s_waitcnt(0); asm volatile("" ::: "memory");
    const int c = lane & 15;
#pragma unroll
    for (int j = 0; j < 8; ++j) { const int n = (lane >> 4) + 4 * j; const float* s = scr + (8 * c) * 33 + n;
        v4u o; o.x = pk2(s[0 * 33], s[1 * 33]); o.y = pk2(s[2 * 33], s[3 * 33]); o.z = pk2(s[4 * 33], s[5 * 33]); o.w = pk2(s[6 * 33], s[7 * 33]);
        *(v4u*)(WT + (size_t)rowmap(n0 + n, map) * K + k0 + 8 * c) = o; }
    __builtin_amdgcn_s_waitcnt(0); asm volatile("" ::: "memory");
}
struct Ptrs {
    const float *x, *pre_mix_g, *w_in, *b_forget, *sinks, *grp_swa_g, *grp_fox_g, *w_out, *post_mix_g, *pre_ffn_g, *w_up, *conv_w, *conv_b, *w_down, *post_ffn_g;
    float* out; unsigned char* ws;
    int use_cg, pad;
};
constexpr int I_IN = (DM / 128) * (DINP / 32), I_OUT = (DM / 128) * (DM / 32), I_UP = (DM / 128) * (NUP / 32), I_DN = (DFF / 128) * (DM / 32);
constexpr int I_CUT = I_IN + I_OUT, I_ALL = I_IN + I_OUT + I_UP + I_DN;
__device__ __forceinline__ void convert_items(const Ptrs& P, float* scr_all, int lo, int hi, int gw, int NGW) {
    const int tid = threadIdx.x, lane = tid & 63, wave = tid >> 6;
    float* scr = scr_all + wave * 128 * 33;
    for (int it = lo + gw; it < hi; it += NGW) {
        int r = it;
        if (r < I_IN) { transpose_item(P.w_in, DM, DIN, DINP, (bf16_t*)(P.ws + WS_WIN), 0, scr, r, lane); continue; } r -= I_IN;
        if (r < I_OUT) { transpose_item(P.w_out, DM, DM, DM, (bf16_t*)(P.ws + WS_WOUT), 0, scr, r, lane, P.grp_swa_g, P.grp_fox_g); continue; } r -= I_OUT;
        if (r < I_UP) { transpose_item(P.w_up, DM, NUP, NUP, (bf16_t*)(P.ws + WS_WUP), 1, scr, r, lane); continue; } r -= I_UP;
        transpose_item(P.w_down, DFF, DM, DM, (bf16_t*)(P.ws + WS_WDN), 0, scr, r, lane);
    }
}
__device__ __forceinline__ void ph_prologue(const Ptrs& P, float* scr_all) {
    const int tid = threadIdx.x;
    const bool defer = (gridDim.x == 256);
    convert_items(P, scr_all, 0, defer ? I_CUT : I_ALL, blockIdx.x * 8 + (tid >> 6), gridDim.x * 8);
    (void)tid;
}

__device__ __forceinline__ void row_load(const float* row, int lane, f32x4 (&v)[8]) {
#pragma unroll
    for (int j = 0; j < 8; ++j) v[j] = ((const f32x4*)row)[lane + 64 * j];
}
__device__ __forceinline__ void row_load_bf16(const bf16_t* row, int lane, f32x4 (&v)[8]) {
#pragma unroll
    for (int j = 0; j < 8; ++j) { const unsigned long long w = ((const unsigned long long*)row)[lane + 64 * j];
        v[j] = (f32x4){bf2f((unsigned)w & 0xffffu), bf2f(((unsigned)w >> 16)), bf2f((unsigned)(w >> 32) & 0xffffu), bf2f((unsigned)(w >> 48))}; }
}
__device__ __forceinline__ float row_sumsq(const f32x4 (&v)[8]) {
    float s = 0.f;
#pragma unroll
    for (int j = 0; j < 8; ++j) s += (v[j].x * v[j].x + v[j].y * v[j].y) + (v[j].z * v[j].z + v[j].w * v[j].w);
    return wave_sum(s);
}
__device__ __forceinline__ void row_store_bf16(bf16_t* orow, int lane, const f32x4 (&v)[8]) {
#pragma unroll
    for (int j = 0; j < 8; ++j) ((unsigned long long*)orow)[lane + 64 * j] = (unsigned long long)pk2(v[j].x, v[j].y) | ((unsigned long long)pk2(v[j].z, v[j].w) << 32);
}
__device__ __forceinline__ void pass_prenorm(const float* x, const float* g, bf16_t* xn, float* r0s, int gw, int NGW, int lane) {
    f32x4 gv[8]; row_load(g, lane, gv);
    for (int m = gw; m < M; m += NGW) {
        f32x4 v[8];
#pragma unroll
        for (int j = 0; j < 8; ++j) v[j] = __builtin_nontemporal_load((const f32x4*)(x + (size_t)m * DM) + lane + 64 * j);
        const float r = 1.0f / sqrtf(row_sumsq(v) * (1.0f / DM) + EPS);
#pragma unroll
        for (int j = 0; j < 8; ++j) v[j] = v[j] * r * gv[j];
        row_store_bf16(xn + (size_t)m * DM, lane, v);
        if (lane == 0) r0s[m] = r;
    }
}
__device__ __forceinline__ void pass_postmix(bf16_t* xn, const float* r0s, const float* gpm, const bf16_t* mix, const float* gpost, const float* gpre, float* r2s, int gw, int NGW, int lane) {
    f32x4 ig[8]; row_load(gpm, lane, ig);
#pragma unroll
    for (int j = 0; j < 8; ++j) { ig[j][0] = __builtin_amdgcn_rcpf(ig[j][0]); ig[j][1] = __builtin_amdgcn_rcpf(ig[j][1]); ig[j][2] = __builtin_amdgcn_rcpf(ig[j][2]); ig[j][3] = __builtin_amdgcn_rcpf(ig[j][3]); }
    for (int m = gw; m < M; m += NGW) {
        f32x4 v[8], xv[8], gv[8]; row_load_bf16(mix + (size_t)m * DM, lane, v); row_load_bf16(xn + (size_t)m * DM, lane, xv); row_load(gpost, lane, gv);
        const float ir0 = __builtin_amdgcn_rcpf(r0s[m]);
        const float r = 1.0f / sqrtf(row_sumsq(v) * (1.0f / DM) + EPS);
#pragma unroll
        for (int j = 0; j < 8; ++j) v[j] = xv[j] * ig[j] * ir0 + v[j] * r * gv[j];
        const float r2 = 1.0f / sqrtf(row_sumsq(v) * (1.0f / DM) + EPS);
        row_load(gpre, lane, gv);
#pragma unroll
        for (int j = 0; j < 8; ++j) v[j] = v[j] * r2 * gv[j];
        row_store_bf16(xn + (size_t)m * DM, lane, v);
        if (lane == 0) r2s[m] = r2;
    }
}
__device__ __forceinline__ void pass_final(const bf16_t* xn, const float* r2s, const float* gpre, const bf16_t* y, const float* g, float* out, int gw, int NGW, int lane) {
    f32x4 ig[8]; row_load(gpre, lane, ig);
#pragma unroll
    for (int j = 0; j < 8; ++j) { ig[j][0] = __builtin_amdgcn_rcpf(ig[j][0]); ig[j][1] = __builtin_amdgcn_rcpf(ig[j][1]); ig[j][2] = __builtin_amdgcn_rcpf(ig[j][2]); ig[j][3] = __builtin_amdgcn_rcpf(ig[j][3]); }
    f32x4 gv[8]; row_load(g, lane, gv);
    for (int m = gw; m < M; m += NGW) {
        f32x4 v[8], xv[8]; row_load_bf16(xn + (size_t)m * DM, lane, xv); row_load_bf16(y + (size_t)m * DM, lane, v);
        const float ir2 = __builtin_amdgcn_rcpf(r2s[m]);
        const float r = 1.0f / sqrtf(row_sumsq(v) * (1.0f / DM) + EPS);
#pragma unroll
        for (int j = 0; j < 8; ++j) __builtin_nontemporal_store(xv[j] * ig[j] * ir2 + v[j] * r * gv[j], (f32x4*)(out + (size_t)m * DM) + lane + 64 * j);
    }
}
__device__ __forceinline__ float log_sigmoid(float z) { return z >= 0.f ? -log1pf(expf(-z)) : z - log1pf(expf(z)); }
__device__ __forceinline__ float gelu_tanh(float x) {
    const float z = 0.7978845608028654f * (x + 0.044715f * x * x * x);
    return x / (1.0f + exp2f(-2.0f * LOG2E * z));
}
namespace pg8 {
#define PG8_LAS __attribute__((address_space(3)))
typedef unsigned short bf16_t;
typedef short bf16x8 __attribute__((ext_vector_type(8)));
typedef float f32x4 __attribute__((ext_vector_type(4)));
typedef unsigned u32x4 __attribute__((ext_vector_type(4)));
constexpr int BM = 256, BK = 64, HALF = 128, HTB = HALF * BK * 2  , STAGE_BYTES = 8 * HTB, NXCD = 8, WGM = 8;

__host__ __device__ __forceinline__ int lds_byte(int r, int c) { const int st = (r >> 4) * 2 + (c >> 5), rr = r & 15, cc = c & 31, ob = rr * 64 + cc * 2; return st * 1024 + (ob ^ (((ob >> 9) & 1) << 5)); }
__host__ __device__ __forceinline__ void stage_rc(int b, int& R, int& C) { const int st = b / 1024, sb = b % 1024, swz = sb ^ (((sb >> 9) & 1) << 5); R = (st >> 1) * 16 + swz / 64; C = (st & 1) * 32 + (swz % 64) / 2; }
__host__ __device__ __forceinline__ int perm32(int rho) { const int n = rho >> 4, i = rho & 15; return 8 * (i >> 2) + 4 * n + (i & 3); }

struct Unit { int pm, pn; };
struct Gemm { const bf16_t* A; const bf16_t* Bt; int M, N, K; };

struct StaticOrder {
    int nM, nN, nwg, G, c;
    __host__ __device__ void init(int M, int N, int G_, int c_) { nM = M / BM; nN = N / BM; nwg = nM * nN; G = G_; c = c_; }
    __host__ __device__ bool next(int i, Unit& u) const {
        const long L = (long)i * G + c; if (L >= nwg) return false;
        int wgid = (int)L; { const int q = nwg / NXCD, r = nwg % NXCD, xcd = wgid % NXCD, off = wgid / NXCD; wgid = (xcd < r ? xcd * (q + 1) : r * (q + 1) + (xcd - r) * q) + off; }
        const int nig = WGM * nN, gid = wgid / nig, fm = gid * WGM, gsz = (nM - fm) < WGM ? (nM - fm) : WGM;
        u.pm = fm + ((wgid % nig) % gsz); u.pn = (wgid % nig) / gsz; return true;
    }
    __device__ __forceinline__ void a_ready(const Unit&) const {}
    __device__ __forceinline__ void done(const Unit&) const {}
};

__device__ __forceinline__ unsigned cvt_pk_bf16(float lo, float hi) { unsigned r; asm volatile("v_cvt_pk_bf16_f32 %0, %1, %2" : "=v"(r) : "v"(lo), "v"(hi)); return r; }
typedef float f32x2 __attribute__((ext_vector_type(2)));
template <class Epi, class Sched, bool ALIGN_EPI = false, bool SP2 = false>
__device__ __forceinline__ void gemm_phase(PG8_LAS unsigned char* lds, const Gemm g, const Sched& S, const Epi& E) {
    int tid = threadIdx.x; asm volatile("" : "+v"(tid));
    const int wid = __builtin_amdgcn_readfirstlane(tid >> 6), lane = tid & 63, wr = wid >> 2, wc = wid & 3, fr = lane & 15, fq = lane >> 4;
    const int K = g.K, nt = K / BK;
    unsigned voffA[2], voffB[2];
#pragma unroll
    for (int i = 0; i < 2; ++i) { int R, C; stage_rc(tid * 16 + i * 8192, R, C); const int Rb = Epi::PERM ? ((R & ~31) + perm32(R & 31)) : R;
        voffA[i] = (unsigned)(R * K + C) * 2u; voffB[i] = (unsigned)(Rb * K + C) * 2u; }
    const size_t kstep = (size_t)(BK * 2);
    const size_t hstep = (size_t)HALF * K * 2;
    const size_t tstep = 2 * hstep;
    const unsigned ldsw = (unsigned)wid * 1024u;
    const int aoff = lds_byte(wr * 64 + fr, fq * 8), boff = lds_byte(wc * 32 + fr, fq * 8);
#define PG8_SA(b, h) (((b) * 2 + (h)) * HTB)
#define PG8_SB(b, h) ((4 + (b) * 2 + (h)) * HTB)
    const unsigned ldsb = (unsigned)(uintptr_t)lds + ldsw;
#define PG8_STAGE(bufoff, gbase, voff) do { _Pragma("unroll") for (int _i = 0; _i < 2; ++_i) { unsigned keep_; \
        asm volatile("s_mov_b32 %0, m0\n\ts_mov_b32 m0, %3\n\ts_nop 0\n\tglobal_load_lds_dwordx4 %1, %2\n\ts_mov_b32 m0, %0" : "=&s"(keep_) \
                     : "v"((voff)[_i]), "s"((const char*)(gbase)), "s"((unsigned)__builtin_amdgcn_readfirstlane(ldsb + (unsigned)((bufoff) + _i * 8192))) : "memory"); } } while (0)
#define PG8_LDA(dst, b, h) do { _Pragma("unroll") for (int m = 0; m < 4; ++m) _Pragma("unroll") for (int k = 0; k < 2; ++k) dst[m][k] = *(const PG8_LAS bf16x8*)(lds + PG8_SA(b, h) + aoff + m * 2048 + k * 1024); } while (0)
#define PG8_LDB(dst, b, h) do { _Pragma("unroll") for (int n = 0; n < 2; ++n) _Pragma("unroll") for (int k = 0; k < 2; ++k) dst[n][k] = *(const PG8_LAS bf16x8*)(lds + PG8_SB(b, h) + boff + n * 2048 + k * 1024); } while (0)
#define PG8_MMA(ai, bj, At, Bt) do { __builtin_amdgcn_s_setprio(1); _Pragma("unroll") for (int m = 0; m < 4; ++m) _Pragma("unroll") for (int n = 0; n < 2; ++n) _Pragma("unroll") for (int k = 0; k < 2; ++k) \
        acc[ai][bj][m][n] = __builtin_amdgcn_mfma_f32_16x16x32_bf16(Bt[n][k], At[m][k], acc[ai][bj][m][n], 0, 0, 0); __builtin_amdgcn_s_setprio(0); } while (0)
#define PG8_WAIT_V(n) asm volatile("s_waitcnt vmcnt(" #n ")" ::: "memory")
#define PG8_WAIT_L(n) asm volatile("s_waitcnt lgkmcnt(" #n ")" ::: "memory")
#define PG8_BAR __builtin_amdgcn_s_barrier()
#define PG8_SCHED __builtin_amdgcn_sched_barrier(0)
    Unit cur, nxt; int ui = 0;
    if (!S.next(0, cur)) return;
    f32x4 acc[2][2][4][2];
#pragma unroll
    for (int a = 0; a < 2; ++a)
#pragma unroll
        for (int b = 0; b < 2; ++b)
#pragma unroll
            for (int m = 0; m < 4; ++m)
#pragma unroll
                for (int n = 0; n < 2; ++n) acc[a][b][m][n] = (f32x4){0.f, 0.f, 0.f, 0.f};
    bf16x8 At[4][2], B0[2][2], B1[2][2];
    const char* cA = (const char*)g.A + (size_t)cur.pm * tstep; const char* cB = (const char*)g.Bt + (size_t)cur.pn * tstep;
    S.a_ready(cur);
    if constexpr (SP2) {
        PG8_STAGE(PG8_SB(0, 0), cB, voffB); PG8_STAGE(PG8_SB(0, 1), cB + hstep, voffB); PG8_STAGE(PG8_SA(0, 0), cA, voffA); PG8_STAGE(PG8_SA(0, 1), cA + hstep, voffA);
        if (wr == 1) PG8_BAR;
        PG8_WAIT_V(2); PG8_BAR;
        PG8_STAGE(PG8_SB(1, 0), cB + kstep, voffB); PG8_STAGE(PG8_SA(1, 0), cA + kstep, voffA); PG8_STAGE(PG8_SB(1, 1), cB + hstep + kstep, voffB);
        PG8_WAIT_V(6); PG8_BAR;
    } else {
        PG8_STAGE(PG8_SB(0, 0), cB, voffB); PG8_STAGE(PG8_SA(0, 0), cA, voffA); PG8_STAGE(PG8_SB(0, 1), cB + hstep, voffB); PG8_STAGE(PG8_SA(0, 1), cA + hstep, voffA);
        if (wr == 1) PG8_BAR;
        PG8_WAIT_V(4); PG8_BAR;
        PG8_STAGE(PG8_SB(1, 0), cB + kstep, voffB); PG8_STAGE(PG8_SA(1, 0), cA + kstep, voffA); PG8_STAGE(PG8_SB(1, 1), cB + hstep + kstep, voffB);
        PG8_WAIT_V(6); PG8_BAR;
    }
    for (;;) {
        const bool has_next = S.next(ui + 1, nxt);
        const char* nA = has_next ? (const char*)g.A + (size_t)nxt.pm * tstep : cA; const char* nB = has_next ? (const char*)g.Bt + (size_t)nxt.pn * tstep : cB;
        for (int t = 0; t < nt; t += 2) {
            if constexpr (Epi::MIDK) { if (t == nt / 2) E.midk(acc, ui, wr, fr); }
            const bool last = (t == nt - 2);
            const char* a1 = cA + (size_t)(t + 1) * kstep;
            const char* a2 = last ? nA : cA + (size_t)(t + 2) * kstep; const char* b2 = last ? nB : cB + (size_t)(t + 2) * kstep;
            const char* a3 = a2 + kstep; const char* b3 = b2 + kstep;
            if (last && has_next) S.a_ready(nxt);
            if constexpr (SP2) {
            PG8_LDB(B0, 0, 0); PG8_LDB(B1, 0, 1); PG8_SCHED; PG8_LDA(At, 0, 0); PG8_STAGE(PG8_SA(1, 1), a1 + hstep, voffA);
            PG8_WAIT_V(8); PG8_WAIT_L(0); PG8_BAR; PG8_MMA(0, 0, At, B0); PG8_MMA(0, 1, At, B1); PG8_BAR; PG8_SCHED;
            PG8_LDA(At, 0, 1); PG8_STAGE(PG8_SB(0, 0), b2, voffB); PG8_STAGE(PG8_SB(0, 1), b2 + hstep, voffB); PG8_STAGE(PG8_SA(0, 0), a2, voffA);
            PG8_WAIT_V(8); PG8_WAIT_L(0); PG8_BAR; PG8_MMA(1, 0, At, B0); PG8_MMA(1, 1, At, B1); PG8_BAR; PG8_SCHED;
            PG8_LDB(B0, 1, 0); PG8_LDB(B1, 1, 1); PG8_SCHED; PG8_LDA(At, 1, 0); PG8_STAGE(PG8_SA(0, 1), a2 + hstep, voffA);
            PG8_WAIT_V(8); PG8_WAIT_L(0); PG8_BAR; PG8_MMA(0, 0, At, B0); PG8_MMA(0, 1, At, B1); PG8_BAR; PG8_SCHED;
            PG8_LDA(At, 1, 1); PG8_STAGE(PG8_SB(1, 0), b3, voffB); PG8_STAGE(PG8_SB(1, 1), b3 + hstep, voffB); PG8_STAGE(PG8_SA(1, 0), a3, voffA);
            PG8_WAIT_V(8); PG8_WAIT_L(0); PG8_BAR; PG8_MMA(1, 0, At, B0); PG8_MMA(1, 1, At, B1); PG8_BAR; PG8_SCHED;
            } else {
            PG8_LDB(B0, 0, 0); PG8_SCHED; PG8_LDA(At, 0, 0); PG8_STAGE(PG8_SA(1, 1), a1 + hstep, voffA);
            PG8_WAIT_L(8); PG8_BAR; PG8_WAIT_L(0); PG8_MMA(0, 0, At, B0); PG8_BAR; PG8_SCHED;
            PG8_LDB(B1, 0, 1); PG8_STAGE(PG8_SB(0, 0), b2, voffB);
            PG8_BAR; PG8_WAIT_L(0); PG8_MMA(0, 1, At, B1); PG8_BAR;
            PG8_LDA(At, 0, 1); PG8_STAGE(PG8_SA(0, 0), a2, voffA);
            PG8_BAR; PG8_WAIT_L(0); PG8_MMA(1, 0, At, B0); PG8_BAR; PG8_SCHED;
            PG8_STAGE(PG8_SB(0, 1), b2 + hstep, voffB);
            PG8_WAIT_V(6); PG8_BAR; PG8_MMA(1, 1, At, B1); PG8_BAR;
            PG8_LDB(B0, 1, 0); PG8_SCHED; PG8_LDA(At, 1, 0); PG8_STAGE(PG8_SA(0, 1), a2 + hstep, voffA);
            PG8_WAIT_L(8); PG8_BAR; PG8_WAIT_L(0); PG8_MMA(0, 0, At, B0); PG8_BAR; PG8_SCHED;
            PG8_LDB(B1, 1, 1); PG8_STAGE(PG8_SB(1, 0), b3, voffB);
            PG8_BAR; PG8_WAIT_L(0); PG8_MMA(0, 1, At, B1); PG8_BAR;
            PG8_LDA(At, 1, 1); PG8_STAGE(PG8_SA(1, 0), a3, voffA);
            PG8_BAR; PG8_WAIT_L(0); PG8_MMA(1, 0, At, B0); PG8_BAR; PG8_SCHED;
            PG8_STAGE(PG8_SB(1, 1), b3 + hstep, voffB);
            PG8_WAIT_V(6); PG8_BAR; PG8_MMA(1, 1, At, B1); PG8_BAR;
            }
        }
        if constexpr (ALIGN_EPI) { if (wr == 0) PG8_BAR; }
        if constexpr (Epi::MIDK) { E.epi(acc, cur, ui, wr, wc, fr, fq); S.done(cur); }
        else if constexpr (!Epi::AFTER_DRAIN) { E(acc, cur, wr, wc, fr, fq); S.done(cur); }
        if (!has_next) break;
#pragma unroll
        for (int a = 0; a < 2; ++a)
#pragma unroll
            for (int b = 0; b < 2; ++b)
#pragma unroll
                for (int m = 0; m < 4; ++m)
#pragma unroll
                    for (int n = 0; n < 2; ++n) acc[a][b][m][n] = (f32x4){0.f, 0.f, 0.f, 0.f};
        cur = nxt; cA = nA; cB = nB; ++ui;
        if constexpr (ALIGN_EPI) { if (wr == 1) PG8_BAR; }
    }
    PG8_WAIT_V(0);
    if constexpr (!ALIGN_EPI) { if (wr == 0) PG8_BAR; }
    PG8_BAR;
    if constexpr (Epi::AFTER_DRAIN) { E.fused(acc, cur, wr, wc, fr, fq, lds, wid, lane); S.done(cur); }
#undef PG8_SA
#undef PG8_SB
#undef PG8_STAGE
#undef PG8_LDA
#undef PG8_LDB
#undef PG8_MMA
#undef PG8_WAIT_V
#undef PG8_WAIT_L
#undef PG8_BAR
#undef PG8_SCHED
}
}

namespace pg8 {
struct EpiInProjT {
    static constexpr bool PERM = true, AFTER_DRAIN = false, MIDK = false;
    unsigned char* ws;
    __device__ __forceinline__ void operator()(const f32x4 (&acc)[2][2][4][2], const Unit& u, int wr, int wc, int fr, int fq) const {
        const int row0 = u.pm * BM + wr * 64 + fr, pn = u.pn, cin = wc * 32 + 8 * fq;
        if (pn == 17) {
            if (wc == 0 && fq < 2) { float* F = (float*)(ws + WS_F);
#pragma unroll
                for (int ai = 0; ai < 2; ++ai)
#pragma unroll
                    for (int m = 0; m < 4; ++m)
#pragma unroll
                        for (int n = 0; n < 2; ++n)
#pragma unroll
                            for (int j = 0; j < 4; ++j) F[(size_t)(8 * fq + 4 * n + j) * M + row0 + ai * HALF + m * 16] = acc[ai][0][m][n][j]; }
            return;
        }
        bf16_t *b0, *b1; int ldc; float sc = 1.f;
        if (pn < 4) { b0 = (bf16_t*)(ws + WS_QA) + pn * 256 + cin; b1 = b0 + HALF; ldc = 1024; sc = C2; }
        else if (pn == 4) { b0 = (bf16_t*)(ws + WS_KA) + cin; b1 = (bf16_t*)(ws + WS_VA) + cin; ldc = 128; }
        else if (pn < 9) { b0 = (bf16_t*)(ws + WS_QB) + (pn - 5) * 256 + cin; b1 = b0 + HALF; ldc = 1024; sc = C2; }
        else if (pn < 13) { b0 = (bf16_t*)(ws + WS_KB) + (pn - 9) * 256 + cin; b1 = b0 + HALF; ldc = 1024; }
        else { b0 = (bf16_t*)(ws + WS_VB) + (pn - 13) * 256 + cin; b1 = b0 + HALF; ldc = 1024; }
#pragma unroll
        for (int ai = 0; ai < 2; ++ai)
#pragma unroll
            for (int m = 0; m < 4; ++m) { const size_t ro = (size_t)(row0 + ai * HALF + m * 16) * ldc;
#pragma unroll
                for (int bj = 0; bj < 2; ++bj) { const f32x4 v0 = acc[ai][bj][m][0] * sc, v1 = acc[ai][bj][m][1] * sc;
                    u32x4 w; w.x = cvt_pk_bf16(v0[0], v0[1]); w.y = cvt_pk_bf16(v0[2], v0[3]); w.z = cvt_pk_bf16(v1[0], v1[1]); w.w = cvt_pk_bf16(v1[2], v1[3]);
                    *(u32x4*)((bj ? b1 : b0) + ro) = w; } }
    }
};
struct EpiBf16T {
    static constexpr bool PERM = true, AFTER_DRAIN = false, MIDK = false;
    bf16_t* C; int ldc;
    __device__ __forceinline__ void operator()(const f32x4 (&acc)[2][2][4][2], const Unit& u, int wr, int wc, int fr, int fq) const {
        const int row0 = u.pm * BM + wr * 64 + fr, col0 = u.pn * BM + wc * 32 + 8 * fq;
#pragma unroll
        for (int ai = 0; ai < 2; ++ai)
#pragma unroll
            for (int m = 0; m < 4; ++m) { bf16_t* rp = C + (size_t)(row0 + ai * HALF + m * 16) * ldc + col0;
#pragma unroll
                for (int bj = 0; bj < 2; ++bj) { const f32x4 v0 = acc[ai][bj][m][0], v1 = acc[ai][bj][m][1];
                    u32x4 w; w.x = cvt_pk_bf16(v0[0], v0[1]); w.y = cvt_pk_bf16(v0[2], v0[3]); w.z = cvt_pk_bf16(v1[0], v1[1]); w.w = cvt_pk_bf16(v1[2], v1[3]);
                    *(u32x4*)(rp + bj * HALF) = w; } }
    }
};
struct EpiOutT {
    static constexpr bool PERM = true, AFTER_DRAIN = false, MIDK = true;
    bf16_t* C; int ldc; const PG8_LAS float* T;
    __device__ __forceinline__ void midk(f32x4 (&acc)[2][2][4][2], int ui, int wr, int fr) const {
#pragma unroll
        for (int ai = 0; ai < 2; ++ai)
#pragma unroll
            for (int m = 0; m < 4; ++m) { const float r = T[((ui & 1) * 256 + ai * HALF + wr * 64 + m * 16 + fr) * 2];
#pragma unroll
                for (int bj = 0; bj < 2; ++bj)
#pragma unroll
                    for (int n = 0; n < 2; ++n) acc[ai][bj][m][n] *= r; }
    }
    __device__ __forceinline__ void epi(const f32x4 (&acc)[2][2][4][2], const Unit& u, int ui, int wr, int wc, int fr, int fq) const {
        const int row0 = u.pm * BM + wr * 64 + fr, col0 = u.pn * BM + wc * 32 + 8 * fq;
#pragma unroll
        for (int ai = 0; ai < 2; ++ai)
#pragma unroll
            for (int m = 0; m < 4; ++m) { bf16_t* rp = C + (size_t)(row0 + ai * HALF + m * 16) * ldc + col0; const float r = T[((ui & 1) * 256 + ai * HALF + wr * 64 + m * 16 + fr) * 2 + 1];
#pragma unroll
                for (int bj = 0; bj < 2; ++bj) { const f32x4 v0 = acc[ai][bj][m][0] * r, v1 = acc[ai][bj][m][1] * r;
                    u32x4 w; w.x = cvt_pk_bf16(v0[0], v0[1]); w.y = cvt_pk_bf16(v0[2], v0[3]); w.z = cvt_pk_bf16(v1[0], v1[1]); w.w = cvt_pk_bf16(v1[2], v1[3]);
                    *(u32x4*)(rp + bj * HALF) = w; } }
    }
};
}

namespace pg8 {
__device__ __forceinline__ float dpp_ror1(float x) { return __builtin_bit_cast(float, __builtin_amdgcn_mov_dpp(__builtin_bit_cast(int, x), 0x121, 0xf, 0xf, true)); }
__device__ __forceinline__ float dpp_ror2(float x) { return __builtin_bit_cast(float, __builtin_amdgcn_mov_dpp(__builtin_bit_cast(int, x), 0x122, 0xf, 0xf, true)); }
__device__ __forceinline__ float gelu_tanh_fast(float x) {
    const float e = __builtin_amdgcn_exp2f(-2.3022082f * x * (1.0f + 0.044715f * x * x));
    return x * __builtin_amdgcn_rcpf(1.0f + e);
}
__device__ __forceinline__ f32x4 geglu4(f32x4 g, f32x4 v) {
    const f32x4 t = (g * g) * 0.044715f + 1.0f, a = (g * -2.3022082f) * t;
    f32x4 e; e[0] = __builtin_amdgcn_exp2f(a[0]); e[1] = __builtin_amdgcn_exp2f(a[1]); e[2] = __builtin_amdgcn_exp2f(a[2]); e[3] = __builtin_amdgcn_exp2f(a[3]);
    e = e + 1.0f;
    f32x4 r; r[0] = __builtin_amdgcn_rcpf(e[0]); r[1] = __builtin_amdgcn_rcpf(e[1]); r[2] = __builtin_amdgcn_rcpf(e[2]); r[3] = __builtin_amdgcn_rcpf(e[3]);
    return (g * v) * r;
}
constexpr size_t SIDE_HEAD = 0, SIDE_TAIL = 6 * MiB;
struct EpiUpT {
    static constexpr bool PERM = true, AFTER_DRAIN = false, MIDK = false;
    bf16_t* act; const float* cw; const float* cb; float* side; PG8_LAS float* X;
    __device__ __forceinline__ void operator()(const f32x4 (&acc)[2][2][4][2], const Unit& u, int wr, int wc, int fr, int fq) const {
        const int cin = wc * 32 + 8 * fq;
        f32x4 Wt[2][2][4];
#define EPIUP_LOADW(n_) do { _Pragma("unroll") for (int bj_ = 0; bj_ < 2; ++bj_) { const int col_ = bj_ * DFF + HALF * u.pn + cin + 4 * (n_); \
            if ((n_) == 0) Wt[n_][bj_][0] = *(const f32x4*)(cw + col_); Wt[n_][bj_][1] = *(const f32x4*)(cw + NUP + col_); Wt[n_][bj_][2] = *(const f32x4*)(cw + 2 * NUP + col_); } } while (0)
#define EPIUP_LOADB(n_) do { _Pragma("unroll") for (int bj_ = 0; bj_ < 2; ++bj_) { Wt[n_][bj_][3] = *(const f32x4*)(cb + bj_ * DFF + HALF * u.pn + cin + 4 * (n_)); if ((n_) == 1) Wt[n_][bj_][0] = *(const f32x4*)(cw + bj_ * DFF + HALF * u.pn + cin + 4 * (n_)); } } while (0)
        EPIUP_LOADW(0); EPIUP_LOADB(0); EPIUP_LOADW(1);
        if (fr >= 14) {
#pragma unroll
            for (int ai = 0; ai < 2; ++ai)
#pragma unroll
                for (int bj = 0; bj < 2; ++bj)
#pragma unroll
                    for (int n = 0; n < 2; ++n) *(PG8_LAS f32x4*)(X + ((2 * ai + wr) * 2 + (fr - 14)) * 256 + bj * HALF + cin + 4 * n) = acc[ai][bj][3][n];
            if (wr == 1) {
#pragma unroll
                for (int bj = 0; bj < 2; ++bj)
#pragma unroll
                    for (int n = 0; n < 2; ++n) *(f32x4*)(side + SIDE_TAIL / 4 + ((size_t)u.pm * 2 + (fr - 14)) * NUP + u.pn * BM + bj * HALF + cin + 4 * n) = acc[1][bj][3][n];
            }
        }
        if (fr < 2 && wr == 0) {
#pragma unroll
            for (int bj = 0; bj < 2; ++bj)
#pragma unroll
                for (int n = 0; n < 2; ++n) *(f32x4*)(side + SIDE_HEAD / 4 + ((size_t)u.pm * 2 + fr) * NUP + u.pn * BM + bj * HALF + cin + 4 * n) = acc[0][bj][0][n];
        }
        asm volatile("s_waitcnt lgkmcnt(0)" ::: "memory"); __builtin_amdgcn_s_barrier(); asm volatile("" ::: "memory");
#pragma unroll
        for (int ai = 0; ai < 2; ++ai) {
            const int b4 = 2 * ai + wr;
            typedef unsigned u32x2v __attribute__((ext_vector_type(2)));
            u32x2v st[4];
#pragma unroll
            for (int n = 0; n < 2; ++n) {
                f32x4 p1[2], p2[2];
#pragma unroll
                for (int bj = 0; bj < 2; ++bj) {
                    f32x4 h62 = (f32x4){0.f, 0.f, 0.f, 0.f}, h63 = h62;
                    if (b4 > 0) { h62 = *(const PG8_LAS f32x4*)(X + ((b4 - 1) * 2 + 0) * 256 + bj * HALF + cin + 4 * n); h63 = *(const PG8_LAS f32x4*)(X + ((b4 - 1) * 2 + 1) * 256 + bj * HALF + cin + 4 * n); }
                    p1[bj] = h63; p2[bj] = (fr == 1) ? h63 : h62;
                }
#pragma unroll
                for (int m = 0; m < 4; ++m) {
                    f32x4 y[2];
#pragma unroll
                    for (int bj = 0; bj < 2; ++bj) {
                        const f32x4 v = acc[ai][bj][m][n];
                        f32x4 r1, r2;
#pragma unroll
                        for (int j = 0; j < 4; ++j) { r1[j] = dpp_ror1(v[j]); r2[j] = dpp_ror2(v[j]); }
                        const f32x4 q1 = (fr >= 1) ? r1 : p1[bj], q2 = (fr >= 2) ? r2 : p2[bj];
                        y[bj] = (Wt[n][bj][2] * v + Wt[n][bj][1] * q1) + (Wt[n][bj][0] * q2 + Wt[n][bj][3]);
                        p1[bj] = r1; p2[bj] = r2;
                    }
                    const f32x4 o4 = geglu4(y[0], y[1]); u32x2v w; w.x = cvt_pk_bf16(o4[0], o4[1]); w.y = cvt_pk_bf16(o4[2], o4[3]);
                    if (n == 0) st[m] = w;
                    else __builtin_nontemporal_store((u32x4){st[m].x, st[m].y, w.x, w.y}, (u32x4*)(act + (size_t)(u.pm * BM + ai * HALF + wr * 64 + m * 16 + fr) * DFF + HALF * u.pn + cin));
                    __builtin_amdgcn_sched_barrier(0);
                }
                if (ai == 0 && n == 0) { EPIUP_LOADB(1); __builtin_amdgcn_sched_barrier(0); }
            }
            asm volatile("" ::: "memory"); __builtin_amdgcn_sched_barrier(0);
        }
#undef EPIUP_LOADW
#undef EPIUP_LOADB
    }
};
}
__device__ __forceinline__ void ph_convfix(const float* side, const float* cw, const float* cb, bf16_t* act) {
    const float* head = side + pg8::SIDE_HEAD / 4; const float* tail = side + pg8::SIDE_TAIL / 4;
    for (int idx = blockIdx.x * 512 + threadIdx.x; idx < 64 * 2 * DFF; idx += gridDim.x * 512) {
        const int pm = idx / (2 * DFF), r = (idx / DFF) & 1, n = idx % DFF;
        if ((pm & 15) == 0) continue;
        const int pg = ((n >> 7) << 8) + (n & 127);
        float y[2];
#pragma unroll
        for (int h = 0; h < 2; ++h) { const int pc = pg + 128 * h, col = h * DFF + n;
            const float H0 = head[((size_t)pm * 2 + 0) * NUP + pc], H1 = head[((size_t)pm * 2 + 1) * NUP + pc];
            const float T0 = tail[((size_t)(pm - 1) * 2 + 0) * NUP + pc], T1 = tail[((size_t)(pm - 1) * 2 + 1) * NUP + pc];
            const float w0 = cw[col], w1 = cw[NUP + col], w2 = cw[2 * NUP + col];
            y[h] = cb[col] + (r == 0 ? (w2 * H0 + w1 * T1 + w0 * T0) : (w2 * H1 + w1 * H0 + w0 * T1)); }
        act[(size_t)(256 * pm + r) * DFF + n] = (bf16_t)f2bf(gelu_tanh(y[0]) * y[1]);
    }
}
#include <hip/hip_bf16.h>
#include <cmath>
namespace attn_body {
using bf16=__hip_bfloat16;
using bf16x8=__attribute__((ext_vector_type(8)))short;
using s16x4=__attribute__((ext_vector_type(4)))short;
using f32x16=__attribute__((ext_vector_type(16)))float;
using u32x4=__attribute__((ext_vector_type(4)))unsigned;
using f32x4v=__attribute__((ext_vector_type(4)))float;
constexpr int BATCH=4,NHEAD=16,SEQ=4096,D=64,QP=1024,OP=2048;
constexpr int NW=8,QBLK=32,QB=QBLK*NW,KVBLK=64,NQB=SEQ/QB;
constexpr int ATTN_UNIT_ROWS=QB;
__device__ __forceinline__ int crow(int r,int hi){return (r&3)+8*(r>>2)+4*hi;}
#define SBAR() __builtin_amdgcn_sched_barrier(0)
template<bool WIN> __device__ __forceinline__ void amask(f32x16&p0,f32x16&p1,int koff,int qrel,int hi){
  const float NEG=-INFINITY; int d=qrel-(koff+4*hi); asm volatile("":"+v"(d));
  #pragma unroll
  for(int r=0;r<16;++r){const int kc=(r&3)+8*(r>>2);
    if(kc>d||(WIN&&kc<=d-128))p0[r]=NEG; if(kc+32>d||(WIN&&kc+32<=d-128))p1[r]=NEG;}
}

constexpr int NSLOT=3, SLOTB=8192;
constexpr int LDS_K=0, LDS_V=NSLOT*SLOTB, LDS_WS=2*NSLOT*SLOTB, LDS_OST=LDS_WS+NW*64*4, LDS_CL=LDS_OST+NW*4096+2048, LDS_CL2=LDS_CL+SEQ*4, LDS_WT=LDS_CL2+384*4, LDS_BYTES=LDS_WT+64;
constexpr float C2=0.125f*1.4426950408889634f;
__device__ __forceinline__ void glds16(const void*gsrc,unsigned lds_dst){unsigned keep;
  asm volatile("s_mov_b32 %0, m0\n\ts_mov_b32 m0, %2\n\ts_nop 0\n\tglobal_load_lds_dwordx4 %1, off\n\ts_mov_b32 m0, %0":"=&s"(keep):"v"(gsrc),"s"(lds_dst):"memory");}
__device__ __forceinline__ float max3f(float a,float b,float c){float r;asm("v_max3_f32 %0, %1, %2, %3":"=v"(r):"v"(a),"v"(b),"v"(c));return r;}
__device__ __forceinline__ float max2f(float a,float b){float r;asm("v_max_f32_e32 %0, %1, %2":"=v"(r):"v"(a),"v"(b));return r;}
__device__ __forceinline__ float fadd_s(float a,float b){float r;asm("v_add_f32_e32 %0, %1, %2":"=v"(r):"v"(a),"v"(b));return r;}
__device__ __forceinline__ float fsub_s(float a,float b){float r;asm("v_sub_f32_e32 %0, %1, %2":"=v"(r):"v"(a),"v"(b));return r;}
typedef float f32x2_t __attribute__((ext_vector_type(2))); typedef __bf16 bf16x2_t __attribute__((ext_vector_type(2)));
__device__ __forceinline__ unsigned cvtpk_s(float lo,float hi){f32x2_t v={lo,hi};bf16x2_t b=__builtin_convertvector(v,bf16x2_t);return __builtin_bit_cast(unsigned,b);}
#define WAIT_BAR(N) asm volatile("s_waitcnt vmcnt(" #N ") lgkmcnt(0)\n\ts_barrier":::"memory")

__device__ __forceinline__ void qkt(f32x16&p0,f32x16&p1,const char*Kslot,const bf16x8*qr,int r32,int hi){
  const char*kb=Kslot+hi*1024+r32*16;
  #pragma unroll
  for(int d0=0;d0<4;++d0){
    const bf16x8 b0=*reinterpret_cast<const bf16x8*>(kb+d0*2048);
    const bf16x8 b1=*reinterpret_cast<const bf16x8*>(kb+d0*2048+512);
    if(d0==0){p0=__builtin_amdgcn_mfma_f32_32x32x16_bf16(b0,qr[0],p0,0,0,0);p1=__builtin_amdgcn_mfma_f32_32x32x16_bf16(b1,qr[0],p1,0,0,0);}
    else{p0=__builtin_amdgcn_mfma_f32_32x32x16_bf16(b0,qr[d0],p0,0,0,0);p1=__builtin_amdgcn_mfma_f32_32x32x16_bf16(b1,qr[d0],p1,0,0,0);}}
}
typedef __attribute__((address_space(3))) const char* lds_cptr;
typedef short v4i16_t __attribute__((ext_vector_type(4)));
__device__ __forceinline__ void kload8(bf16x8*kf,lds_cptr kp){
  kf[0]=*(const __attribute__((address_space(3))) bf16x8*)(kp);      kf[1]=*(const __attribute__((address_space(3))) bf16x8*)(kp+512);
  kf[2]=*(const __attribute__((address_space(3))) bf16x8*)(kp+2048); kf[3]=*(const __attribute__((address_space(3))) bf16x8*)(kp+2560);
  kf[4]=*(const __attribute__((address_space(3))) bf16x8*)(kp+4096); kf[5]=*(const __attribute__((address_space(3))) bf16x8*)(kp+4608);
  kf[6]=*(const __attribute__((address_space(3))) bf16x8*)(kp+6144); kf[7]=*(const __attribute__((address_space(3))) bf16x8*)(kp+6656);
}
__device__ __forceinline__ void kload2(bf16x8*kf,lds_cptr kp,int j){ kf[2*j]=*(const __attribute__((address_space(3))) bf16x8*)(kp+j*2048); kf[2*j+1]=*(const __attribute__((address_space(3))) bf16x8*)(kp+j*2048+512); }
__device__ __forceinline__ s16x4 vtr(lds_cptr p){ return __builtin_bit_cast(s16x4,__builtin_amdgcn_ds_read_tr16_b64_v4i16((__attribute__((address_space(3))) v4i16_t*)p)); }
__device__ __forceinline__ float rowmax(const f32x16&p0,const f32x16&p1){
  float a=max3f(p0[0],p0[1],p1[0]),b=max3f(p0[2],p0[3],p1[1]);a=max3f(a,p1[2],p1[3]);
  #pragma unroll
  for(int r=4;r<16;r+=4){a=max3f(a,p0[r],p0[r+1]);b=max3f(b,p0[r+2],p0[r+3]);a=max3f(a,p1[r],p1[r+1]);b=max3f(b,p1[r+2],p1[r+3]);}
  const float m=max2f(a,b);
  auto rr=__builtin_amdgcn_permlane32_swap(__float_as_uint(m),__float_as_uint(m),false,false);
  return max2f(__uint_as_float(rr[0]),__uint_as_float(rr[1]));
}
__device__ __forceinline__ void pv(f32x16*o,int vb,bf16x8 pa0,bf16x8 pa1,bf16x8 pa2,bf16x8 pa3){
  #pragma unroll
  for(int d0=0;d0<2;++d0){s16x4 lo[4],hi[4];
    #pragma unroll
    for(int ks=0;ks<4;++ks){
      asm volatile("ds_read_b64_tr_b16 %0,%1 offset:%c2":"=&v"(lo[ks]):"v"(vb),"i"(d0*4096+ks*1024):"memory");
      asm volatile("ds_read_b64_tr_b16 %0,%1 offset:%c2":"=&v"(hi[ks]):"v"(vb),"i"(d0*4096+ks*1024+512):"memory");}
    asm volatile("s_waitcnt lgkmcnt(0)":::"memory");SBAR();
    #define PK(k) (bf16x8){lo[k][0],lo[k][1],lo[k][2],lo[k][3],hi[k][0],hi[k][1],hi[k][2],hi[k][3]}
    o[d0]=__builtin_amdgcn_mfma_f32_32x32x16_bf16(pa0,PK(0),o[d0],0,0,0);
    o[d0]=__builtin_amdgcn_mfma_f32_32x32x16_bf16(pa1,PK(1),o[d0],0,0,0);
    o[d0]=__builtin_amdgcn_mfma_f32_32x32x16_bf16(pa2,PK(2),o[d0],0,0,0);
    o[d0]=__builtin_amdgcn_mfma_f32_32x32x16_bf16(pa3,PK(3),o[d0],0,0,0);
    #undef PK
  }
}

#ifndef ATTN_STORE16
#define ATTN_STORE16(p,v) (*(u32x4*)(p)=(v))
#endif
template<int THRL,int MODE> __device__ __forceinline__ void attn_unit(int b,int h,int qb,const bf16*Q,const bf16*__restrict__ K,const bf16*__restrict__ V,int KP,int kvcol,bf16*O,int ocol,float*ssq,float slope_l2,float sink_l2,char*shm){
  int tid=threadIdx.x; asm volatile("":"+v"(tid));
  const int lane=tid&63,r32=lane&31,hi=lane>>5; const int wid=__builtin_amdgcn_readfirstlane(tid>>6);
  const long rowbase=(long)b*SEQ; const int q0=qb*QB;
  const int t0=(MODE==0)?((qb>0)?4*qb-2:0):0;
  const bf16*Qw=Q+(rowbase+q0+wid*QBLK)*QP+h*D;
  const bf16*Kh=K+(rowbase+(long)t0*KVBLK)*KP+kvcol,*Vh=V+(rowbase+(long)t0*KVBLK)*KP+kvcol;
  const unsigned lds0=(unsigned)(uintptr_t)shm;
  float*wsf=(float*)(shm+LDS_WS)+wid*64;
  const bf16*ksrc=Kh+(long)lane*KP+wid*8;
  const bf16*vsrc=Vh+(long)(16*(wid&3)+(lane>>2))*KP+(wid>>2)*32+(lane&3)*8;
  const unsigned kdst=lds0+LDS_K+wid*1024, vdst=lds0+LDS_V+wid*1024;
  #define DMA_K(t,slot) glds16(ksrc+(long)(t)*KVBLK*KP,(unsigned)__builtin_amdgcn_readfirstlane(kdst+(slot)))
  #define DMA_V(t,slot) glds16(vsrc+(long)(t)*KVBLK*KP,(unsigned)__builtin_amdgcn_readfirstlane(vdst+(slot)))
  const int vb0=(int)(lds0+LDS_V)+((lane>>4)&1)*32+(lane&3)*8+(4*hi+((lane&15)>>2))*64;
  const char*Kbase=shm+LDS_K; bf16x8 kf[8];
  const lds_cptr shm3=(lds_cptr)shm; const lds_cptr kp0=shm3+LDS_K+hi*1024+r32*16; const lds_cptr vp0=shm3+LDS_V+((lane>>4)&1)*32+(lane&3)*8+(4*hi+((lane&15)>>2))*64;
  const int NT=(MODE==0)?((qb>0)?6:4):(q0+QB)/KVBLK;
  typedef __attribute__((address_space(3))) float* lds_fptr;
  const lds_fptr cl=(lds_fptr)((lds_cptr)shm+((MODE==1)?LDS_CL:LDS_CL2));
  if(MODE==0){ if(tid<384)cl[tid]=-slope_l2*(float)tid; }
  DMA_K(0,0);DMA_V(0,0);DMA_K(1,SLOTB);
  bf16x8 qr[4];
  #pragma unroll
  for(int d0=0;d0<4;++d0)qr[d0]=*reinterpret_cast<const bf16x8*>(&Qw[(long)r32*QP+d0*16+hi*8]);
  float mhat=0.f,l_reg=0.f;f32x16 o[2];o[0]=f32x16{};o[1]=f32x16{};
  const int qrel=wid*QBLK+r32;
  asm volatile("s_waitcnt lgkmcnt(0)\n\ts_barrier":::"memory");
  const float ct=cl[q0-t0*KVBLK+qrel];
  float nm=ct;
  #define CINIT(I0,I1,t) do{ const lds_fptr cp_=cl+64*(t)+4*hi; _Pragma("unroll") for(int g_=0;g_<4;++g_){ \
      const f32x4v a_=*(const __attribute__((address_space(3))) f32x4v*)(cp_+8*g_), b_=*(const __attribute__((address_space(3))) f32x4v*)(cp_+8*g_+32); \
      _Pragma("unroll") for(int j_=0;j_<4;++j_){ I0[4*g_+j_]=nm-a_[j_]; I1[4*g_+j_]=nm-b_[j_]; } SBAR(); } }while(0)
  #define CMASK(P0,P1,t) do{int ko_=64*((t)-(NT-4)); if(MODE==0||ko_>=0)amask<MODE==0>(P0,P1,ko_,qrel,hi);}while(0)
  bool resc=false;
  #define START(P0,P1) do{ const float rm=rowmax(P0,P1); resc=false; \
    { const float dl=__builtin_fmaxf(rm,-1000.f); mhat=fadd_s(mhat,dl); \
      _Pragma("unroll") for(int r=0;r<16;++r){P0[r]=fsub_s(P0[r],dl);P1[r]=fsub_s(P1[r],dl);} \
      nm=ct-mhat; } \
    _Pragma("unroll") for(int r=0;r<16;++r)P0[r]=__builtin_amdgcn_exp2f(P0[r]); }while(0)
  #define RESC() do{ if(resc){ asm volatile("s_waitcnt lgkmcnt(0)":::"memory"); \
      _Pragma("unroll") for(int d_=0;d_<2;++d_) _Pragma("unroll") for(int r=0;r<16;++r)o[d_][r]*=wsf[crow(r,hi)]; } }while(0)
  f32x16 pA0,pA1,pB0,pB1;
  int sl_prev=0,sl_cur=0,sl_next=SLOTB;
  #define ROT() do{sl_prev=sl_cur;sl_cur=sl_next;sl_next=(sl_next==(NSLOT-1)*SLOTB)?0:sl_next+SLOTB;}while(0)
  DMA_K(2,2*SLOTB);
  WAIT_BAR(3);
  CINIT(pA0,pA1,0); qkt(pA0,pA1,Kbase,qr,r32,hi);asm volatile("s_nop 15\n\ts_nop 7":"+v"(pA0),"+v"(pA1));CMASK(pA0,pA1,0);
  START(pA0,pA1);
  _Pragma("unroll") for(int r=0;r<16;++r)pA1[r]=__builtin_amdgcn_exp2f(pA1[r]);
  WAIT_BAR(0);
  DMA_K(3,0);DMA_V(1,SLOTB);
  ROT();
  kload8(kf,kp0+sl_cur);
  WAIT_BAR(2);
  s16x4 vlo[8],vhi[8]; u32x4 pw0,pw1,pw2,pw3;
  #define PKW(P,B) cvtpk_s(P[B],P[B+1])
  #define PAF(k) __builtin_bit_cast(bf16x8,pw##k)
  #define VFR(i) (bf16x8){vlo[i][0],vlo[i][1],vlo[i][2],vlo[i][3],vhi[i][0],vhi[i][1],vhi[i][2],vhi[i][3]}
  #define PIN(x) asm volatile("":"+v"(x))
  #define MX3(a,b,c) __builtin_fmaxf(__builtin_fmaxf((a),(b)),(c))
  #define GAPA(MF,A0,A1,A2,A3,W0,W1,PW) do{ MF; sacc+=A0; sacc+=A1; sacc+=A2; sacc+=A3; PIN(sacc); W0; W1; PIN(PW); SBAR(); }while(0)
  #define EX(v) __builtin_amdgcn_exp2f(v)
  #define GAPB(MF,X,B) do{ MF; X[B]=EX(X[B]); X[B+1]=EX(X[B+1]); X[B+2]=EX(X[B+2]); X[B+3]=EX(X[B+3]); PIN(X); SBAR(); }while(0)
  #define VRD(i) do{ vlo[i]=vtr(vp_+(((i)>>2)*4096+((i)&3)*1024)); vhi[i]=vtr(vp_+(((i)>>2)*4096+((i)&3)*1024+512)); }while(0)
  #define KRD(G,j) do{ if(G){ kload2(kf,kp0+sl_next,j); SBAR(); } }while(0)
  #define STEP(C0,C1,P0,P1,t,GK,GV,GL) do{ SBAR(); CINIT(C0,C1,t); SBAR(); \
    const lds_cptr vp_=vp0+sl_prev; \
    VRD(0); SBAR(); float sacc=(P0[0]+P0[1]); \
    GAPA(C0=__builtin_amdgcn_mfma_f32_32x32x16_bf16(kf[0],qr[0],C0,0,0,0), P0[2],P0[3],P0[4],P0[5],     pw0[0]=PKW(P0,0), pw0[1]=PKW(P0,2), pw0); \
    VRD(4); SBAR(); GAPA(C1=__builtin_amdgcn_mfma_f32_32x32x16_bf16(kf[1],qr[0],C1,0,0,0), P0[6],P0[7],P0[8],P0[9],     pw0[2]=PKW(P0,4), pw0[3]=PKW(P0,6), pw0); \
    VRD(1); SBAR(); GAPA(C0=__builtin_amdgcn_mfma_f32_32x32x16_bf16(kf[2],qr[1],C0,0,0,0),   P0[10],P0[11],P0[12],P0[13], pw1[0]=PKW(P0,8), pw1[1]=PKW(P0,10), pw1); \
    VRD(5); SBAR(); GAPA(C1=__builtin_amdgcn_mfma_f32_32x32x16_bf16(kf[3],qr[1],C1,0,0,0),   P0[14],P0[15],P1[0],P1[1],   pw1[2]=PKW(P0,12),pw1[3]=PKW(P0,14), pw1); \
    VRD(2); SBAR(); GAPA(C0=__builtin_amdgcn_mfma_f32_32x32x16_bf16(kf[4],qr[2],C0,0,0,0),   P1[2],P1[3],P1[4],P1[5],     pw2[0]=PKW(P1,0), pw2[1]=PKW(P1,2), pw2); \
    VRD(6); SBAR(); GAPA(C1=__builtin_amdgcn_mfma_f32_32x32x16_bf16(kf[5],qr[2],C1,0,0,0),   P1[6],P1[7],P1[8],P1[9],     pw2[2]=PKW(P1,4), pw2[3]=PKW(P1,6), pw2); \
    VRD(3); SBAR(); GAPA(C0=__builtin_amdgcn_mfma_f32_32x32x16_bf16(kf[6],qr[3],C0,0,0,0),   P1[10],P1[11],P1[12],P1[13], pw3[0]=PKW(P1,8), pw3[1]=PKW(P1,10), pw3); \
    VRD(7); SBAR(); GAPA(C1=__builtin_amdgcn_mfma_f32_32x32x16_bf16(kf[7],qr[3],C1,0,0,0),   P1[14],P1[15],0.f,0.f,       pw3[2]=PKW(P1,12),pw3[3]=PKW(P1,14), pw3); \
    l_reg+=sacc; \
    if(GK){DMA_K((t)+3,sl_cur);} if(GV){DMA_V((t)+1,sl_next);} \
    CMASK(C0,C1,t); \
    { float a=MX3(C0[0],C0[1],C1[0]),b=MX3(C0[2],C0[3],C1[1]); a=MX3(a,C1[2],C1[3]); \
      _Pragma("unroll") for(int r=4;r<16;r+=4){a=MX3(a,C0[r],C0[r+1]);b=MX3(b,C0[r+2],C0[r+3]);a=MX3(a,C1[r],C1[r+1]);b=MX3(b,C1[r+2],C1[r+3]);} \
      float rm=__builtin_fmaxf(a,b); { auto rr=__builtin_amdgcn_permlane32_swap(__float_as_uint(rm),__float_as_uint(rm),false,false); rm=__builtin_fmaxf(__uint_as_float(rr[0]),__uint_as_float(rr[1])); } \
      resc=false; \
      if(__builtin_expect(__any(rm>(float)THRL),0)){ const float dl=__builtin_fmaxf(rm,0.f); mhat+=dl; \
        _Pragma("unroll") for(int r=0;r<16;++r){C0[r]-=dl;C1[r]-=dl;} \
        nm=ct-mhat; \
        const float f=__builtin_amdgcn_exp2f(-dl); l_reg*=f; if(hi==0)wsf[r32]=f; resc=true; } } \
    SBAR(); \
    GAPB(o[0]=__builtin_amdgcn_mfma_f32_32x32x16_bf16(PAF(0),VFR(0),o[0],0,0,0), C0,0); \
    GAPB(o[1]=__builtin_amdgcn_mfma_f32_32x32x16_bf16(PAF(0),VFR(4),o[1],0,0,0), C0,4); \
    KRD(GL,0); GAPB(o[0]=__builtin_amdgcn_mfma_f32_32x32x16_bf16(PAF(1),VFR(1),o[0],0,0,0), C0,8); \
    KRD(GL,1); GAPB(o[1]=__builtin_amdgcn_mfma_f32_32x32x16_bf16(PAF(1),VFR(5),o[1],0,0,0), C0,12); \
    KRD(GL,2); GAPB(o[0]=__builtin_amdgcn_mfma_f32_32x32x16_bf16(PAF(2),VFR(2),o[0],0,0,0), C1,0); \
    KRD(GL,3); GAPB(o[1]=__builtin_amdgcn_mfma_f32_32x32x16_bf16(PAF(2),VFR(6),o[1],0,0,0), C1,4); \
    GAPB(o[0]=__builtin_amdgcn_mfma_f32_32x32x16_bf16(PAF(3),VFR(3),o[0],0,0,0), C1,8); \
    GAPB(o[1]=__builtin_amdgcn_mfma_f32_32x32x16_bf16(PAF(3),VFR(7),o[1],0,0,0), C1,12); \
    }while(0)
  #define ACT(tt) ((64*((tt)-(NT-4))+63>=32*wid-127)&&(64*((tt)-(NT-4))<=32*wid+31))
  #define STEPW(C0,C1,P0,P1,t,GK,GV,GL) do{ SBAR(); \
    const bool aq_=ACT(t), ap_=ACT((t)-1); \
    const lds_cptr vp_=vp0+sl_prev; \
    if(ap_){ VRD(0);VRD(4);VRD(1);VRD(5);VRD(2);VRD(6);VRD(3);VRD(7); \
      float sacc=(P0[0]+P0[1]); _Pragma("unroll") for(int r=2;r<16;++r)sacc+=P0[r]; _Pragma("unroll") for(int r=0;r<16;++r)sacc+=P1[r]; l_reg+=sacc; \
      pw0=(u32x4){PKW(P0,0),PKW(P0,2),PKW(P0,4),PKW(P0,6)};pw1=(u32x4){PKW(P0,8),PKW(P0,10),PKW(P0,12),PKW(P0,14)};pw2=(u32x4){PKW(P1,0),PKW(P1,2),PKW(P1,4),PKW(P1,6)};pw3=(u32x4){PKW(P1,8),PKW(P1,10),PKW(P1,12),PKW(P1,14)}; } \
    SBAR(); \
    if(aq_){ CINIT(C0,C1,t); \
      C0=__builtin_amdgcn_mfma_f32_32x32x16_bf16(kf[0],qr[0],C0,0,0,0); C1=__builtin_amdgcn_mfma_f32_32x32x16_bf16(kf[1],qr[0],C1,0,0,0); \
      C0=__builtin_amdgcn_mfma_f32_32x32x16_bf16(kf[2],qr[1],C0,0,0,0); C1=__builtin_amdgcn_mfma_f32_32x32x16_bf16(kf[3],qr[1],C1,0,0,0); \
      C0=__builtin_amdgcn_mfma_f32_32x32x16_bf16(kf[4],qr[2],C0,0,0,0); C1=__builtin_amdgcn_mfma_f32_32x32x16_bf16(kf[5],qr[2],C1,0,0,0); \
      C0=__builtin_amdgcn_mfma_f32_32x32x16_bf16(kf[6],qr[3],C0,0,0,0); C1=__builtin_amdgcn_mfma_f32_32x32x16_bf16(kf[7],qr[3],C1,0,0,0); } \
    if(GK){DMA_K((t)+3,sl_cur);} if(GV){DMA_V((t)+1,sl_next);} \
    resc=false; \
    if(aq_){ CMASK(C0,C1,t); \
      float a=MX3(C0[0],C0[1],C1[0]),b=MX3(C0[2],C0[3],C1[1]); a=MX3(a,C1[2],C1[3]); \
      _Pragma("unroll") for(int r=4;r<16;r+=4){a=MX3(a,C0[r],C0[r+1]);b=MX3(b,C0[r+2],C0[r+3]);a=MX3(a,C1[r],C1[r+1]);b=MX3(b,C1[r+2],C1[r+3]);} \
      float rm=__builtin_fmaxf(a,b); { auto rr=__builtin_amdgcn_permlane32_swap(__float_as_uint(rm),__float_as_uint(rm),false,false); rm=__builtin_fmaxf(__uint_as_float(rr[0]),__uint_as_float(rr[1])); } \
      if(__builtin_expect(__any(rm>(float)THRL),0)){ const float dl=__builtin_fmaxf(rm,0.f); mhat+=dl; \
        _Pragma("unroll") for(int r=0;r<16;++r){C0[r]-=dl;C1[r]-=dl;} \
        nm=ct-mhat; \
        const float f=__builtin_amdgcn_exp2f(-dl); l_reg*=f; if(hi==0)wsf[r32]=f; resc=true; } } \
    SBAR(); \
    if(ap_){ \
      o[0]=__builtin_amdgcn_mfma_f32_32x32x16_bf16(PAF(0),VFR(0),o[0],0,0,0); o[1]=__builtin_amdgcn_mfma_f32_32x32x16_bf16(PAF(0),VFR(4),o[1],0,0,0); \
      o[0]=__builtin_amdgcn_mfma_f32_32x32x16_bf16(PAF(1),VFR(1),o[0],0,0,0); o[1]=__builtin_amdgcn_mfma_f32_32x32x16_bf16(PAF(1),VFR(5),o[1],0,0,0); \
      o[0]=__builtin_amdgcn_mfma_f32_32x32x16_bf16(PAF(2),VFR(2),o[0],0,0,0); o[1]=__builtin_amdgcn_mfma_f32_32x32x16_bf16(PAF(2),VFR(6),o[1],0,0,0); \
      o[0]=__builtin_amdgcn_mfma_f32_32x32x16_bf16(PAF(3),VFR(3),o[0],0,0,0); o[1]=__builtin_amdgcn_mfma_f32_32x32x16_bf16(PAF(3),VFR(7),o[1],0,0,0); } \
    if((GL)&&ACT((t)+1)){ kload2(kf,kp0+sl_next,0); kload2(kf,kp0+sl_next,1); kload2(kf,kp0+sl_next,2); kload2(kf,kp0+sl_next,3); } \
    if(aq_){ _Pragma("unroll") for(int r=0;r<16;++r){C0[r]=EX(C0[r]);C1[r]=EX(C1[r]);} } else { C0=f32x16{}; C1=f32x16{}; } \
    SBAR(); \
    }while(0)
  #define STEPX(C0,C1,P0,P1,t,GK,GV,GL) do{ if(MODE==0){ STEPW(C0,C1,P0,P1,t,GK,GV,GL); } else { STEP(C0,C1,P0,P1,t,GK,GV,GL); } }while(0)
  int t=1;
  #undef CMASK
  #define CMASK(P0,P1,t) do{}while(0)
  for(;t+5<NT;t+=2){
    STEP(pB0,pB1,pA0,pA1,t,true,true,true);     WAIT_BAR(2); RESC(); ROT();
    STEP(pA0,pA1,pB0,pB1,t+1,true,true,true);   WAIT_BAR(2); RESC(); ROT();
  }
  #undef CMASK
  #define CMASK(P0,P1,t) do{int ko_=64*((t)-(NT-4)); if(MODE==0||ko_>=0)amask<MODE==0>(P0,P1,ko_,qrel,hi);}while(0)
  #define ENDW(tt) do{ if((tt)+3<NT){WAIT_BAR(2);} else if((tt)+2<NT){WAIT_BAR(1);} else {WAIT_BAR(0);} }while(0)
  for(;t+1<NT;t+=2){
    STEPX(pB0,pB1,pA0,pA1,t,(t+3<NT),(t+1<NT),(t+1<NT));       ENDW(t);   RESC(); ROT();
    STEPX(pA0,pA1,pB0,pB1,t+1,(t+4<NT),(t+2<NT),(t+2<NT));     ENDW(t+1); RESC(); ROT();
  }
  STEPX(pB0,pB1,pA0,pA1,NT-1,false,false,false); RESC();
  if(MODE==1||ACT(NT-1))
  { float sacc=pB0[0]+pB0[1]; _Pragma("unroll") for(int r=2;r<16;++r)sacc+=pB0[r]; _Pragma("unroll") for(int r=0;r<16;++r)sacc+=pB1[r]; l_reg+=sacc;
    pw0=(u32x4){PKW(pB0,0),PKW(pB0,2),PKW(pB0,4),PKW(pB0,6)};pw1=(u32x4){PKW(pB0,8),PKW(pB0,10),PKW(pB0,12),PKW(pB0,14)};pw2=(u32x4){PKW(pB1,0),PKW(pB1,2),PKW(pB1,4),PKW(pB1,6)};pw3=(u32x4){PKW(pB1,8),PKW(pB1,10),PKW(pB1,12),PKW(pB1,14)};
    SBAR(); pv(o,vb0+sl_cur,PAF(0),PAF(1),PAF(2),PAF(3)); }
  #undef PKW
  #undef PAF
  #undef VFR
  #undef PIN
  #undef MX3
  #undef GAPA
  #undef GAPB
  #undef EX
  #undef VRD
  #undef KRD
  #undef STEP
  #undef ENDW
  #undef STEPX
  #undef STEPW
  #undef ACT
  {auto rr=__builtin_amdgcn_permlane32_swap(__float_as_uint(l_reg),__float_as_uint(l_reg),false,false);l_reg=__uint_as_float(rr[0])+__uint_as_float(rr[1]);}
  if(MODE==0)l_reg+=__builtin_amdgcn_exp2f(sink_l2-mhat);
  if(hi==0)wsf[32+r32]=l_reg;asm volatile("s_waitcnt lgkmcnt(0)":::"memory");
  float rli[16];
  #pragma unroll
  for(int r=0;r<16;++r)rli[r]=__builtin_amdgcn_rcpf(wsf[32+crow(r,hi)]);
  bf16*Ow=O+(rowbase+q0+wid*QBLK)*OP+ocol;
  { bf16*stg=(bf16*)(shm+LDS_OST)+wid*2048;
    #pragma unroll
    for(int r=0;r<16;++r){const int orow=crow(r,hi);
      #pragma unroll
      for(int d0=0;d0<2;++d0)stg[orow*64+d0*32+r32]=__float2bfloat16(o[d0][r]*rli[r]);}
    asm volatile("s_waitcnt lgkmcnt(0)":::"memory");
    #pragma unroll
    for(int i=0;i<4;++i){const int row=i*8+(lane>>3),ch=lane&7; const u32x4 v=*(const u32x4*)(stg+row*64+ch*8); ATTN_STORE16(Ow+(long)row*OP+ch*8,v);
      float ss=0.f;
      #pragma unroll
      for(int e=0;e<4;++e){const float lo=__builtin_bit_cast(float,v[e]<<16),hh=__builtin_bit_cast(float,v[e]&0xffff0000u); ss+=lo*lo+hh*hh;}
      ss+=__shfl_xor(ss,1); ss+=__shfl_xor(ss,2); ss+=__shfl_xor(ss,4);
      if(ch==0)ssq[(rowbase+q0+wid*QBLK+row)*32+MODE*16+h]=ss; } }
  asm volatile("s_waitcnt lgkmcnt(0)\n\ts_barrier":::"memory");
  #undef CINIT
  #undef DMA_K
  #undef DMA_V
  #undef CMASK
  #undef START
  #undef RESC
  #undef ROT
}
constexpr int ATTN_LDS_BYTES=LDS_BYTES;
#undef SBAR
#undef WAIT_BAR
}

__device__ __forceinline__ void fox_cumsum(const float* Ft, float bias, int b, int h, char* lds) {
    typedef __attribute__((address_space(3))) float* lds_fptr; typedef __attribute__((address_space(3))) const char* lds_cptr;
    const lds_fptr cl = (lds_fptr)((lds_cptr)lds + attn_body::LDS_CL), wt = (lds_fptr)((lds_cptr)lds + attn_body::LDS_WT);
    int tid = threadIdx.x; asm volatile("" : "+v"(tid));
    const int lane = tid & 63, wave = tid >> 6;
    const f32x4* f = (const f32x4*)(Ft + (size_t)h * M + (size_t)b * SEQ + 8 * tid);
    const f32x4 a = f[0], c = f[1];
    float v[8] = {a[0], a[1], a[2], a[3], c[0], c[1], c[2], c[3]};
#pragma unroll
    for (int k = 0; k < 8; ++k) v[k] = log_sigmoid(v[k] + bias);
#pragma unroll
    for (int k = 1; k < 8; ++k) v[k] += v[k - 1];
    float inc = v[7];
#pragma unroll
    for (int o = 1; o < 64; o <<= 1) { const float t = __shfl_up(inc, o); if (lane >= o) inc += t; }
    if (lane == 63) wt[wave] = inc;
    __syncthreads();
    float base = inc - v[7];
#pragma unroll
    for (int w = 0; w < 8; ++w) if (w < wave) base += wt[w];
    *(__attribute__((address_space(3))) f32x4*)(cl + 8 * tid) = (f32x4){(v[0] + base) * LOG2E, (v[1] + base) * LOG2E, (v[2] + base) * LOG2E, (v[3] + base) * LOG2E};
    *(__attribute__((address_space(3))) f32x4*)(cl + 8 * tid + 4) = (f32x4){(v[4] + base) * LOG2E, (v[5] + base) * LOG2E, (v[6] + base) * LOG2E, (v[7] + base) * LOG2E};
    __syncthreads();
}
__device__ __forceinline__ void attn_phase(const Ptrs& P, char* lds) {
    unsigned char* ws = P.ws;
    const int G = gridDim.x, bx = blockIdx.x, vcu0 = (G % 8 == 0) ? (bx % 8) * (G / 8) + bx / 8 : bx;
    for (int v = vcu0; v < 256; v += G) {
        const int bh = v >> 2, s = v & 3, b = bh >> 4, h = bh & 15;
        fox_cumsum((const float*)(ws + WS_F), P.b_forget[h], b, h, lds);
        for (int i = 0; i < 4; ++i) {
            const int qb = (i == 0) ? s : (i == 1) ? 7 - s : (i == 2) ? 8 + s : 15 - s;
            attn_body::attn_unit<60, 1>(b, h, qb, (const attn_body::bf16*)(ws + WS_QB), (const attn_body::bf16*)(ws + WS_KB), (const attn_body::bf16*)(ws + WS_VB), 1024, h * 64,
                                        (attn_body::bf16*)(ws + WS_O), 1024 + h * 64, (float*)(ws + WS_Y), 0.f, 0.f, lds);
        }
        for (int i = 0; i < 4; ++i) {
            const int qb = (i == 0) ? s : (i == 1) ? 7 - s : (i == 2) ? 8 + s : 15 - s;
            attn_body::attn_unit<8, 0>(b, h, qb, (const attn_body::bf16*)(ws + WS_QA), (const attn_body::bf16*)(ws + WS_KA), (const attn_body::bf16*)(ws + WS_VA), 128, (h >> 3) * 64,
                                       (attn_body::bf16*)(ws + WS_O), h * 64, (float*)(ws + WS_Y), exp2f(-0.5f * (float)(h + 1)) * LOG2E, P.sinks[h] * LOG2E, lds);
        }
    }
}
#define LAS __attribute__((address_space(3)))
#define XB_TMO      128
#define XB_XCNT(j)  (256  + 64 * (j))
#define XB_XSUB(j)  (1280 + 64 * (j))
#define XB_XGEN(j)  (2304 + 64 * (j))
#define XB_TOP      3328
#define XB_TOPGEN   3392
#define XCD_BAR_WORDS 3456
#define XB_SPIN_CAP (1u << 18)

__device__ __forceinline__ unsigned xb_ld(unsigned* p)              { return __hip_atomic_load(p, __ATOMIC_RELAXED, __HIP_MEMORY_SCOPE_AGENT); }
__device__ __forceinline__ unsigned xb_add(unsigned* p, unsigned v) { return __hip_atomic_fetch_add(p, v, __ATOMIC_RELAXED, __HIP_MEMORY_SCOPE_AGENT); }
__device__ __forceinline__ unsigned xb_xcc_id() { return (unsigned)__builtin_amdgcn_s_getreg((3 << 11) | 20) & 0xFu; }
#define XB_SPIN(cond, bar) do { unsigned _sp = 0; while (cond) { __builtin_amdgcn_s_sleep(1); \
    if ((++_sp & 255u) == 0u) { if (xb_ld(&(bar)[XB_TMO])) break; if (_sp > XB_SPIN_CAP) { atomicAdd(&(bar)[XB_TMO], 1u); break; } } } } while (0)

struct XcdBarrier {
    unsigned* bar; unsigned x;
    volatile LAS unsigned* st;
};

__device__ __forceinline__ XcdBarrier xcd_barrier_post(unsigned* bar, volatile LAS unsigned* st) {
    XcdBarrier b; b.bar = bar; b.x = xb_xcc_id(); b.st = st;
    if (threadIdx.x == 0) (void)xb_add(&bar[XB_XCNT(b.x)], 1u);
    return b;
}
__device__ __forceinline__ void xcd_barrier_complete(unsigned* bar, unsigned x, unsigned& nloc, unsigned& nx) {
    const unsigned G = gridDim.x * gridDim.y * gridDim.z;
    unsigned sum, cnt, mine, sp = 0u;
    for (;;) {
        sum = 0u; cnt = 0u; mine = 0u;
#pragma unroll
        for (unsigned j = 0; j < 16; ++j) { const unsigned c = xb_ld(&bar[XB_XCNT(j)]); sum += c; cnt += (c > 0u) ? 1u : 0u; mine = (j == x) ? c : mine; }
        if (sum == G) break;
        __builtin_amdgcn_s_sleep(1);
        if ((++sp & 255u) == 0u) { if (xb_ld(&bar[XB_TMO])) break; if (sp > XB_SPIN_CAP) { atomicAdd(&bar[XB_TMO], 1u); break; } }
    }
    nloc = mine > 0u ? mine : 1u; nx = cnt > 0u ? cnt : 1u;
}

__device__ __forceinline__ void xcd_barrier(const XcdBarrier& b) {
    asm volatile("s_waitcnt vmcnt(0)" ::: "memory");
    __syncthreads();
    if (threadIdx.x == 0) {
        unsigned* bar = b.bar;
        __builtin_amdgcn_s_waitcnt(0);
        unsigned nloc = b.st[0], nx = b.st[1];
        if (nloc == 0u) { xcd_barrier_complete(bar, b.x, nloc, nx); b.st[0] = nloc; b.st[1] = nx; }
        const unsigned old = xb_add(&bar[XB_XSUB(b.x)], 1u);
        const unsigned gen = old / nloc;
        if (old + 1u == (gen + 1u) * nloc) {
            __builtin_amdgcn_fence(__ATOMIC_RELEASE, "agent");
            asm volatile("s_waitcnt vmcnt(0)" ::: "memory");
            const unsigned og = xb_add(&bar[XB_TOP], 1u);
            const unsigned tg = og / nx;
            if (og + 1u == (tg + 1u) * nx) xb_add(&bar[XB_TOPGEN], 1u);
            else XB_SPIN(xb_ld(&bar[XB_TOPGEN]) == tg, bar);
            __builtin_amdgcn_fence(__ATOMIC_ACQUIRE, "agent");
            xb_add(&bar[XB_XGEN(b.x)], 1u);
            asm volatile("s_waitcnt vmcnt(0)" ::: "memory");
        } else {
            XB_SPIN(xb_ld(&bar[XB_XGEN(b.x)]) == gen, bar);
            __builtin_amdgcn_fence(__ATOMIC_ACQUIRE, "agent");
            asm volatile("s_waitcnt vmcnt(0)" ::: "memory");
        }
    }
    __syncthreads();
}

constexpr int LDS_BYTES = 147456;
__global__ void __launch_bounds__(512, 2) mega_fwd(Ptrs P) {
    extern __shared__ __attribute__((aligned(16))) unsigned char lds[];
    cg::grid_group grid = cg::this_grid();
    if (P.use_cg) grid.sync();
    unsigned char* ws = P.ws;
    PG8_LAS unsigned char* ldsp = (PG8_LAS unsigned char*)lds;
    const int NGW = gridDim.x * 8;
    volatile LAS unsigned* bst = (volatile LAS unsigned*)(ldsp + 143360);
    if (threadIdx.x == 0) { bst[0] = 0u; bst[1] = 0u; }
    __syncthreads();
    const XcdBarrier bar = xcd_barrier_post((unsigned*)(ws + WS_CTL), bst);
#define GRID_SYNC() xcd_barrier(bar)
#define FRESH_IDS() int tid_; asm volatile("v_mov_b32 %0, %1" : "=v"(tid_) : "v"(threadIdx.x)); const int lane = tid_ & 63, gw = blockIdx.x * 8 + (tid_ >> 6)
    ph_prologue(P, (float*)lds);
    { FRESH_IDS(); pass_prenorm(P.x, P.pre_mix_g, (bf16_t*)(ws + WS_XN), (float*)(ws + WS_CS + 512 * 1024), gw, NGW, lane); }
    GRID_SYNC();
    { pg8::Gemm g{(const bf16_t*)(ws + WS_XN), (const bf16_t*)(ws + WS_WIN), M, DINP, DM}; pg8::StaticOrder S; S.init(M, DINP, (int)gridDim.x, (int)blockIdx.x);
      pg8::gemm_phase<pg8::EpiInProjT, pg8::StaticOrder, true, true>(ldsp, g, S, pg8::EpiInProjT{ws}); }
    if (gridDim.x == 256 && blockIdx.x >= 128) convert_items(P, (float*)lds, I_CUT, I_ALL, (blockIdx.x - 128) * 8 + (threadIdx.x >> 6), 128 * 8);
    GRID_SYNC();
    attn_phase(P, (char*)lds);
    GRID_SYNC();
    { pg8::Gemm g{(const bf16_t*)(ws + WS_O), (const bf16_t*)(ws + WS_WOUT), M, DM, DM}; pg8::StaticOrder S; S.init(M, DM, (int)gridDim.x, (int)blockIdx.x);
      PG8_LAS float* T = (PG8_LAS float*)(ldsp + 139264);
      { pg8::Unit u; const float* SS = (const float*)(ws + WS_Y);
        for (int i = 0; i < 2; ++i) if (S.next(i, u) && threadIdx.x < 256) { const int row = u.pm * 256 + (int)threadIdx.x;
            float sa = 0.f, sb = 0.f;
#pragma unroll
            for (int q4 = 0; q4 < 4; ++q4) { const f32x4 a4 = *(const f32x4*)(SS + (size_t)row * 32 + 4 * q4), b4 = *(const f32x4*)(SS + (size_t)row * 32 + 16 + 4 * q4); sa += (a4[0] + a4[1]) + (a4[2] + a4[3]); sb += (b4[0] + b4[1]) + (b4[2] + b4[3]); }
            const float ra = 1.0f / sqrtf(sa * (1.0f / 1024.f) + EPS), rb = 1.0f / sqrtf(sb * (1.0f / 1024.f) + EPS);
            T[(i * 256 + (int)threadIdx.x) * 2] = ra / rb; T[(i * 256 + (int)threadIdx.x) * 2 + 1] = rb; } }
      __syncthreads();
      pg8::gemm_phase<pg8::EpiOutT, pg8::StaticOrder, true, true>(ldsp, g, S, pg8::EpiOutT{(bf16_t*)(ws + WS_MIX), DM, T}); }
    GRID_SYNC();
    { FRESH_IDS(); pass_postmix((bf16_t*)(ws + WS_XN), (const float*)(ws + WS_CS + 512 * 1024), P.pre_mix_g, (const bf16_t*)(ws + WS_MIX), P.post_mix_g, P.pre_ffn_g, (float*)(ws + WS_CS + 256 * 1024), gw, NGW, lane); }
    GRID_SYNC();
    { pg8::Gemm g{(const bf16_t*)(ws + WS_XN), (const bf16_t*)(ws + WS_WUP), M, NUP, DM}; pg8::StaticOrder S; S.init(M, NUP, (int)gridDim.x, (int)blockIdx.x);
      pg8::gemm_phase<pg8::EpiUpT, pg8::StaticOrder, true, true>(ldsp, g, S, pg8::EpiUpT{(bf16_t*)(ws + WS_ACT), P.conv_w, P.conv_b, (float*)(ws + WS_SIDE), (PG8_LAS float*)(ldsp + 131072)}); }
    GRID_SYNC();
    ph_convfix((const float*)(ws + WS_SIDE), P.conv_w, P.conv_b, (bf16_t*)(ws + WS_ACT));
    GRID_SYNC();
    { pg8::Gemm g{(const bf16_t*)(ws + WS_ACT), (const bf16_t*)(ws + WS_WDN), M, DM, DFF}; pg8::StaticOrder S; S.init(M, DM, (int)gridDim.x, (int)blockIdx.x);
      pg8::gemm_phase<pg8::EpiBf16T, pg8::StaticOrder, true, true>(ldsp, g, S, pg8::EpiBf16T{(bf16_t*)(ws + WS_Y), DM}); }
    GRID_SYNC();
    { FRESH_IDS(); pass_final((const bf16_t*)(ws + WS_XN), (const float*)(ws + WS_CS + 256 * 1024), P.pre_ffn_g, (const bf16_t*)(ws + WS_Y), P.post_ffn_g, P.out, gw, NGW, lane); }
}

extern "C" void kernel_launch(void* const* d_in, const int* in_sizes, int n_in, void* d_out, int out_size, void* d_ws, size_t ws_size, hipStream_t stream) {
    if (n_in != 15 || ws_size < WS_END || out_size != M * DM) { fprintf(stderr, "kernel_launch: unexpected sizes n_in %d ws %zu out %d\n", n_in, ws_size, out_size); return; }
    static int grid_blocks = 0;
    if (!grid_blocks) {
        int dev = 0, cus = 0, per_cu = 0;
        hipGetDevice(&dev);
        hipDeviceGetAttribute(&cus, hipDeviceAttributeMultiprocessorCount, dev);
        if (hipFuncSetAttribute((const void*)mega_fwd, hipFuncAttributeMaxDynamicSharedMemorySize, LDS_BYTES) != hipSuccess) fprintf(stderr, "kernel_launch: hipFuncSetAttribute failed\n");
        hipOccupancyMaxActiveBlocksPerMultiprocessor(&per_cu, (const void*)mega_fwd, 512, LDS_BYTES);
        if (per_cu < 1) { fprintf(stderr, "kernel_launch: occupancy query gave %d\n", per_cu); per_cu = 1; }
        grid_blocks = cus * per_cu;
        if (grid_blocks != 256) fprintf(stderr, "kernel_launch: expected 256 resident workgroups, got %d (the output projection assumes two units per workgroup)\n", grid_blocks);
        (void)hipGetLastError();
    }
    Ptrs P{};
    const float** pp = (const float**)&P;
    for (int i = 0; i < 15; ++i) pp[i] = (const float*)d_in[i];
    P.out = (float*)d_out; P.ws = (unsigned char*)d_ws;
    P.use_cg = 0; P.pad = 0;
    if (hipMemsetAsync((char*)d_ws + WS_CTL, 0, CTL_BYTES, stream) != hipSuccess) { fprintf(stderr, "kernel_launch: hipMemsetAsync failed\n"); return; }
    void* args[] = {&P};
    hipError_t e = hipLaunchCooperativeKernel((const void*)mega_fwd, dim3(grid_blocks), dim3(512), args, LDS_BYTES, stream);
    if (e != hipSuccess) fprintf(stderr, "cooperative launch failed: %s (grid %d)\n", hipGetErrorString(e), grid_blocks);
}
```

```cpp
#include <hip/hip_runtime.h>
#include <hip/hip_cooperative_groups.h>
namespace cg = cooperative_groups;
#include <cstdio>
#include <cstdint>

constexpr int NB = 4, SEQ = 4096, DM = 2048, M = NB * SEQ;
constexpr int HD = 64, NHA = 16, NKVA = 2, NHB = 16, WIN = 128, DFF = 5632, NUP = 2 * DFF;
constexpr int DIN = 4368, DINP = 4608;
constexpr float EPS = 1e-6f;
constexpr float LOG2E = 1.4426950408889634f;
constexpr float C2 = 0.125f * LOG2E;

constexpr size_t MiB = 1u << 20;
constexpr size_t WS_WIN = 0, WS_WOUT = 18 * MiB, WS_WUP = 26 * MiB, WS_WDN = 70 * MiB;
constexpr size_t WS_XN = 92 * MiB;
constexpr size_t WS_CS = 156 * MiB, WS_F = 157 * MiB, WS_SIDE = 158 * MiB;
constexpr size_t WS_QA = 170 * MiB, WS_KA = 202 * MiB, WS_VA = 206 * MiB, WS_QB = 210 * MiB, WS_KB = 242 * MiB, WS_VB = 274 * MiB, WS_O = 306 * MiB;
constexpr size_t WS_ACT = 170 * MiB;
constexpr size_t WS_MIX = 370 * MiB, WS_Y = 434 * MiB;
constexpr size_t WS_CTL = 169 * MiB + 768 * 1024, CTL_BYTES = 16 * 1024;
constexpr size_t WS_END = 498 * MiB;

typedef unsigned short bf16_t;
typedef unsigned v4u __attribute__((ext_vector_type(4)));
typedef float f32x4 __attribute__((ext_vector_type(4)));

__device__ __forceinline__ unsigned f2bf(float f) { unsigned u = __builtin_bit_cast(unsigned, f); return (u + 0x7fffu + ((u >> 16) & 1u)) >> 16; }
__device__ __forceinline__ unsigned pk2(float lo, float hi) { return f2bf(lo) | (f2bf(hi) << 16); }
__device__ __forceinline__ float bf2f(unsigned h) { return __builtin_bit_cast(float, h << 16); }
__device__ __forceinline__ float wave_sum(float v) {
#pragma unroll
    for (int o = 1; o < 64; o <<= 1) v += __shfl_xor(v, o);
    return v;
}
__device__ __forceinline__ float wave_max(float v) {
#pragma unroll
    for (int o = 1; o < 64; o <<= 1) v = fmaxf(v, __shfl_xor(v, o));
    return v;
}

__device__ __forceinline__ int rowmap(int n, int map) {
    if (map == 0) return n;
    if (n < DFF) return ((n >> 7) << 8) + (n & 127);
    const int g = n - DFF; return ((g >> 7) << 8) + 128 + (g & 127);
}
__device__ __forceinline__ void transpose_item(const float* W, int K, int N, int Npad, bf16_t* WT, int map, float* scr, int item, int lane, const float* ks0 = nullptr, const float* ks1 = nullptr) {
    const int nblk = Npad / 32, kb = item / nblk, nb = item % nblk, k0 = 128 * kb, n0 = 32 * nb;
    { const int n4 = lane & 7, n = n0 + 4 * n4;
      f32x4 w[16];
#pragma unroll
      for (int i = 0; i < 16; ++i) { const int kk = (lane >> 3) + 8 * i; w[i] = (n < N) ? __builtin_nontemporal_load((const f32x4*)(W + (size_t)(k0 + kk) * N + n)) : (f32x4){0.f, 0.f, 0.f, 0.f}; }
#pragma unroll
      for (int i = 0; i < 16; ++i) { const int kk = (lane >> 3) + 8 * i;
          if (ks0) w[i] = w[i] * ((k0 < 1024) ? ks0[k0 + kk] : ks1[k0 + kk - 1024]);
#pragma unroll
          for (int j = 0; j < 4; ++j) scr[kk * 33 + 4 * n4 + j] = w[i][j]; } }
    __builtin_amdgcn_s_waitcnt(0); asm volatile("" ::: "memory");
    const int c = lane & 15;
#pragma unroll
    for (int j = 0; j < 8; ++j) { const int n = (lane >> 4) + 4 * j; const float* s = scr + (8 * c) * 33 + n;
        v4u o; o.x = pk2(s[0 * 33], s[1 * 33]); o.y = pk2(s[2 * 33], s[3 * 33]); o.z = pk2(s[4 * 33], s[5 * 33]); o.w = pk2(s[6 * 33], s[7 * 33]);
        *(v4u*)(WT + (size_t)rowmap(n0 + n, map) * K + k0 + 8 * c) = o; }
    __builtin_amdgcn_s_waitcnt(0); asm volatile("" ::: "memory");
}
struct Ptrs {
    const float *x, *pre_mix_g, *w_in, *b_forget, *sinks, *grp_swa_g, *grp_fox_g, *w_out, *post_mix_g, *pre_ffn_g, *w_up, *conv_w, *conv_b, *w_down, *post_ffn_g;
    float* out; unsigned char* ws;
    int use_cg, pad;
};
constexpr int I_IN = (DM / 128) * (DINP / 32), I_OUT = (DM / 128) * (DM / 32), I_UP = (DM / 128) * (NUP / 32), I_DN = (DFF / 128) * (DM / 32);
constexpr int I_CUT = I_IN + I_OUT, I_ALL = I_IN + I_OUT + I_UP + I_DN;
__device__ __forceinline__ void convert_items(const Ptrs& P, float* scr_all, int lo, int hi, int gw, int NGW) {
    const int tid = threadIdx.x, lane = tid & 63, wave = tid >> 6;
    float* scr = scr_all + wave * 128 * 33;
    for (int it = lo + gw; it < hi; it += NGW) {
        int r = it;
        if (r < I_IN) { transpose_item(P.w_in, DM, DIN, DINP, (bf16_t*)(P.ws + WS_WIN), 0, scr, r, lane); continue; } r -= I_IN;
        if (r < I_OUT) { transpose_item(P.w_out, DM, DM, DM, (bf16_t*)(P.ws + WS_WOUT), 0, scr, r, lane, P.grp_swa_g, P.grp_fox_g); continue; } r -= I_OUT;
        if (r < I_UP) { transpose_item(P.w_up, DM, NUP, NUP, (bf16_t*)(P.ws + WS_WUP), 1, scr, r, lane); continue; } r -= I_UP;
        transpose_item(P.w_down, DFF, DM, DM, (bf16_t*)(P.ws + WS_WDN), 0, scr, r, lane);
    }
}
__device__ __forceinline__ void ph_prologue(const Ptrs& P, float* scr_all) {
    const int tid = threadIdx.x;
    const bool defer = (gridDim.x == 256);
    convert_items(P, scr_all, 0, defer ? I_CUT : I_ALL, blockIdx.x * 8 + (tid >> 6), gridDim.x * 8);
    (void)tid;
}

__device__ __forceinline__ void row_load(const float* row, int lane, f32x4 (&v)[8]) {
#pragma unroll
    for (int j = 0; j < 8; ++j) v[j] = ((const f32x4*)row)[lane + 64 * j];
}
__device__ __forceinline__ void row_load_bf16(const bf16_t* row, int lane, f32x4 (&v)[8]) {
#pragma unroll
    for (int j = 0; j < 8; ++j) { const unsigned long long w = ((const unsigned long long*)row)[lane + 64 * j];
        v[j] = (f32x4){bf2f((unsigned)w & 0xffffu), bf2f(((unsigned)w >> 16)), bf2f((unsigned)(w >> 32) & 0xffffu), bf2f((unsigned)(w >> 48))}; }
}
__device__ __forceinline__ float row_sumsq(const f32x4 (&v)[8]) {
    float s = 0.f;
#pragma unroll
    for (int j = 0; j < 8; ++j) s += (v[j].x * v[j].x + v[j].y * v[j].y) + (v[j].z * v[j].z + v[j].w * v[j].w);
    return wave_sum(s);
}
__device__ __forceinline__ void row_store_bf16(bf16_t* orow, int lane, const f32x4 (&v)[8]) {
#pragma unroll
    for (int j = 0; j < 8; ++j) ((unsigned long long*)orow)[lane + 64 * j] = (unsigned long long)pk2(v[j].x, v[j].y) | ((unsigned long long)pk2(v[j].z, v[j].w) << 32);
}
__device__ __forceinline__ void pass_prenorm(const float* x, const float* g, bf16_t* xn, float* r0s, int gw, int NGW, int lane) {
    f32x4 gv[8]; row_load(g, lane, gv);
    for (int m = gw; m < M; m += NGW) {
        f32x4 v[8];
#pragma unroll
        for (int j = 0; j < 8; ++j) v[j] = __builtin_nontemporal_load((const f32x4*)(x + (size_t)m * DM) + lane + 64 * j);
        const float r = 1.0f / sqrtf(row_sumsq(v) * (1.0f / DM) + EPS);
#pragma unroll
        for (int j = 0; j < 8; ++j) v[j] = v[j] * r * gv[j];
        row_store_bf16(xn + (size_t)m * DM, lane, v);
        if (lane == 0) r0s[m] = r;
    }
}
__device__ __forceinline__ void pass_postmix(bf16_t* xn, const float* r0s, const float* gpm, const bf16_t* mix, const float* gpost, const float* gpre, float* r2s, int gw, int NGW, int lane) {
    f32x4 ig[8]; row_load(gpm, lane, ig);
#pragma unroll
    for (int j = 0; j < 8; ++j) { ig[j][0] = __builtin_amdgcn_rcpf(ig[j][0]); ig[j][1] = __builtin_amdgcn_rcpf(ig[j][1]); ig[j][2] = __builtin_amdgcn_rcpf(ig[j][2]); ig[j][3] = __builtin_amdgcn_rcpf(ig[j][3]); }
    for (int m = gw; m < M; m += NGW) {
        f32x4 v[8], xv[8], gv[8]; row_load_bf16(mix + (size_t)m * DM, lane, v); row_load_bf16(xn + (size_t)m * DM, lane, xv); row_load(gpost, lane, gv);
        const float ir0 = __builtin_amdgcn_rcpf(r0s[m]);
        const float r = 1.0f / sqrtf(row_sumsq(v) * (1.0f / DM) + EPS);
#pragma unroll
        for (int j = 0; j < 8; ++j) v[j] = xv[j] * ig[j] * ir0 + v[j] * r * gv[j];
        const float r2 = 1.0f / sqrtf(row_sumsq(v) * (1.0f / DM) + EPS);
        row_load(gpre, lane, gv);
#pragma unroll
        for (int j = 0; j < 8; ++j) v[j] = v[j] * r2 * gv[j];
        row_store_bf16(xn + (size_t)m * DM, lane, v);
        if (lane == 0) r2s[m] = r2;
    }
}
__device__ __forceinline__ void pass_final(const bf16_t* xn, const float* r2s, const float* gpre, const bf16_t* y, const float* g, float* out, int gw, int NGW, int lane) {
    f32x4 ig[8]; row_load(gpre, lane, ig);
#pragma unroll
    for (int j = 0; j < 8; ++j) { ig[j][0] = __builtin_amdgcn_rcpf(ig[j][0]); ig[j][1] = __builtin_amdgcn_rcpf(ig[j][1]); ig[j][2] = __builtin_amdgcn_rcpf(ig[j][2]); ig[j][3] = __builtin_amdgcn_rcpf(ig[j][3]); }
    f32x4 gv[8]; row_load(g, lane, gv);
    for (int m = gw; m < M; m += NGW) {
        f32x4 v[8], xv[8]; row_load_bf16(xn + (size_t)m * DM, lane, xv); row_load_bf16(y + (size_t)m * DM, lane, v);
        const float ir2 = __builtin_amdgcn_rcpf(r2s[m]);
        const float r = 1.0f / sqrtf(row_sumsq(v) * (1.0f / DM) + EPS);
#pragma unroll
        for (int j = 0; j < 8; ++j) __builtin_nontemporal_store(xv[j] * ig[j] * ir2 + v[j] * r * gv[j], (f32x4*)(out + (size_t)m * DM) + lane + 64 * j);
    }
}
__device__ __forceinline__ float log_sigmoid(float z) {
    const float e = __builtin_amdgcn_exp2f(-fabsf(z) * LOG2E), l = __builtin_amdgcn_logf(1.0f + e) * 0.6931471805599453f;
    return fminf(z, 0.f) - l;
}
__device__ __forceinline__ float gelu_tanh(float x) {
    const float z = 0.7978845608028654f * (x + 0.044715f * x * x * x);
    return x / (1.0f + exp2f(-2.0f * LOG2E * z));
}
namespace pg8 {
#define PG8_LAS __attribute__((address_space(3)))
typedef unsigned short bf16_t;
typedef short bf16x8 __attribute__((ext_vector_type(8)));
typedef float f32x4 __attribute__((ext_vector_type(4)));
typedef unsigned u32x4 __attribute__((ext_vector_type(4)));
constexpr int BM = 256, BK = 64, HALF = 128, HTB = HALF * BK * 2  , STAGE_BYTES = 8 * HTB, NXCD = 8, WGM = 8;

__host__ __device__ __forceinline__ int lds_byte(int r, int c) { const int st = (r >> 4) * 2 + (c >> 5), rr = r & 15, cc = c & 31, ob = rr * 64 + cc * 2; return st * 1024 + (ob ^ (((ob >> 9) & 1) << 5)); }
__host__ __device__ __forceinline__ void stage_rc(int b, int& R, int& C) { const int st = b / 1024, sb = b % 1024, swz = sb ^ (((sb >> 9) & 1) << 5); R = (st >> 1) * 16 + swz / 64; C = (st & 1) * 32 + (swz % 64) / 2; }
__host__ __device__ __forceinline__ int perm32(int rho) { const int n = rho >> 4, i = rho & 15; return 8 * (i >> 2) + 4 * n + (i & 3); }

struct Unit { int pm, pn; };
struct Gemm { const bf16_t* A; const bf16_t* Bt; int M, N, K; };

struct StaticOrder {
    int nM, nN, nwg, G, c;
    __host__ __device__ void init(int M, int N, int G_, int c_) { nM = M / BM; nN = N / BM; nwg = nM * nN; G = G_; c = c_; }
    __host__ __device__ bool next(int i, Unit& u) const {
        const long L = (long)i * G + c; if (L >= nwg) return false;
        int wgid = (int)L; { const int q = nwg / NXCD, r = nwg % NXCD, xcd = wgid % NXCD, off = wgid / NXCD; wgid = (xcd < r ? xcd * (q + 1) : r * (q + 1) + (xcd - r) * q) + off; }
        const int nig = WGM * nN, gid = wgid / nig, fm = gid * WGM, gsz = (nM - fm) < WGM ? (nM - fm) : WGM;
        u.pm = fm + ((wgid % nig) % gsz); u.pn = (wgid % nig) / gsz; return true;
    }
    __device__ __forceinline__ void a_ready(const Unit&) const {}
    __device__ __forceinline__ void done(const Unit&) const {}
};

__device__ __forceinline__ unsigned cvt_pk_bf16(float lo, float hi) { unsigned r; asm volatile("v_cvt_pk_bf16_f32 %0, %1, %2" : "=v"(r) : "v"(lo), "v"(hi)); return r; }
typedef float f32x2 __attribute__((ext_vector_type(2)));
template <class Epi, class Sched, bool ALIGN_EPI = false, bool SP2 = false>
__device__ __forceinline__ void gemm_phase(PG8_LAS unsigned char* lds, const Gemm g, const Sched& S, const Epi& E) {
    int tid = threadIdx.x; asm volatile("" : "+v"(tid));
    const int wid = __builtin_amdgcn_readfirstlane(tid >> 6), lane = tid & 63, wr = wid >> 2, wc = wid & 3, fr = lane & 15, fq = lane >> 4;
    const int K = g.K, nt = K / BK;
    unsigned voffA[2], voffB[2];
#pragma unroll
    for (int i = 0; i < 2; ++i) { int R, C; stage_rc(tid * 16 + i * 8192, R, C); const int Rb = Epi::PERM ? ((R & ~31) + perm32(R & 31)) : R;
        voffA[i] = (unsigned)(R * K + C) * 2u; voffB[i] = (unsigned)(Rb * K + C) * 2u; }
    const size_t kstep = (size_t)(BK * 2);
    const size_t hstep = (size_t)HALF * K * 2;
    const size_t tstep = 2 * hstep;
    const unsigned ldsw = (unsigned)wid * 1024u;
    const int aoff = lds_byte(wr * 64 + fr, fq * 8), boff = lds_byte(wc * 32 + fr, fq * 8);
#define PG8_SA(b, h) (((b) * 2 + (h)) * HTB)
#define PG8_SB(b, h) ((4 + (b) * 2 + (h)) * HTB)
    const unsigned ldsb = (unsigned)(uintptr_t)lds + ldsw;
#define PG8_STAGE(bufoff, gbase, voff) do { _Pragma("unroll") for (int _i = 0; _i < 2; ++_i) { unsigned keep_; \
        asm volatile("s_mov_b32 %0, m0\n\ts_mov_b32 m0, %3\n\ts_nop 0\n\tglobal_load_lds_dwordx4 %1, %2\n\ts_mov_b32 m0, %0" : "=&s"(keep_) \
                     : "v"((voff)[_i]), "s"((const char*)(gbase)), "s"((unsigned)__builtin_amdgcn_readfirstlane(ldsb + (unsigned)((bufoff) + _i * 8192))) : "memory"); } } while (0)
#define PG8_LDA(dst, b, h) do { _Pragma("unroll") for (int m = 0; m < 4; ++m) _Pragma("unroll") for (int k = 0; k < 2; ++k) dst[m][k] = *(const PG8_LAS bf16x8*)(lds + PG8_SA(b, h) + aoff + m * 2048 + k * 1024); } while (0)
#define PG8_LDB(dst, b, h) do { _Pragma("unroll") for (int n = 0; n < 2; ++n) _Pragma("unroll") for (int k = 0; k < 2; ++k) dst[n][k] = *(const PG8_LAS bf16x8*)(lds + PG8_SB(b, h) + boff + n * 2048 + k * 1024); } while (0)
#define PG8_MMA(ai, bj, At, Bt) do { __builtin_amdgcn_s_setprio(1); _Pragma("unroll") for (int m = 0; m < 4; ++m) _Pragma("unroll") for (int n = 0; n < 2; ++n) _Pragma("unroll") for (int k = 0; k < 2; ++k) \
        acc[ai][bj][m][n] = __builtin_amdgcn_mfma_f32_16x16x32_bf16(Bt[n][k], At[m][k], acc[ai][bj][m][n], 0, 0, 0); __builtin_amdgcn_s_setprio(0); } while (0)
#define PG8_WAIT_V(n) asm volatile("s_waitcnt vmcnt(" #n ")" ::: "memory")
#define PG8_WAIT_L(n) asm volatile("s_waitcnt lgkmcnt(" #n ")" ::: "memory")
#define PG8_BAR __builtin_amdgcn_s_barrier()
#define PG8_SCHED __builtin_amdgcn_sched_barrier(0)
    Unit cur, nxt; int ui = 0;
    if (!S.next(0, cur)) return;
    f32x4 acc[2][2][4][2];
#pragma unroll
    for (int a = 0; a < 2; ++a)
#pragma unroll
        for (int b = 0; b < 2; ++b)
#pragma unroll
            for (int m = 0; m < 4; ++m)
#pragma unroll
                for (int n = 0; n < 2; ++n) acc[a][b][m][n] = (f32x4){0.f, 0.f, 0.f, 0.f};
    bf16x8 At[4][2], B0[2][2], B1[2][2];
    const char* cA = (const char*)g.A + (size_t)cur.pm * tstep; const char* cB = (const char*)g.Bt + (size_t)cur.pn * tstep;
    S.a_ready(cur);
    if constexpr (SP2) {
        PG8_STAGE(PG8_SB(0, 0), cB, voffB); PG8_STAGE(PG8_SB(0, 1), cB + hstep, voffB); PG8_STAGE(PG8_SA(0, 0), cA, voffA); PG8_STAGE(PG8_SA(0, 1), cA + hstep, voffA);
        if (wr == 1) PG8_BAR;
        PG8_WAIT_V(2); PG8_BAR;
        PG8_STAGE(PG8_SB(1, 0), cB + kstep, voffB); PG8_STAGE(PG8_SA(1, 0), cA + kstep, voffA); PG8_STAGE(PG8_SB(1, 1), cB + hstep + kstep, voffB);
        PG8_WAIT_V(6); PG8_BAR;
    } else {
        PG8_STAGE(PG8_SB(0, 0), cB, voffB); PG8_STAGE(PG8_SA(0, 0), cA, voffA); PG8_STAGE(PG8_SB(0, 1), cB + hstep, voffB); PG8_STAGE(PG8_SA(0, 1), cA + hstep, voffA);
        if (wr == 1) PG8_BAR;
        PG8_WAIT_V(4); PG8_BAR;
        PG8_STAGE(PG8_SB(1, 0), cB + kstep, voffB); PG8_STAGE(PG8_SA(1, 0), cA + kstep, voffA); PG8_STAGE(PG8_SB(1, 1), cB + hstep + kstep, voffB);
        PG8_WAIT_V(6); PG8_BAR;
    }
    for (;;) {
        const bool has_next = S.next(ui + 1, nxt);
        const char* nA = has_next ? (const char*)g.A + (size_t)nxt.pm * tstep : cA; const char* nB = has_next ? (const char*)g.Bt + (size_t)nxt.pn * tstep : cB;
        for (int t = 0; t < nt; t += 2) {
            if constexpr (Epi::MIDK) { if (t == nt / 2) E.midk(acc, ui, wr, fr); }
            const bool last = (t == nt - 2);
            const char* a1 = cA + (size_t)(t + 1) * kstep;
            const char* a2 = last ? nA : cA + (size_t)(t + 2) * kstep; const char* b2 = last ? nB : cB + (size_t)(t + 2) * kstep;
            const char* a3 = a2 + kstep; const char* b3 = b2 + kstep;
            if (last && has_next) S.a_ready(nxt);
            if constexpr (SP2) {
            PG8_LDB(B0, 0, 0); PG8_LDB(B1, 0, 1); PG8_SCHED; PG8_LDA(At, 0, 0); PG8_STAGE(PG8_SA(1, 1), a1 + hstep, voffA);
            PG8_WAIT_V(8); PG8_WAIT_L(0); PG8_BAR; PG8_MMA(0, 0, At, B0); PG8_MMA(0, 1, At, B1); PG8_BAR; PG8_SCHED;
            PG8_LDA(At, 0, 1); PG8_STAGE(PG8_SB(0, 0), b2, voffB); PG8_STAGE(PG8_SB(0, 1), b2 + hstep, voffB); PG8_STAGE(PG8_SA(0, 0), a2, voffA);
            PG8_WAIT_V(8); PG8_WAIT_L(0); PG8_BAR; PG8_MMA(1, 0, At, B0); PG8_MMA(1, 1, At, B1); PG8_BAR; PG8_SCHED;
            PG8_LDB(B0, 1, 0); PG8_LDB(B1, 1, 1); PG8_SCHED; PG8_LDA(At, 1, 0); PG8_STAGE(PG8_SA(0, 1), a2 + hstep, voffA);
            PG8_WAIT_V(8); PG8_WAIT_L(0); PG8_BAR; PG8_MMA(0, 0, At, B0); PG8_MMA(0, 1, At, B1); PG8_BAR; PG8_SCHED;
            PG8_LDA(At, 1, 1); PG8_STAGE(PG8_SB(1, 0), b3, voffB); PG8_STAGE(PG8_SB(1, 1), b3 + hstep, voffB); PG8_STAGE(PG8_SA(1, 0), a3, voffA);
            PG8_WAIT_V(8); PG8_WAIT_L(0); PG8_BAR; PG8_MMA(1, 0, At, B0); PG8_MMA(1, 1, At, B1); PG8_BAR; PG8_SCHED;
            } else {
            PG8_LDB(B0, 0, 0); PG8_SCHED; PG8_LDA(At, 0, 0); PG8_STAGE(PG8_SA(1, 1), a1 + hstep, voffA);
            PG8_WAIT_L(8); PG8_BAR; PG8_WAIT_L(0); PG8_MMA(0, 0, At, B0); PG8_BAR; PG8_SCHED;
            PG8_LDB(B1, 0, 1); PG8_STAGE(PG8_SB(0, 0), b2, voffB);
            PG8_BAR; PG8_WAIT_L(0); PG8_MMA(0, 1, At, B1); PG8_BAR;
            PG8_LDA(At, 0, 1); PG8_STAGE(PG8_SA(0, 0), a2, voffA);
            PG8_BAR; PG8_WAIT_L(0); PG8_MMA(1, 0, At, B0); PG8_BAR; PG8_SCHED;
            PG8_STAGE(PG8_SB(0, 1), b2 + hstep, voffB);
            PG8_WAIT_V(6); PG8_BAR; PG8_MMA(1, 1, At, B1); PG8_BAR;
            PG8_LDB(B0, 1, 0); PG8_SCHED; PG8_LDA(At, 1, 0); PG8_STAGE(PG8_SA(0, 1), a2 + hstep, voffA);
            PG8_WAIT_L(8); PG8_BAR; PG8_WAIT_L(0); PG8_MMA(0, 0, At, B0); PG8_BAR; PG8_SCHED;
            PG8_LDB(B1, 1, 1); PG8_STAGE(PG8_SB(1, 0), b3, voffB);
            PG8_BAR; PG8_WAIT_L(0); PG8_MMA(0, 1, At, B1); PG8_BAR;
            PG8_LDA(At, 1, 1); PG8_STAGE(PG8_SA(1, 0), a3, voffA);
            PG8_BAR; PG8_WAIT_L(0); PG8_MMA(1, 0, At, B0); PG8_BAR; PG8_SCHED;
            PG8_STAGE(PG8_SB(1, 1), b3 + hstep, voffB);
            PG8_WAIT_V(6); PG8_BAR; PG8_MMA(1, 1, At, B1); PG8_BAR;
            }
        }
        if constexpr (ALIGN_EPI) { if (wr == 0) PG8_BAR; }
        if constexpr (Epi::MIDK) { E.epi(acc, cur, ui, wr, wc, fr, fq); S.done(cur); }
        else if constexpr (!Epi::AFTER_DRAIN) { E(acc, cur, wr, wc, fr, fq); S.done(cur); }
        if (!has_next) break;
#pragma unroll
        for (int a = 0; a < 2; ++a)
#pragma unroll
            for (int b = 0; b < 2; ++b)
#pragma unroll
                for (int m = 0; m < 4; ++m)
#pragma unroll
                    for (int n = 0; n < 2; ++n) acc[a][b][m][n] = (f32x4){0.f, 0.f, 0.f, 0.f};
        cur = nxt; cA = nA; cB = nB; ++ui;
        if constexpr (ALIGN_EPI) { if (wr == 1) PG8_BAR; }
    }
    PG8_WAIT_V(0);
    if constexpr (!ALIGN_EPI) { if (wr == 0) PG8_BAR; }
    PG8_BAR;
    if constexpr (Epi::AFTER_DRAIN) { E.fused(acc, cur, wr, wc, fr, fq, lds, wid, lane); S.done(cur); }
#undef PG8_SA
#undef PG8_SB
#undef PG8_STAGE
#undef PG8_LDA
#undef PG8_LDB
#undef PG8_MMA
#undef PG8_WAIT_V
#undef PG8_WAIT_L
#undef PG8_BAR
#undef PG8_SCHED
}
}

namespace pg8 {
struct EpiInProjT {
    static constexpr bool PERM = true, AFTER_DRAIN = false, MIDK = false;
    unsigned char* ws;
    __device__ __forceinline__ void operator()(const f32x4 (&acc)[2][2][4][2], const Unit& u, int wr, int wc, int fr, int fq) const {
        const int row0 = u.pm * BM + wr * 64 + fr, pn = u.pn, cin = wc * 32 + 8 * fq;
        if (pn == 17) {
            if (wc == 0 && fq < 2) { float* F = (float*)(ws + WS_F);
#pragma unroll
                for (int ai = 0; ai < 2; ++ai)
#pragma unroll
                    for (int m = 0; m < 4; ++m)
#pragma unroll
                        for (int n = 0; n < 2; ++n)
#pragma unroll
                            for (int j = 0; j < 4; ++j) F[(size_t)(8 * fq + 4 * n + j) * M + row0 + ai * HALF + m * 16] = acc[ai][0][m][n][j]; }
            return;
        }
        bf16_t *b0, *b1; int ldc; float sc = 1.f;
        if (pn < 4) { b0 = (bf16_t*)(ws + WS_QA) + pn * 256 + cin; b1 = b0 + HALF; ldc = 1024; sc = C2; }
        else if (pn == 4) { b0 = (bf16_t*)(ws + WS_KA) + cin; b1 = (bf16_t*)(ws + WS_VA) + cin; ldc = 128; }
        else if (pn < 9) { b0 = (bf16_t*)(ws + WS_QB) + (pn - 5) * 256 + cin; b1 = b0 + HALF; ldc = 1024; sc = C2; }
        else if (pn < 13) { b0 = (bf16_t*)(ws + WS_KB) + (pn - 9) * 256 + cin; b1 = b0 + HALF; ldc = 1024; }
        else { b0 = (bf16_t*)(ws + WS_VB) + (pn - 13) * 256 + cin; b1 = b0 + HALF; ldc = 1024; }
#pragma unroll
        for (int ai = 0; ai < 2; ++ai)
#pragma unroll
            for (int m = 0; m < 4; ++m) { const size_t ro = (size_t)(row0 + ai * HALF + m * 16) * ldc;
#pragma unroll
                for (int bj = 0; bj < 2; ++bj) { const f32x4 v0 = acc[ai][bj][m][0] * sc, v1 = acc[ai][bj][m][1] * sc;
                    u32x4 w; w.x = cvt_pk_bf16(v0[0], v0[1]); w.y = cvt_pk_bf16(v0[2], v0[3]); w.z = cvt_pk_bf16(v1[0], v1[1]); w.w = cvt_pk_bf16(v1[2], v1[3]);
                    *(u32x4*)((bj ? b1 : b0) + ro) = w; } }
    }
};
struct EpiBf16T {
    static constexpr bool PERM = true, AFTER_DRAIN = false, MIDK = false;
    bf16_t* C; int ldc;
    __device__ __forceinline__ void operator()(const f32x4 (&acc)[2][2][4][2], const Unit& u, int wr, int wc, int fr, int fq) const {
        const int row0 = u.pm * BM + wr * 64 + fr, col0 = u.pn * BM + wc * 32 + 8 * fq;
#pragma unroll
        for (int ai = 0; ai < 2; ++ai)
#pragma unroll
            for (int m = 0; m < 4; ++m) { bf16_t* rp = C + (size_t)(row0 + ai * HALF + m * 16) * ldc + col0;
#pragma unroll
                for (int bj = 0; bj < 2; ++bj) { const f32x4 v0 = acc[ai][bj][m][0], v1 = acc[ai][bj][m][1];
                    u32x4 w; w.x = cvt_pk_bf16(v0[0], v0[1]); w.y = cvt_pk_bf16(v0[2], v0[3]); w.z = cvt_pk_bf16(v1[0], v1[1]); w.w = cvt_pk_bf16(v1[2], v1[3]);
                    *(u32x4*)(rp + bj * HALF) = w; } }
    }
};
struct EpiOutT {
    static constexpr bool PERM = true, AFTER_DRAIN = false, MIDK = true;
    bf16_t* C; int ldc; const PG8_LAS float* T;
    __device__ __forceinline__ void midk(f32x4 (&acc)[2][2][4][2], int ui, int wr, int fr) const {
#pragma unroll
        for (int ai = 0; ai < 2; ++ai)
#pragma unroll
            for (int m = 0; m < 4; ++m) { const float r = T[((ui & 1) * 256 + ai * HALF + wr * 64 + m * 16 + fr) * 2];
#pragma unroll
                for (int bj = 0; bj < 2; ++bj)
#pragma unroll
                    for (int n = 0; n < 2; ++n) acc[ai][bj][m][n] *= r; }
    }
    __device__ __forceinline__ void epi(const f32x4 (&acc)[2][2][4][2], const Unit& u, int ui, int wr, int wc, int fr, int fq) const {
        const int row0 = u.pm * BM + wr * 64 + fr, col0 = u.pn * BM + wc * 32 + 8 * fq;
#pragma unroll
        for (int ai = 0; ai < 2; ++ai)
#pragma unroll
            for (int m = 0; m < 4; ++m) { bf16_t* rp = C + (size_t)(row0 + ai * HALF + m * 16) * ldc + col0; const float r = T[((ui & 1) * 256 + ai * HALF + wr * 64 + m * 16 + fr) * 2 + 1];
#pragma unroll
                for (int bj = 0; bj < 2; ++bj) { const f32x4 v0 = acc[ai][bj][m][0] * r, v1 = acc[ai][bj][m][1] * r;
                    u32x4 w; w.x = cvt_pk_bf16(v0[0], v0[1]); w.y = cvt_pk_bf16(v0[2], v0[3]); w.z = cvt_pk_bf16(v1[0], v1[1]); w.w = cvt_pk_bf16(v1[2], v1[3]);
                    *(u32x4*)(rp + bj * HALF) = w; } }
    }
};
}

namespace pg8 {
__device__ __forceinline__ float dpp_ror1(float x) { return __builtin_bit_cast(float, __builtin_amdgcn_mov_dpp(__builtin_bit_cast(int, x), 0x121, 0xf, 0xf, true)); }
__device__ __forceinline__ float dpp_ror2(float x) { return __builtin_bit_cast(float, __builtin_amdgcn_mov_dpp(__builtin_bit_cast(int, x), 0x122, 0xf, 0xf, true)); }
__device__ __forceinline__ float gelu_tanh_fast(float x) {
    const float e = __builtin_amdgcn_exp2f(-2.3022082f * x * (1.0f + 0.044715f * x * x));
    return x * __builtin_amdgcn_rcpf(1.0f + e);
}
__device__ __forceinline__ f32x4 geglu4(f32x4 g, f32x4 v) {
    const f32x4 t = (g * g) * 0.044715f + 1.0f, a = (g * -2.3022082f) * t;
    f32x4 e; e[0] = __builtin_amdgcn_exp2f(a[0]); e[1] = __builtin_amdgcn_exp2f(a[1]); e[2] = __builtin_amdgcn_exp2f(a[2]); e[3] = __builtin_amdgcn_exp2f(a[3]);
    e = e + 1.0f;
    f32x4 r; r[0] = __builtin_amdgcn_rcpf(e[0]); r[1] = __builtin_amdgcn_rcpf(e[1]); r[2] = __builtin_amdgcn_rcpf(e[2]); r[3] = __builtin_amdgcn_rcpf(e[3]);
    return (g * v) * r;
}
constexpr size_t SIDE_HEAD = 0, SIDE_TAIL = 6 * MiB;
struct EpiUpT {
    static constexpr bool PERM = true, AFTER_DRAIN = false, MIDK = false;
    bf16_t* act; const float* cw; const float* cb; float* side; PG8_LAS float* X;
    __device__ __forceinline__ void operator()(const f32x4 (&acc)[2][2][4][2], const Unit& u, int wr, int wc, int fr, int fq) const {
        const int cin = wc * 32 + 8 * fq;
        f32x4 Wt[2][2][4];
#define EPIUP_LOADW(n_) do { _Pragma("unroll") for (int bj_ = 0; bj_ < 2; ++bj_) { const int col_ = bj_ * DFF + HALF * u.pn + cin + 4 * (n_); \
            if ((n_) == 0) Wt[n_][bj_][0] = *(const f32x4*)(cw + col_); Wt[n_][bj_][1] = *(const f32x4*)(cw + NUP + col_); Wt[n_][bj_][2] = *(const f32x4*)(cw + 2 * NUP + col_); } } while (0)
#define EPIUP_LOADB(n_) do { _Pragma("unroll") for (int bj_ = 0; bj_ < 2; ++bj_) { Wt[n_][bj_][3] = *(const f32x4*)(cb + bj_ * DFF + HALF * u.pn + cin + 4 * (n_)); if ((n_) == 1) Wt[n_][bj_][0] = *(const f32x4*)(cw + bj_ * DFF + HALF * u.pn + cin + 4 * (n_)); } } while (0)
        EPIUP_LOADW(0); EPIUP_LOADB(0); EPIUP_LOADW(1);
        if (fr >= 14) {
#pragma unroll
            for (int ai = 0; ai < 2; ++ai)
#pragma unroll
                for (int bj = 0; bj < 2; ++bj)
#pragma unroll
                    for (int n = 0; n < 2; ++n) *(PG8_LAS f32x4*)(X + ((2 * ai + wr) * 2 + (fr - 14)) * 256 + bj * HALF + cin + 4 * n) = acc[ai][bj][3][n];
            if (wr == 1) {
#pragma unroll
                for (int bj = 0; bj < 2; ++bj)
#pragma unroll
                    for (int n = 0; n < 2; ++n) *(f32x4*)(side + SIDE_TAIL / 4 + ((size_t)u.pm * 2 + (fr - 14)) * NUP + u.pn * BM + bj * HALF + cin + 4 * n) = acc[1][bj][3][n];
            }
        }
        if (fr < 2 && wr == 0) {
#pragma unroll
            for (int bj = 0; bj < 2; ++bj)
#pragma unroll
                for (int n = 0; n < 2; ++n) *(f32x4*)(side + SIDE_HEAD / 4 + ((size_t)u.pm * 2 + fr) * NUP + u.pn * BM + bj * HALF + cin + 4 * n) = acc[0][bj][0][n];
        }
        asm volatile("s_waitcnt lgkmcnt(0)" ::: "memory"); __builtin_amdgcn_s_barrier(); asm volatile("" ::: "memory");
#pragma unroll
        for (int ai = 0; ai < 2; ++ai) {
            const int b4 = 2 * ai + wr;
            typedef unsigned u32x2v __attribute__((ext_vector_type(2)));
            u32x2v st[4];
#pragma unroll
            for (int n = 0; n < 2; ++n) {
                f32x4 p1[2], p2[2];
#pragma unroll
                for (int bj = 0; bj < 2; ++bj) {
                    f32x4 h62 = (f32x4){0.f, 0.f, 0.f, 0.f}, h63 = h62;
                    if (b4 > 0) { h62 = *(const PG8_LAS f32x4*)(X + ((b4 - 1) * 2 + 0) * 256 + bj * HALF + cin + 4 * n); h63 = *(const PG8_LAS f32x4*)(X + ((b4 - 1) * 2 + 1) * 256 + bj * HALF + cin + 4 * n); }
                    p1[bj] = h63; p2[bj] = (fr == 1) ? h63 : h62;
                }
#pragma unroll
                for (int m = 0; m < 4; ++m) {
                    f32x4 y[2];
#pragma unroll
                    for (int bj = 0; bj < 2; ++bj) {
                        const f32x4 v = acc[ai][bj][m][n];
                        f32x4 r1, r2;
#pragma unroll
                        for (int j = 0; j < 4; ++j) { r1[j] = dpp_ror1(v[j]); r2[j] = dpp_ror2(v[j]); }
                        const f32x4 q1 = (fr >= 1) ? r1 : p1[bj], q2 = (fr >= 2) ? r2 : p2[bj];
                        y[bj] = (Wt[n][bj][2] * v + Wt[n][bj][1] * q1) + (Wt[n][bj][0] * q2 + Wt[n][bj][3]);
                        p1[bj] = r1; p2[bj] = r2;
                    }
                    const f32x4 o4 = geglu4(y[0], y[1]); u32x2v w; w.x = cvt_pk_bf16(o4[0], o4[1]); w.y = cvt_pk_bf16(o4[2], o4[3]);
                    if (n == 0) st[m] = w;
                    else __builtin_nontemporal_store((u32x4){st[m].x, st[m].y, w.x, w.y}, (u32x4*)(act + (size_t)(u.pm * BM + ai * HALF + wr * 64 + m * 16 + fr) * DFF + HALF * u.pn + cin));
                    __builtin_amdgcn_sched_barrier(0);
                }
                if (ai == 0 && n == 0) { EPIUP_LOADB(1); __builtin_amdgcn_sched_barrier(0); }
            }
            asm volatile("" ::: "memory"); __builtin_amdgcn_sched_barrier(0);
        }
#undef EPIUP_LOADW
#undef EPIUP_LOADB
    }
};
}
__device__ __forceinline__ void ph_convfix(const float* side, const float* cw, const float* cb, bf16_t* act) {
    const float* head = side + pg8::SIDE_HEAD / 4; const float* tail = side + pg8::SIDE_TAIL / 4;
    for (int idx = blockIdx.x * 512 + threadIdx.x; idx < 64 * 2 * DFF; idx += gridDim.x * 512) {
        const int pm = idx / (2 * DFF), r = (idx / DFF) & 1, n = idx % DFF;
        if ((pm & 15) == 0) continue;
        const int pg = ((n >> 7) << 8) + (n & 127);
        float y[2];
#pragma unroll
        for (int h = 0; h < 2; ++h) { const int pc = pg + 128 * h, col = h * DFF + n;
            const float H0 = head[((size_t)pm * 2 + 0) * NUP + pc], H1 = head[((size_t)pm * 2 + 1) * NUP + pc];
            const float T0 = tail[((size_t)(pm - 1) * 2 + 0) * NUP + pc], T1 = tail[((size_t)(pm - 1) * 2 + 1) * NUP + pc];
            const float w0 = cw[col], w1 = cw[NUP + col], w2 = cw[2 * NUP + col];
            y[h] = cb[col] + (r == 0 ? (w2 * H0 + w1 * T1 + w0 * T0) : (w2 * H1 + w1 * H0 + w0 * T1)); }
        act[(size_t)(256 * pm + r) * DFF + n] = (bf16_t)f2bf(gelu_tanh(y[0]) * y[1]);
    }
}
#include <hip/hip_bf16.h>
#include <cmath>
namespace attn_body {
using bf16=__hip_bfloat16;
using bf16x8=__attribute__((ext_vector_type(8)))short;
using s16x4=__attribute__((ext_vector_type(4)))short;
using f32x16=__attribute__((ext_vector_type(16)))float;
using u32x4=__attribute__((ext_vector_type(4)))unsigned;
using f32x4v=__attribute__((ext_vector_type(4)))float;
constexpr int BATCH=4,NHEAD=16,SEQ=4096,D=64,QP=1024,OP=2048;
constexpr int NW=8,QBLK=32,QB=QBLK*NW,KVBLK=64,NQB=SEQ/QB;
constexpr int ATTN_UNIT_ROWS=QB;
__device__ __forceinline__ int crow(int r,int hi){return (r&3)+8*(r>>2)+4*hi;}
#define SBAR() __builtin_amdgcn_sched_barrier(0)
template<bool WIN> __device__ __forceinline__ void amask(f32x16&p0,f32x16&p1,int koff,int qrel,int hi){
  const float NEG=-INFINITY; int d=qrel-(koff+4*hi); asm volatile("":"+v"(d));
  #pragma unroll
  for(int r=0;r<16;++r){const int kc=(r&3)+8*(r>>2);
    if(kc>d||(WIN&&kc<=d-128))p0[r]=NEG; if(kc+32>d||(WIN&&kc+32<=d-128))p1[r]=NEG;}
}

constexpr int NSLOT=3, SLOTB=8192;
constexpr int LDS_K=0, LDS_V=NSLOT*SLOTB, LDS_WS=2*NSLOT*SLOTB, LDS_OST=LDS_WS+NW*64*4, LDS_CL=LDS_OST+NW*4096+2048, LDS_CL2=LDS_CL+SEQ*4, LDS_WT=LDS_CL2+384*4, LDS_BYTES=LDS_WT+64;
constexpr float C2=0.125f*1.4426950408889634f;
__device__ __forceinline__ void glds16(const void*gsrc,unsigned lds_dst){unsigned keep;
  asm volatile("s_mov_b32 %0, m0\n\ts_mov_b32 m0, %2\n\ts_nop 0\n\tglobal_load_lds_dwordx4 %1, off\n\ts_mov_b32 m0, %0":"=&s"(keep):"v"(gsrc),"s"(lds_dst):"memory");}
__device__ __forceinline__ float max3f(float a,float b,float c){float r;asm("v_max3_f32 %0, %1, %2, %3":"=v"(r):"v"(a),"v"(b),"v"(c));return r;}
__device__ __forceinline__ float max2f(float a,float b){float r;asm("v_max_f32_e32 %0, %1, %2":"=v"(r):"v"(a),"v"(b));return r;}
__device__ __forceinline__ float fadd_s(float a,float b){float r;asm("v_add_f32_e32 %0, %1, %2":"=v"(r):"v"(a),"v"(b));return r;}
__device__ __forceinline__ float fsub_s(float a,float b){float r;asm("v_sub_f32_e32 %0, %1, %2":"=v"(r):"v"(a),"v"(b));return r;}
typedef float f32x2_t __attribute__((ext_vector_type(2))); typedef __bf16 bf16x2_t __attribute__((ext_vector_type(2)));
__device__ __forceinline__ unsigned cvtpk_s(float lo,float hi){f32x2_t v={lo,hi};bf16x2_t b=__builtin_convertvector(v,bf16x2_t);return __builtin_bit_cast(unsigned,b);}
#define WAIT_BAR(N) asm volatile("s_waitcnt vmcnt(" #N ") lgkmcnt(0)\n\ts_barrier":::"memory")

__device__ __forceinline__ void qkt(f32x16&p0,f32x16&p1,const char*Kslot,const bf16x8*qr,int r32,int hi){
  const char*kb=Kslot+hi*1024+r32*16;
  #pragma unroll
  for(int d0=0;d0<4;++d0){
    const bf16x8 b0=*reinterpret_cast<const bf16x8*>(kb+d0*2048);
    const bf16x8 b1=*reinterpret_cast<const bf16x8*>(kb+d0*2048+512);
    if(d0==0){p0=__builtin_amdgcn_mfma_f32_32x32x16_bf16(b0,qr[0],p0,0,0,0);p1=__builtin_amdgcn_mfma_f32_32x32x16_bf16(b1,qr[0],p1,0,0,0);}
    else{p0=__builtin_amdgcn_mfma_f32_32x32x16_bf16(b0,qr[d0],p0,0,0,0);p1=__builtin_amdgcn_mfma_f32_32x32x16_bf16(b1,qr[d0],p1,0,0,0);}}
}
typedef __attribute__((address_space(3))) const char* lds_cptr;
typedef short v4i16_t __attribute__((ext_vector_type(4)));
__device__ __forceinline__ void kload8(bf16x8*kf,lds_cptr kp){
  kf[0]=*(const __attribute__((address_space(3))) bf16x8*)(kp);      kf[1]=*(const __attribute__((address_space(3))) bf16x8*)(kp+512);
  kf[2]=*(const __attribute__((address_space(3))) bf16x8*)(kp+2048); kf[3]=*(const __attribute__((address_space(3))) bf16x8*)(kp+2560);
  kf[4]=*(const __attribute__((address_space(3))) bf16x8*)(kp+4096); kf[5]=*(const __attribute__((address_space(3))) bf16x8*)(kp+4608);
  kf[6]=*(const __attribute__((address_space(3))) bf16x8*)(kp+6144); kf[7]=*(const __attribute__((address_space(3))) bf16x8*)(kp+6656);
}
__device__ __forceinline__ void kload2(bf16x8*kf,lds_cptr kp,int j){ kf[2*j]=*(const __attribute__((address_space(3))) bf16x8*)(kp+j*2048); kf[2*j+1]=*(const __attribute__((address_space(3))) bf16x8*)(kp+j*2048+512); }
__device__ __forceinline__ s16x4 vtr(lds_cptr p){ return __builtin_bit_cast(s16x4,__builtin_amdgcn_ds_read_tr16_b64_v4i16((__attribute__((address_space(3))) v4i16_t*)p)); }
__device__ __forceinline__ float rowmax(const f32x16&p0,const f32x16&p1){
  float a=max3f(p0[0],p0[1],p1[0]),b=max3f(p0[2],p0[3],p1[1]);a=max3f(a,p1[2],p1[3]);
  #pragma unroll
  for(int r=4;r<16;r+=4){a=max3f(a,p0[r],p0[r+1]);b=max3f(b,p0[r+2],p0[r+3]);a=max3f(a,p1[r],p1[r+1]);b=max3f(b,p1[r+2],p1[r+3]);}
  const float m=max2f(a,b);
  auto rr=__builtin_amdgcn_permlane32_swap(__float_as_uint(m),__float_as_uint(m),false,false);
  return max2f(__uint_as_float(rr[0]),__uint_as_float(rr[1]));
}
__device__ __forceinline__ void pv(f32x16*o,int vb,bf16x8 pa0,bf16x8 pa1,bf16x8 pa2,bf16x8 pa3){
  #pragma unroll
  for(int d0=0;d0<2;++d0){s16x4 lo[4],hi[4];
    #pragma unroll
    for(int ks=0;ks<4;++ks){
      asm volatile("ds_read_b64_tr_b16 %0,%1 offset:%c2":"=&v"(lo[ks]):"v"(vb),"i"(d0*4096+ks*1024):"memory");
      asm volatile("ds_read_b64_tr_b16 %0,%1 offset:%c2":"=&v"(hi[ks]):"v"(vb),"i"(d0*4096+ks*1024+512):"memory");}
    asm volatile("s_waitcnt lgkmcnt(0)":::"memory");SBAR();
    #define PK(k) (bf16x8){lo[k][0],lo[k][1],lo[k][2],lo[k][3],hi[k][0],hi[k][1],hi[k][2],hi[k][3]}
    o[d0]=__builtin_amdgcn_mfma_f32_32x32x16_bf16(pa0,PK(0),o[d0],0,0,0);
    o[d0]=__builtin_amdgcn_mfma_f32_32x32x16_bf16(pa1,PK(1),o[d0],0,0,0);
    o[d0]=__builtin_amdgcn_mfma_f32_32x32x16_bf16(pa2,PK(2),o[d0],0,0,0);
    o[d0]=__builtin_amdgcn_mfma_f32_32x32x16_bf16(pa3,PK(3),o[d0],0,0,0);
    #undef PK
  }
}

#ifndef ATTN_STORE16
#define ATTN_STORE16(p,v) (*(u32x4*)(p)=(v))
#endif
template<int THRL,int MODE> __device__ __forceinline__ void attn_unit(int b,int h,int qb,const bf16*Q,const bf16*__restrict__ K,const bf16*__restrict__ V,int KP,int kvcol,bf16*O,int ocol,float*ssq,float slope_l2,float sink_l2,char*shm){
  int tid=threadIdx.x; asm volatile("":"+v"(tid));
  const int lane=tid&63,r32=lane&31,hi=lane>>5; const int wid=__builtin_amdgcn_readfirstlane(tid>>6);
  const long rowbase=(long)b*SEQ; const int q0=qb*QB;
  const int t0=(MODE==0)?((qb>0)?4*qb-2:0):0;
  const bf16*Qw=Q+(rowbase+q0+wid*QBLK)*QP+h*D;
  const bf16*Kh=K+(rowbase+(long)t0*KVBLK)*KP+kvcol,*Vh=V+(rowbase+(long)t0*KVBLK)*KP+kvcol;
  const unsigned lds0=(unsigned)(uintptr_t)shm;
  float*wsf=(float*)(shm+LDS_WS)+wid*64;
  const bf16*ksrc=Kh+(long)lane*KP+wid*8;
  const bf16*vsrc=Vh+(long)(16*(wid&3)+(lane>>2))*KP+(wid>>2)*32+(lane&3)*8;
  const unsigned kdst=lds0+LDS_K+wid*1024, vdst=lds0+LDS_V+wid*1024;
  #define DMA_K(t,slot) glds16(ksrc+(long)(t)*KVBLK*KP,(unsigned)__builtin_amdgcn_readfirstlane(kdst+(slot)))
  #define DMA_V(t,slot) glds16(vsrc+(long)(t)*KVBLK*KP,(unsigned)__builtin_amdgcn_readfirstlane(vdst+(slot)))
  const int vb0=(int)(lds0+LDS_V)+((lane>>4)&1)*32+(lane&3)*8+(4*hi+((lane&15)>>2))*64;
  const char*Kbase=shm+LDS_K; bf16x8 kf[8];
  const lds_cptr shm3=(lds_cptr)shm; const lds_cptr kp0=shm3+LDS_K+hi*1024+r32*16; const lds_cptr vp0=shm3+LDS_V+((lane>>4)&1)*32+(lane&3)*8+(4*hi+((lane&15)>>2))*64;
  const int NT=(MODE==0)?((qb>0)?6:4):(q0+QB)/KVBLK;
  typedef __attribute__((address_space(3))) float* lds_fptr;
  const lds_fptr cl=(lds_fptr)((lds_cptr)shm+((MODE==1)?LDS_CL:LDS_CL2));
  if(MODE==0){ if(tid<384)cl[tid]=-slope_l2*(float)tid; }
  DMA_K(0,0);DMA_V(0,0);DMA_K(1,SLOTB);
  bf16x8 qr[4];
  #pragma unroll
  for(int d0=0;d0<4;++d0)qr[d0]=*reinterpret_cast<const bf16x8*>(&Qw[(long)r32*QP+d0*16+hi*8]);
  float mhat=0.f,l_reg=0.f;f32x16 o[2];o[0]=f32x16{};o[1]=f32x16{};
  const int qrel=wid*QBLK+r32;
  asm volatile("s_waitcnt lgkmcnt(0)\n\ts_barrier":::"memory");
  const float ct=cl[q0-t0*KVBLK+qrel];
  float nm=ct;
  #define CINIT(I0,I1,t) do{ const lds_fptr cp_=cl+64*(t)+4*hi; _Pragma("unroll") for(int g_=0;g_<4;++g_){ \
      const f32x4v a_=*(const __attribute__((address_space(3))) f32x4v*)(cp_+8*g_), b_=*(const __attribute__((address_space(3))) f32x4v*)(cp_+8*g_+32); \
      _Pragma("unroll") for(int j_=0;j_<4;++j_){ I0[4*g_+j_]=nm-a_[j_]; I1[4*g_+j_]=nm-b_[j_]; } SBAR(); } }while(0)
  #define CMASK(P0,P1,t) do{int ko_=64*((t)-(NT-4)); if(MODE==0||ko_>=0)amask<MODE==0>(P0,P1,ko_,qrel,hi);}while(0)
  bool resc=false;
  #define START(P0,P1) do{ const float rm=rowmax(P0,P1); resc=false; \
    { const float dl=__builtin_fmaxf(rm,-1000.f); mhat=fadd_s(mhat,dl); \
      _Pragma("unroll") for(int r=0;r<16;++r){P0[r]=fsub_s(P0[r],dl);P1[r]=fsub_s(P1[r],dl);} \
      nm=ct-mhat; } \
    _Pragma("unroll") for(int r=0;r<16;++r)P0[r]=__builtin_amdgcn_exp2f(P0[r]); }while(0)
  #define RESC() do{ if(resc){ asm volatile("s_waitcnt lgkmcnt(0)":::"memory"); \
      _Pragma("unroll") for(int d_=0;d_<2;++d_) _Pragma("unroll") for(int r=0;r<16;++r)o[d_][r]*=wsf[crow(r,hi)]; } }while(0)
  f32x16 pA0,pA1,pB0,pB1;
  int sl_prev=0,sl_cur=0,sl_next=SLOTB;
  #define ROT() do{sl_prev=sl_cur;sl_cur=sl_next;sl_next=(sl_next==(NSLOT-1)*SLOTB)?0:sl_next+SLOTB;}while(0)
  DMA_K(2,2*SLOTB);
  WAIT_BAR(3);
  CINIT(pA0,pA1,0); qkt(pA0,pA1,Kbase,qr,r32,hi);asm volatile("s_nop 15\n\ts_nop 7":"+v"(pA0),"+v"(pA1));CMASK(pA0,pA1,0);
  START(pA0,pA1);
  _Pragma("unroll") for(int r=0;r<16;++r)pA1[r]=__builtin_amdgcn_exp2f(pA1[r]);
  WAIT_BAR(0);
  DMA_K(3,0);DMA_V(1,SLOTB);
  ROT();
  kload8(kf,kp0+sl_cur);
  WAIT_BAR(2);
  s16x4 vlo[8],vhi[8]; u32x4 pw0,pw1,pw2,pw3;
  #define PKW(P,B) cvtpk_s(P[B],P[B+1])
  #define PAF(k) __builtin_bit_cast(bf16x8,pw##k)
  #define VFR(i) (bf16x8){vlo[i][0],vlo[i][1],vlo[i][2],vlo[i][3],vhi[i][0],vhi[i][1],vhi[i][2],vhi[i][3]}
  #define PIN(x) asm volatile("":"+v"(x))
  #define MX3(a,b,c) __builtin_fmaxf(__builtin_fmaxf((a),(b)),(c))
  #define GAPA(MF,A0,A1,A2,A3,W0,W1,PW) do{ MF; sacc+=A0; sacc+=A1; sacc+=A2; sacc+=A3; PIN(sacc); W0; W1; PIN(PW); SBAR(); }while(0)
  #define EX(v) __builtin_amdgcn_exp2f(v)
  #define GAPB(MF,X,B) do{ MF; X[B]=EX(X[B]); X[B+1]=EX(X[B+1]); X[B+2]=EX(X[B+2]); X[B+3]=EX(X[B+3]); PIN(X); SBAR(); }while(0)
  #define VRD(i) do{ vlo[i]=vtr(vp_+(((i)>>2)*4096+((i)&3)*1024)); vhi[i]=vtr(vp_+(((i)>>2)*4096+((i)&3)*1024+512)); }while(0)
  #define KRD(G,j) do{ if(G){ kload2(kf,kp0+sl_next,j); SBAR(); } }while(0)
  #define STEP(C0,C1,P0,P1,t,GK,GV,GL) do{ SBAR(); CINIT(C0,C1,t); SBAR(); \
    const lds_cptr vp_=vp0+sl_prev; \
    VRD(0); SBAR(); float sacc=(P0[0]+P0[1]); \
    GAPA(C0=__builtin_amdgcn_mfma_f32_32x32x16_bf16(kf[0],qr[0],C0,0,0,0), P0[2],P0[3],P0[4],P0[5],     pw0[0]=PKW(P0,0), pw0[1]=PKW(P0,2), pw0); \
    VRD(4); SBAR(); GAPA(C1=__builtin_amdgcn_mfma_f32_32x32x16_bf16(kf[1],qr[0],C1,0,0,0), P0[6],P0[7],P0[8],P0[9],     pw0[2]=PKW(P0,4), pw0[3]=PKW(P0,6), pw0); \
    VRD(1); SBAR(); GAPA(C0=__builtin_amdgcn_mfma_f32_32x32x16_bf16(kf[2],qr[1],C0,0,0,0),   P0[10],P0[11],P0[12],P0[13], pw1[0]=PKW(P0,8), pw1[1]=PKW(P0,10), pw1); \
    VRD(5); SBAR(); GAPA(C1=__builtin_amdgcn_mfma_f32_32x32x16_bf16(kf[3],qr[1],C1,0,0,0),   P0[14],P0[15],P1[0],P1[1],   pw1[2]=PKW(P0,12),pw1[3]=PKW(P0,14), pw1); \
    VRD(2); SBAR(); GAPA(C0=__builtin_amdgcn_mfma_f32_32x32x16_bf16(kf[4],qr[2],C0,0,0,0),   P1[2],P1[3],P1[4],P1[5],     pw2[0]=PKW(P1,0), pw2[1]=PKW(P1,2), pw2); \
    VRD(6); SBAR(); GAPA(C1=__builtin_amdgcn_mfma_f32_32x32x16_bf16(kf[5],qr[2],C1,0,0,0),   P1[6],P1[7],P1[8],P1[9],     pw2[2]=PKW(P1,4), pw2[3]=PKW(P1,6), pw2); \
    VRD(3); SBAR(); GAPA(C0=__builtin_amdgcn_mfma_f32_32x32x16_bf16(kf[6],qr[3],C0,0,0,0),   P1[10],P1[11],P1[12],P1[13], pw3[0]=PKW(P1,8), pw3[1]=PKW(P1,10), pw3); \
    VRD(7); SBAR(); GAPA(C1=__builtin_amdgcn_mfma_f32_32x32x16_bf16(kf[7],qr[3],C1,0,0,0),   P1[14],P1[15],0.f,0.f,       pw3[2]=PKW(P1,12),pw3[3]=PKW(P1,14), pw3); \
    l_reg+=sacc; \
    if(GK){DMA_K((t)+3,sl_cur);} if(GV){DMA_V((t)+1,sl_next);} \
    CMASK(C0,C1,t); \
    { float a=MX3(C0[0],C0[1],C1[0]),b=MX3(C0[2],C0[3],C1[1]); a=MX3(a,C1[2],C1[3]); \
      _Pragma("unroll") for(int r=4;r<16;r+=4){a=MX3(a,C0[r],C0[r+1]);b=MX3(b,C0[r+2],C0[r+3]);a=MX3(a,C1[r],C1[r+1]);b=MX3(b,C1[r+2],C1[r+3]);} \
      float rm=__builtin_fmaxf(a,b); { auto rr=__builtin_amdgcn_permlane32_swap(__float_as_uint(rm),__float_as_uint(rm),false,false); rm=__builtin_fmaxf(__uint_as_float(rr[0]),__uint_as_float(rr[1])); } \
      resc=false; \
      if(__builtin_expect(__any(rm>(float)THRL),0)){ const float dl=__builtin_fmaxf(rm,0.f); mhat+=dl; \
        _Pragma("unroll") for(int r=0;r<16;++r){C0[r]-=dl;C1[r]-=dl;} \
        nm=ct-mhat; \
        const float f=__builtin_amdgcn_exp2f(-dl); l_reg*=f; if(hi==0)wsf[r32]=f; resc=true; } } \
    SBAR(); \
    GAPB(o[0]=__builtin_amdgcn_mfma_f32_32x32x16_bf16(PAF(0),VFR(0),o[0],0,0,0), C0,0); \
    GAPB(o[1]=__builtin_amdgcn_mfma_f32_32x32x16_bf16(PAF(0),VFR(4),o[1],0,0,0), C0,4); \
    KRD(GL,0); GAPB(o[0]=__builtin_amdgcn_mfma_f32_32x32x16_bf16(PAF(1),VFR(1),o[0],0,0,0), C0,8); \
    KRD(GL,1); GAPB(o[1]=__builtin_amdgcn_mfma_f32_32x32x16_bf16(PAF(1),VFR(5),o[1],0,0,0), C0,12); \
    KRD(GL,2); GAPB(o[0]=__builtin_amdgcn_mfma_f32_32x32x16_bf16(PAF(2),VFR(2),o[0],0,0,0), C1,0); \
    KRD(GL,3); GAPB(o[1]=__builtin_amdgcn_mfma_f32_32x32x16_bf16(PAF(2),VFR(6),o[1],0,0,0), C1,4); \
    GAPB(o[0]=__builtin_amdgcn_mfma_f32_32x32x16_bf16(PAF(3),VFR(3),o[0],0,0,0), C1,8); \
    GAPB(o[1]=__builtin_amdgcn_mfma_f32_32x32x16_bf16(PAF(3),VFR(7),o[1],0,0,0), C1,12); \
    }while(0)
  #define ACT(tt) ((64*((tt)-(NT-4))+63>=32*wid-127)&&(64*((tt)-(NT-4))<=32*wid+31))
  #define STEPW(C0,C1,P0,P1,t,GK,GV,GL) do{ SBAR(); \
    const bool aq_=ACT(t), ap_=ACT((t)-1); \
    const lds_cptr vp_=vp0+sl_prev; \
    if(ap_){ VRD(0);VRD(4);VRD(1);VRD(5);VRD(2);VRD(6);VRD(3);VRD(7); \
      float sacc=(P0[0]+P0[1]); _Pragma("unroll") for(int r=2;r<16;++r)sacc+=P0[r]; _Pragma("unroll") for(int r=0;r<16;++r)sacc+=P1[r]; l_reg+=sacc; \
      pw0=(u32x4){PKW(P0,0),PKW(P0,2),PKW(P0,4),PKW(P0,6)};pw1=(u32x4){PKW(P0,8),PKW(P0,10),PKW(P0,12),PKW(P0,14)};pw2=(u32x4){PKW(P1,0),PKW(P1,2),PKW(P1,4),PKW(P1,6)};pw3=(u32x4){PKW(P1,8),PKW(P1,10),PKW(P1,12),PKW(P1,14)}; } \
    SBAR(); \
    if(aq_){ CINIT(C0,C1,t); \
      C0=__builtin_amdgcn_mfma_f32_32x32x16_bf16(kf[0],qr[0],C0,0,0,0); C1=__builtin_amdgcn_mfma_f32_32x32x16_bf16(kf[1],qr[0],C1,0,0,0); \
      C0=__builtin_amdgcn_mfma_f32_32x32x16_bf16(kf[2],qr[1],C0,0,0,0); C1=__builtin_amdgcn_mfma_f32_32x32x16_bf16(kf[3],qr[1],C1,0,0,0); \
      C0=__builtin_amdgcn_mfma_f32_32x32x16_bf16(kf[4],qr[2],C0,0,0,0); C1=__builtin_amdgcn_mfma_f32_32x32x16_bf16(kf[5],qr[2],C1,0,0,0); \
      C0=__builtin_amdgcn_mfma_f32_32x32x16_bf16(kf[6],qr[3],C0,0,0,0); C1=__builtin_amdgcn_mfma_f32_32x32x16_bf16(kf[7],qr[3],C1,0,0,0); } \
    if(GK){DMA_K((t)+3,sl_cur);} if(GV){DMA_V((t)+1,sl_next);} \
    resc=false; \
    if(aq_){ CMASK(C0,C1,t); \
      float a=MX3(C0[0],C0[1],C1[0]),b=MX3(C0[2],C0[3],C1[1]); a=MX3(a,C1[2],C1[3]); \
      _Pragma("unroll") for(int r=4;r<16;r+=4){a=MX3(a,C0[r],C0[r+1]);b=MX3(b,C0[r+2],C0[r+3]);a=MX3(a,C1[r],C1[r+1]);b=MX3(b,C1[r+2],C1[r+3]);} \
      float rm=__builtin_fmaxf(a,b); { auto rr=__builtin_amdgcn_permlane32_swap(__float_as_uint(rm),__float_as_uint(rm),false,false); rm=__builtin_fmaxf(__uint_as_float(rr[0]),__uint_as_float(rr[1])); } \
      if(__builtin_expect(__any(rm>(float)THRL),0)){ const float dl=__builtin_fmaxf(rm,0.f); mhat+=dl; \
        _Pragma("unroll") for(int r=0;r<16;++r){C0[r]-=dl;C1[r]-=dl;} \
        nm=ct-mhat; \
        const float f=__builtin_amdgcn_exp2f(-dl); l_reg*=f; if(hi==0)wsf[r32]=f; resc=true; } } \
    SBAR(); \
    if(ap_){ \
      o[0]=__builtin_amdgcn_mfma_f32_32x32x16_bf16(PAF(0),VFR(0),o[0],0,0,0); o[1]=__builtin_amdgcn_mfma_f32_32x32x16_bf16(PAF(0),VFR(4),o[1],0,0,0); \
      o[0]=__builtin_amdgcn_mfma_f32_32x32x16_bf16(PAF(1),VFR(1),o[0],0,0,0); o[1]=__builtin_amdgcn_mfma_f32_32x32x16_bf16(PAF(1),VFR(5),o[1],0,0,0); \
      o[0]=__builtin_amdgcn_mfma_f32_32x32x16_bf16(PAF(2),VFR(2),o[0],0,0,0); o[1]=__builtin_amdgcn_mfma_f32_32x32x16_bf16(PAF(2),VFR(6),o[1],0,0,0); \
      o[0]=__builtin_amdgcn_mfma_f32_32x32x16_bf16(PAF(3),VFR(3),o[0],0,0,0); o[1]=__builtin_amdgcn_mfma_f32_32x32x16_bf16(PAF(3),VFR(7),o[1],0,0,0); } \
    if((GL)&&ACT((t)+1)){ kload2(kf,kp0+sl_next,0); kload2(kf,kp0+sl_next,1); kload2(kf,kp0+sl_next,2); kload2(kf,kp0+sl_next,3); } \
    if(aq_){ _Pragma("unroll") for(int r=0;r<16;++r){C0[r]=EX(C0[r]);C1[r]=EX(C1[r]);} } else { C0=f32x16{}; C1=f32x16{}; } \
    SBAR(); \
    }while(0)
  #define STEPX(C0,C1,P0,P1,t,GK,GV,GL) do{ if(MODE==0){ STEPW(C0,C1,P0,P1,t,GK,GV,GL); } else { STEP(C0,C1,P0,P1,t,GK,GV,GL); } }while(0)
  int t=1;
  #undef CMASK
  #define CMASK(P0,P1,t) do{}while(0)
  for(;t+5<NT;t+=2){
    STEP(pB0,pB1,pA0,pA1,t,true,true,true);     WAIT_BAR(2); RESC(); ROT();
    STEP(pA0,pA1,pB0,pB1,t+1,true,true,true);   WAIT_BAR(2); RESC(); ROT();
  }
  #undef CMASK
  #define CMASK(P0,P1,t) do{int ko_=64*((t)-(NT-4)); if(MODE==0||ko_>=0)amask<MODE==0>(P0,P1,ko_,qrel,hi);}while(0)
  #define ENDW(tt) do{ if((tt)+3<NT){WAIT_BAR(2);} else if((tt)+2<NT){WAIT_BAR(1);} else {WAIT_BAR(0);} }while(0)
  for(;t+1<NT;t+=2){
    STEPX(pB0,pB1,pA0,pA1,t,(t+3<NT),(t+1<NT),(t+1<NT));       ENDW(t);   RESC(); ROT();
    STEPX(pA0,pA1,pB0,pB1,t+1,(t+4<NT),(t+2<NT),(t+2<NT));     ENDW(t+1); RESC(); ROT();
  }
  STEPX(pB0,pB1,pA0,pA1,NT-1,false,false,false); RESC();
  if(MODE==1||ACT(NT-1))
  { float sacc=pB0[0]+pB0[1]; _Pragma("unroll") for(int r=2;r<16;++r)sacc+=pB0[r]; _Pragma("unroll") for(int r=0;r<16;++r)sacc+=pB1[r]; l_reg+=sacc;
    pw0=(u32x4){PKW(pB0,0),PKW(pB0,2),PKW(pB0,4),PKW(pB0,6)};pw1=(u32x4){PKW(pB0,8),PKW(pB0,10),PKW(pB0,12),PKW(pB0,14)};pw2=(u32x4){PKW(pB1,0),PKW(pB1,2),PKW(pB1,4),PKW(pB1,6)};pw3=(u32x4){PKW(pB1,8),PKW(pB1,10),PKW(pB1,12),PKW(pB1,14)};
    SBAR(); pv(o,vb0+sl_cur,PAF(0),PAF(1),PAF(2),PAF(3)); }
  #undef PKW
  #undef PAF
  #undef VFR
  #undef PIN
  #undef MX3
  #undef GAPA
  #undef GAPB
  #undef EX
  #undef VRD
  #undef KRD
  #undef STEP
  #undef ENDW
  #undef STEPX
  #undef STEPW
  #undef ACT
  {auto rr=__builtin_amdgcn_permlane32_swap(__float_as_uint(l_reg),__float_as_uint(l_reg),false,false);l_reg=__uint_as_float(rr[0])+__uint_as_float(rr[1]);}
  if(MODE==0)l_reg+=__builtin_amdgcn_exp2f(sink_l2-mhat);
  if(hi==0)wsf[32+r32]=l_reg;asm volatile("s_waitcnt lgkmcnt(0)":::"memory");
  float rli[16];
  #pragma unroll
  for(int r=0;r<16;++r)rli[r]=__builtin_amdgcn_rcpf(wsf[32+crow(r,hi)]);
  bf16*Ow=O+(rowbase+q0+wid*QBLK)*OP+ocol;
  { bf16*stg=(bf16*)(shm+LDS_OST)+wid*2048;
    #pragma unroll
    for(int r=0;r<16;++r){const int orow=crow(r,hi);
      #pragma unroll
      for(int d0=0;d0<2;++d0)stg[orow*64+d0*32+r32]=__float2bfloat16(o[d0][r]*rli[r]);}
    asm volatile("s_waitcnt lgkmcnt(0)":::"memory");
    #pragma unroll
    for(int i=0;i<4;++i){const int row=i*8+(lane>>3),ch=lane&7; const u32x4 v=*(const u32x4*)(stg+row*64+ch*8); ATTN_STORE16(Ow+(long)row*OP+ch*8,v);
      float ss=0.f;
      #pragma unroll
      for(int e=0;e<4;++e){const float lo=__builtin_bit_cast(float,v[e]<<16),hh=__builtin_bit_cast(float,v[e]&0xffff0000u); ss+=lo*lo+hh*hh;}
      ss+=__shfl_xor(ss,1); ss+=__shfl_xor(ss,2); ss+=__shfl_xor(ss,4);
      if(ch==0)ssq[(rowbase+q0+wid*QBLK+row)*32+MODE*16+h]=ss; } }
  asm volatile("s_waitcnt lgkmcnt(0)\n\ts_barrier":::"memory");
  #undef CINIT
  #undef DMA_K
  #undef DMA_V
  #undef CMASK
  #undef START
  #undef RESC
  #undef ROT
}
constexpr int ATTN_LDS_BYTES=LDS_BYTES;
#undef SBAR
#undef WAIT_BAR
}

__device__ __forceinline__ void fox_cumsum(const float* Ft, float bias, int b, int h, char* lds) {
    typedef __attribute__((address_space(3))) float* lds_fptr; typedef __attribute__((address_space(3))) const char* lds_cptr;
    const lds_fptr cl = (lds_fptr)((lds_cptr)lds + attn_body::LDS_CL), wt = (lds_fptr)((lds_cptr)lds + attn_body::LDS_WT);
    int tid = threadIdx.x; asm volatile("" : "+v"(tid));
    const int lane = tid & 63, wave = tid >> 6;
    const f32x4* f = (const f32x4*)(Ft + (size_t)h * M + (size_t)b * SEQ + 8 * tid);
    const f32x4 a = f[0], c = f[1];
    float v[8] = {a[0], a[1], a[2], a[3], c[0], c[1], c[2], c[3]};
#pragma unroll
    for (int k = 0; k < 8; ++k) v[k] = log_sigmoid(v[k] + bias);
#pragma unroll
    for (int k = 1; k < 8; ++k) v[k] += v[k - 1];
    float inc = v[7];
#pragma unroll
    for (int o = 1; o < 64; o <<= 1) { const float t = __shfl_up(inc, o); if (lane >= o) inc += t; }
    if (lane == 63) wt[wave] = inc;
    __syncthreads();
    float base = inc - v[7];
#pragma unroll
    for (int w = 0; w < 8; ++w) if (w < wave) base += wt[w];
    *(__attribute__((address_space(3))) f32x4*)(cl + 8 * tid) = (f32x4){(v[0] + base) * LOG2E, (v[1] + base) * LOG2E, (v[2] + base) * LOG2E, (v[3] + base) * LOG2E};
    *(__attribute__((address_space(3))) f32x4*)(cl + 8 * tid + 4) = (f32x4){(v[4] + base) * LOG2E, (v[5] + base) * LOG2E, (v[6] + base) * LOG2E, (v[7] + base) * LOG2E};
    __syncthreads();
}
__device__ __forceinline__ void attn_phase(const Ptrs& P, char* lds) {
    unsigned char* ws = P.ws;
    const int G = gridDim.x, bx = blockIdx.x, vcu0 = (G % 8 == 0) ? (bx % 8) * (G / 8) + bx / 8 : bx;
    for (int v = vcu0; v < 256; v += G) {
        const int bh = v >> 2, s = v & 3, b = bh >> 4, h = bh & 15;
        fox_cumsum((const float*)(ws + WS_F), P.b_forget[h], b, h, lds);
        for (int i = 0; i < 4; ++i) {
            const int qb = (i == 0) ? s : (i == 1) ? 7 - s : (i == 2) ? 8 + s : 15 - s;
            attn_body::attn_unit<60, 1>(b, h, qb, (const attn_body::bf16*)(ws + WS_QB), (const attn_body::bf16*)(ws + WS_KB), (const attn_body::bf16*)(ws + WS_VB), 1024, h * 64,
                                        (attn_body::bf16*)(ws + WS_O), 1024 + h * 64, (float*)(ws + WS_Y), 0.f, 0.f, lds);
        }
        for (int i = 0; i < 4; ++i) {
            const int qb = (i == 0) ? s : (i == 1) ? 7 - s : (i == 2) ? 8 + s : 15 - s;
            attn_body::attn_unit<8, 0>(b, h, qb, (const attn_body::bf16*)(ws + WS_QA), (const attn_body::bf16*)(ws + WS_KA), (const attn_body::bf16*)(ws + WS_VA), 128, (h >> 3) * 64,
                                       (attn_body::bf16*)(ws + WS_O), h * 64, (float*)(ws + WS_Y), exp2f(-0.5f * (float)(h + 1)) * LOG2E, P.sinks[h] * LOG2E, lds);
        }
    }
}
#define LAS __attribute__((address_space(3)))
#define XB_TMO      128
#define XB_XCNT(j)  (256  + 64 * (j))
#define XB_XSUB(j)  (1280 + 64 * (j))
#define XB_XGEN(j)  (2304 + 64 * (j))
#define XB_TOP      3328
#define XB_TOPGEN   3392
#define XCD_BAR_WORDS 3456
#define XB_SPIN_CAP (1u << 18)

__device__ __forceinline__ unsigned xb_ld(unsigned* p)              { return __hip_atomic_load(p, __ATOMIC_RELAXED, __HIP_MEMORY_SCOPE_AGENT); }
__device__ __forceinline__ unsigned xb_add(unsigned* p, unsigned v) { return __hip_atomic_fetch_add(p, v, __ATOMIC_RELAXED, __HIP_MEMORY_SCOPE_AGENT); }
__device__ __forceinline__ unsigned xb_xcc_id() { return (unsigned)__builtin_amdgcn_s_getreg((3 << 11) | 20) & 0xFu; }
#define XB_SPIN(cond, bar) do { unsigned _sp = 0; while (cond) { __builtin_amdgcn_s_sleep(1); \
    if ((++_sp & 255u) == 0u) { if (xb_ld(&(bar)[XB_TMO])) break; if (_sp > XB_SPIN_CAP) { atomicAdd(&(bar)[XB_TMO], 1u); break; } } } } while (0)

struct XcdBarrier {
    unsigned* bar; unsigned x;
    volatile LAS unsigned* st;
};

__device__ __forceinline__ XcdBarrier xcd_barrier_post(unsigned* bar, volatile LAS unsigned* st) {
    XcdBarrier b; b.bar = bar; b.x = xb_xcc_id(); b.st = st;
    if (threadIdx.x == 0) (void)xb_add(&bar[XB_XCNT(b.x)], 1u);
    return b;
}
__device__ __forceinline__ void xcd_barrier_complete(unsigned* bar, unsigned x, unsigned& nloc, unsigned& nx) {
    const unsigned G = gridDim.x * gridDim.y * gridDim.z;
    unsigned sum, cnt, mine, sp = 0u;
    for (;;) {
        sum = 0u; cnt = 0u; mine = 0u;
#pragma unroll
        for (unsigned j = 0; j < 16; ++j) { const unsigned c = xb_ld(&bar[XB_XCNT(j)]); sum += c; cnt += (c > 0u) ? 1u : 0u; mine = (j == x) ? c : mine; }
        if (sum == G) break;
        __builtin_amdgcn_s_sleep(1);
        if ((++sp & 255u) == 0u) { if (xb_ld(&bar[XB_TMO])) break; if (sp > XB_SPIN_CAP) { atomicAdd(&bar[XB_TMO], 1u); break; } }
    }
    nloc = mine > 0u ? mine : 1u; nx = cnt > 0u ? cnt : 1u;
}

__device__ __forceinline__ void xcd_barrier(const XcdBarrier& b) {
    asm volatile("s_waitcnt vmcnt(0)" ::: "memory");
    __syncthreads();
    if (threadIdx.x == 0) {
        unsigned* bar = b.bar;
        __builtin_amdgcn_s_waitcnt(0);
        unsigned nloc = b.st[0], nx = b.st[1];
        if (nloc == 0u) { xcd_barrier_complete(bar, b.x, nloc, nx); b.st[0] = nloc; b.st[1] = nx; }
        const unsigned old = xb_add(&bar[XB_XSUB(b.x)], 1u);
        const unsigned gen = old / nloc;
        if (old + 1u == (gen + 1u) * nloc) {
            __builtin_amdgcn_fence(__ATOMIC_RELEASE, "agent");
            asm volatile("s_waitcnt vmcnt(0)" ::: "memory");
            const unsigned og = xb_add(&bar[XB_TOP], 1u);
            const unsigned tg = og / nx;
            if (og + 1u == (tg + 1u) * nx) xb_add(&bar[XB_TOPGEN], 1u);
            else XB_SPIN(xb_ld(&bar[XB_TOPGEN]) == tg, bar);
            __builtin_amdgcn_fence(__ATOMIC_ACQUIRE, "agent");
            xb_add(&bar[XB_XGEN(b.x)], 1u);
            asm volatile("s_waitcnt vmcnt(0)" ::: "memory");
        } else {
            XB_SPIN(xb_ld(&bar[XB_XGEN(b.x)]) == gen, bar);
            __builtin_amdgcn_fence(__ATOMIC_ACQUIRE, "agent");
            asm volatile("s_waitcnt vmcnt(0)" ::: "memory");
        }
    }
    __syncthreads();
}

constexpr int LDS_BYTES = 147456;
__global__ void __launch_bounds__(512, 2) mega_fwd(Ptrs P) {
    extern __shared__ __attribute__((aligned(16))) unsigned char lds[];
    cg::grid_group grid = cg::this_grid();
    if (P.use_cg) grid.sync();
    unsigned char* ws = P.ws;
    PG8_LAS unsigned char* ldsp = (PG8_LAS unsigned char*)lds;
    const int NGW = gridDim.x * 8;
    volatile LAS unsigned* bst = (volatile LAS unsigned*)(ldsp + 143360);
    if (threadIdx.x == 0) { bst[0] = 0u; bst[1] = 0u; }
    __syncthreads();
    const XcdBarrier bar = xcd_barrier_post((unsigned*)(ws + WS_CTL), bst);
#define GRID_SYNC() xcd_barrier(bar)
#define FRESH_IDS() int tid_; asm volatile("v_mov_b32 %0, %1" : "=v"(tid_) : "v"(threadIdx.x)); const int lane = tid_ & 63, gw = blockIdx.x * 8 + (tid_ >> 6)
    ph_prologue(P, (float*)lds);
    { FRESH_IDS(); pass_prenorm(P.x, P.pre_mix_g, (bf16_t*)(ws + WS_XN), (float*)(ws + WS_CS + 512 * 1024), gw, NGW, lane); }
    GRID_SYNC();
    { pg8::Gemm g{(const bf16_t*)(ws + WS_XN), (const bf16_t*)(ws + WS_WIN), M, DINP, DM}; pg8::StaticOrder S; S.init(M, DINP, (int)gridDim.x, (int)blockIdx.x);
      pg8::gemm_phase<pg8::EpiInProjT, pg8::StaticOrder, true, true>(ldsp, g, S, pg8::EpiInProjT{ws}); }
    if (gridDim.x == 256 && blockIdx.x >= 128) convert_items(P, (float*)lds, I_CUT, I_ALL, (blockIdx.x - 128) * 8 + (threadIdx.x >> 6), 128 * 8);
    GRID_SYNC();
    attn_phase(P, (char*)lds);
    GRID_SYNC();
    { pg8::Gemm g{(const bf16_t*)(ws + WS_O), (const bf16_t*)(ws + WS_WOUT), M, DM, DM}; pg8::StaticOrder S; S.init(M, DM, (int)gridDim.x, (int)blockIdx.x);
      PG8_LAS float* T = (PG8_LAS float*)(ldsp + 139264);
      { pg8::Unit u; const float* SS = (const float*)(ws + WS_Y);
        for (int i = 0; i < 2; ++i) if (S.next(i, u) && threadIdx.x < 256) { const int row = u.pm * 256 + (int)threadIdx.x;
            float sa = 0.f, sb = 0.f;
#pragma unroll
            for (int q4 = 0; q4 < 4; ++q4) { const f32x4 a4 = *(const f32x4*)(SS + (size_t)row * 32 + 4 * q4), b4 = *(const f32x4*)(SS + (size_t)row * 32 + 16 + 4 * q4); sa += (a4[0] + a4[1]) + (a4[2] + a4[3]); sb += (b4[0] + b4[1]) + (b4[2] + b4[3]); }
            const float ra = 1.0f / sqrtf(sa * (1.0f / 1024.f) + EPS), rb = 1.0f / sqrtf(sb * (1.0f / 1024.f) + EPS);
            T[(i * 256 + (int)threadIdx.x) * 2] = ra / rb; T[(i * 256 + (int)threadIdx.x) * 2 + 1] = rb; } }
      __syncthreads();
      pg8::gemm_phase<pg8::EpiOutT, pg8::StaticOrder, true, true>(ldsp, g, S, pg8::EpiOutT{(bf16_t*)(ws + WS_MIX), DM, T}); }
    GRID_SYNC();
    { FRESH_IDS(); pass_postmix((bf16_t*)(ws + WS_XN), (const float*)(ws + WS_CS + 512 * 1024), P.pre_mix_g, (const bf16_t*)(ws + WS_MIX), P.post_mix_g, P.pre_ffn_g, (float*)(ws + WS_CS + 256 * 1024), gw, NGW, lane); }
    GRID_SYNC();
    { pg8::Gemm g{(const bf16_t*)(ws + WS_XN), (const bf16_t*)(ws + WS_WUP), M, NUP, DM}; pg8::StaticOrder S; S.init(M, NUP, (int)gridDim.x, (int)blockIdx.x);
      pg8::gemm_phase<pg8::EpiUpT, pg8::StaticOrder, true, true>(ldsp, g, S, pg8::EpiUpT{(bf16_t*)(ws + WS_ACT), P.conv_w, P.conv_b, (float*)(ws + WS_SIDE), (PG8_LAS float*)(ldsp + 131072)}); }
    GRID_SYNC();
    ph_convfix((const float*)(ws + WS_SIDE), P.conv_w, P.conv_b, (bf16_t*)(ws + WS_ACT));
    GRID_SYNC();
    { pg8::Gemm g{(const bf16_t*)(ws + WS_ACT), (const bf16_t*)(ws + WS_WDN), M, DM, DFF}; pg8::StaticOrder S; S.init(M, DM, (int)gridDim.x, (int)blockIdx.x);
      pg8::gemm_phase<pg8::EpiBf16T, pg8::StaticOrder, true, true>(ldsp, g, S, pg8::EpiBf16T{(bf16_t*)(ws + WS_Y), DM}); }
    GRID_SYNC();
    { FRESH_IDS(); pass_final((const bf16_t*)(ws + WS_XN), (const float*)(ws + WS_CS + 256 * 1024), P.pre_ffn_g, (const bf16_t*)(ws + WS_Y), P.post_ffn_g, P.out, gw, NGW, lane); }
}

extern "C" void kernel_launch(void* const* d_in, const int* in_sizes, int n_in, void* d_out, int out_size, void* d_ws, size_t ws_size, hipStream_t stream) {
    if (n_in != 15 || ws_size < WS_END || out_size != M * DM) { fprintf(stderr, "kernel_launch: unexpected sizes n_in %d ws %zu out %d\n", n_in, ws_size, out_size); return; }
    static int grid_blocks = 0;
    if (!grid_blocks) {
        int dev = 0, cus = 0, per_cu = 0;
        hipGetDevice(&dev);
        hipDeviceGetAttribute(&cus, hipDeviceAttributeMultiprocessorCount, dev);
        if (hipFuncSetAttribute((const void*)mega_fwd, hipFuncAttributeMaxDynamicSharedMemorySize, LDS_BYTES) != hipSuccess) fprintf(stderr, "kernel_launch: hipFuncSetAttribute failed\n");
        hipOccupancyMaxActiveBlocksPerMultiprocessor(&per_cu, (const void*)mega_fwd, 512, LDS_BYTES);
        if (per_cu < 1) { fprintf(stderr, "kernel_launch: occupancy query gave %d\n", per_cu); per_cu = 1; }
        grid_blocks = cus * per_cu;
        if (grid_blocks != 256) fprintf(stderr, "kernel_launch: expected 256 resident workgroups, got %d (the output projection assumes two units per workgroup)\n", grid_blocks);
        (void)hipGetLastError();
    }
    Ptrs P{};
    const float** pp = (const float**)&P;
    for (int i = 0; i < 15; ++i) pp[i] = (const float*)d_in[i];
    P.out = (float*)d_out; P.ws = (unsigned char*)d_ws;
    P.use_cg = 0; P.pad = 0;
    if (hipMemsetAsync((char*)d_ws + WS_CTL, 0, CTL_BYTES, stream) != hipSuccess) { fprintf(stderr, "kernel_launch: hipMemsetAsync failed\n"); return; }
    void* args[] = {&P};
    hipError_t e = hipLaunchCooperativeKernel((const void*)mega_fwd, dim3(grid_blocks), dim3(512), args, LDS_BYTES, stream);
    if (e != hipSuccess) fprintf(stderr, "cooperative launch failed: %s (grid %d)\n", hipGetErrorString(e), grid_blocks);
}
```
